# Optimizing an MI355X kernel written in HIP

```python
import jax
import jax.numpy as jnp
from jax import lax
import numpy as np

D_MODEL = 2048
BATCH = 4
SEQ = 4096
DEPTH = 1

MEM_LEN = 256
EPS = 1e-6

GLA_HEADS = 4
GLA_DK = D_MODEL // (2 * GLA_HEADS)
GLA_DV = D_MODEL // GLA_HEADS
GLA_RANK = 16
GLA_GATE_NORM = 16.0
GLA_CHUNK = 64
GLA_QK = GLA_HEADS * GLA_DK
GLA_V = GLA_HEADS * GLA_DV

FOX_HEADS = 16
FOX_DH = D_MODEL // FOX_HEADS
FOX_W = FOX_HEADS * FOX_DH
FOX_BLOCK = 128

MEM_HEADS = 4
MEM_DH = 128
MEM_W = MEM_HEADS * MEM_DH

N_EXPERTS = 32
TOP_K = 4
D_FF = D_MODEL
SWIGLU_LIMIT = 7.0
SWIGLU_ALPHA = 1.702
MOE_BLOCK = 512

IN_SPLITS = (GLA_QK, GLA_QK, GLA_V, GLA_V, GLA_RANK, FOX_W, FOX_W, FOX_W, FOX_HEADS, D_MODEL, D_MODEL)
IN_COLS = sum(IN_SPLITS)

kernel_name = 'hybrid_gla_fox_memory_moe_block'


def rms_norm(x, g):
    xf = x.astype(jnp.float32)
    y = xf * lax.rsqrt(jnp.mean(xf * xf, axis=-1, keepdims=True) + EPS)
    return (y * g.astype(jnp.float32)).astype(x.dtype)


def split_points(sizes):
    pts, acc = [], 0
    for s in sizes[:-1]:
        acc += s
        pts.append(acc)
    return pts


def to_heads(t, n):
    b, s, w = t.shape
    return t.reshape(b, s, n, w // n).transpose(0, 2, 1, 3)


def from_heads(t):
    b, n, s, d = t.shape
    return t.transpose(0, 2, 1, 3).reshape(b, s, n * d)


def gla_chunked(q, k, v, log_a):
    B, H, S, DK = q.shape
    DV = v.shape[-1]
    C = GLA_CHUNK
    NC = S // C

    def to_chunks(t):
        return jnp.moveaxis(t.reshape(B, H, NC, C, t.shape[-1]), 2, 0)

    xs = tuple(to_chunks(t) for t in (q, k, v, log_a))
    causal = jnp.tril(jnp.ones((C, C), dtype=bool))

    def step(state, inp):
        qi, ki, vi, gi = (t.astype(jnp.float32) for t in inp)
        b = jnp.cumsum(gi, axis=-2)
        o_inter = jnp.einsum('bhtk,bhkv->bhtv', qi * jnp.exp(b), state)
        rel = b[:, :, :, None, :] - b[:, :, None, :, :]
        decay = jnp.exp(jnp.where(causal[:, :, None], rel, -jnp.inf))
        scores = jnp.einsum('bhtk,bhsk,bhtsk->bhts', qi, ki, decay)
        o_intra = jnp.einsum('bhts,bhsv->bhtv', scores, vi)
        b_last = b[:, :, -1:, :]
        new_state = jnp.exp(b_last[:, :, 0, :])[..., None] * state + jnp.einsum(
            'bhsk,bhsv->bhkv', ki * jnp.exp(b_last - b), vi)
        return new_state, o_inter + o_intra

    state0 = jnp.zeros((B, H, DK, DV), jnp.float32)
    _, o = lax.scan(step, state0, xs)
    return jnp.moveaxis(o, 0, 2).reshape(B, H, S, DV).astype(v.dtype)


def forgetting_attention(q, k, v, log_f):
    B, H, S, D = q.shape
    c = jnp.cumsum(log_f, axis=-1)
    scale = D ** -0.5
    outs = []
    for i in range(S // FOX_BLOCK):
        lo, hi = i * FOX_BLOCK, (i + 1) * FOX_BLOCK
        logits = jnp.einsum('bhqd,bhkd->bhqk', q[:, :, lo:hi], k[:, :, :hi]).astype(jnp.float32) * scale
        logits = logits + (c[:, :, lo:hi, None] - c[:, :, None, :hi])
        mask = (lo + jnp.arange(FOX_BLOCK))[:, None] >= jnp.arange(hi)[None, :]
        p = jax.nn.softmax(jnp.where(mask, logits, -jnp.inf), axis=-1)
        outs.append(jnp.einsum('bhqk,bhkd->bhqd', p.astype(v.dtype), v[:, :, :hi]))
    return jnp.concatenate(outs, axis=2)


def mixer_block(x, mix_norm_g, w_in, gla_alpha_up, gla_alpha_bias, gla_out_norm_g,
                fox_f_bias, fox_q_norm_g, fox_k_norm_g, w_branch_gla, w_branch_fox, w_out):
    h = rms_norm(x, mix_norm_g)
    proj = h @ w_in
    (gq, gk, gv, gr, ga, fq, fk, fv, ff, gate_gla, gate_fox) = jnp.split(
        proj, split_points(IN_SPLITS), axis=-1)

    q = to_heads(gq, GLA_HEADS) * (GLA_DK ** -0.5)
    k = to_heads(gk, GLA_HEADS)
    v = to_heads(gv, GLA_HEADS)
    log_a = jax.nn.log_sigmoid((ga @ gla_alpha_up + gla_alpha_bias).astype(jnp.float32)) / GLA_GATE_NORM
    o = gla_chunked(q, k, v, to_heads(log_a, GLA_HEADS))
    o = from_heads(rms_norm(o, gla_out_norm_g)) * jax.nn.silu(gr)
    y_gla = o @ w_branch_gla

    fq_h = rms_norm(to_heads(fq, FOX_HEADS), fox_q_norm_g)
    fk_h = rms_norm(to_heads(fk, FOX_HEADS), fox_k_norm_g)
    fv_h = to_heads(fv, FOX_HEADS)
    log_f = jax.nn.log_sigmoid((ff + fox_f_bias).astype(jnp.float32)).transpose(0, 2, 1)
    y_fox = from_heads(forgetting_attention(fq_h, fk_h, fv_h, log_f)) @ w_branch_fox

    merged = jax.nn.sigmoid(gate_gla) * y_gla + jax.nn.sigmoid(gate_fox) * y_fox
    return x + merged @ w_out


def memory_block(x, mem, mem_norm_g, mem_kv_norm_g, mem_w_q, mem_w_kv,
                 mem_q_norm_g, mem_k_norm_g, mem_w_o):
    h = rms_norm(x, mem_norm_g)
    mn = rms_norm(mem, mem_kv_norm_g)
    q = rms_norm(to_heads(h @ mem_w_q, MEM_HEADS), mem_q_norm_g)
    kv = mn @ mem_w_kv
    k = rms_norm(to_heads(kv[..., :MEM_W], MEM_HEADS), mem_k_norm_g)
    v = to_heads(kv[..., MEM_W:], MEM_HEADS)
    logits = jnp.einsum('bhqd,bhkd->bhqk', q, k).astype(jnp.float32) * (MEM_DH ** -0.5)
    p = jax.nn.softmax(logits, axis=-1)
    o = jnp.einsum('bhqk,bhkd->bhqd', p.astype(v.dtype), v)
    return x + from_heads(o) @ mem_w_o


def moe_block(x, moe_norm_g, w_router, b_router, w_expert_up, b_expert_up,
              w_expert_down, b_expert_down):
    B, S, D = x.shape
    T = B * S
    A = T * TOP_K
    xs = rms_norm(x, moe_norm_g).reshape(T, D)
    logits = (xs @ w_router).astype(jnp.float32) + b_router.astype(jnp.float32)
    top_vals, top_idx = lax.top_k(logits, TOP_K)
    gates = jax.nn.softmax(top_vals, axis=-1)

    flat_e = top_idx.reshape(A)
    order = jnp.argsort(flat_e)
    sorted_e = flat_e[order]
    tok = (order // TOP_K).astype(jnp.int32)
    w_assign = gates.reshape(A)[order]
    counts = jnp.bincount(flat_e, length=N_EXPERTS)
    padded = (counts + MOE_BLOCK - 1) // MOE_BLOCK * MOE_BLOCK
    pend = jnp.cumsum(padded)
    pstart = pend - padded
    ustart = jnp.cumsum(counts) - counts
    slot = pstart[sorted_e] + (jnp.arange(A) - ustart[sorted_e])
    NB = (A + MOE_BLOCK - 1) // MOE_BLOCK + N_EXPERTS
    P = NB * MOE_BLOCK
    slot_tok = jnp.zeros((P,), jnp.int32).at[slot].set(tok)
    slot_w = jnp.zeros((P,), jnp.float32).at[slot].set(w_assign)
    block_e = jnp.minimum(jnp.searchsorted(pend, jnp.arange(NB) * MOE_BLOCK, side='right'), N_EXPERTS - 1)

    def expert_rows(args):
        idx, wts, e = args
        xb = xs[idx]
        gu = xb @ w_expert_up[e] + b_expert_up[e]
        glu = jnp.minimum(gu[:, :D_FF], SWIGLU_LIMIT)
        lin = jnp.clip(gu[:, D_FF:], -SWIGLU_LIMIT, SWIGLU_LIMIT)
        act = glu * jax.nn.sigmoid(SWIGLU_ALPHA * glu) * (lin + 1.0)
        y = act @ w_expert_down[e] + b_expert_down[e]
        return y * wts.astype(y.dtype)[:, None]

    y_blocks = lax.map(expert_rows, (slot_tok.reshape(NB, MOE_BLOCK), slot_w.reshape(NB, MOE_BLOCK), block_e))
    out = jax.ops.segment_sum(y_blocks.reshape(P, D), slot_tok, num_segments=T)
    return x + out.reshape(B, S, D).astype(x.dtype)


def setup_inputs(seed: int = 0) -> dict:
    key = jax.random.key(seed)
    ks = jax.random.split(key, 32)
    L = DEPTH

    def dense(k, shape, fan_in):
        return jax.random.normal(k, shape, jnp.float32) * (fan_in ** -0.5)

    def gain(k, shape):
        return 1.0 + 0.02 * jax.random.normal(k, shape, jnp.float32)

    def small(k, shape, s):
        return s * jax.random.normal(k, shape, jnp.float32)

    return {
        'x': jax.random.normal(ks[0], (BATCH, SEQ, D_MODEL), jnp.float32),
        'mem': jax.random.normal(ks[1], (BATCH, MEM_LEN, D_MODEL), jnp.float32),
        'mix_norm_g': gain(ks[2], (L, D_MODEL)),
        'w_in': dense(ks[3], (L, D_MODEL, IN_COLS), D_MODEL),
        'gla_alpha_up': dense(ks[4], (L, GLA_RANK, GLA_QK), GLA_RANK),
        'gla_alpha_bias': small(ks[5], (L, GLA_QK), 0.1),
        'gla_out_norm_g': gain(ks[6], (L, GLA_DV)),
        'fox_f_bias': 2.0 + small(ks[7], (L, FOX_HEADS), 0.5),
        'fox_q_norm_g': gain(ks[8], (L, FOX_DH)),
        'fox_k_norm_g': gain(ks[9], (L, FOX_DH)),
        'w_branch_gla': dense(ks[10], (L, GLA_V, D_MODEL), GLA_V),
        'w_branch_fox': dense(ks[11], (L, FOX_W, D_MODEL), FOX_W),
        'w_out': dense(ks[12], (L, D_MODEL, D_MODEL), D_MODEL),
        'mem_norm_g': gain(ks[13], (L, D_MODEL)),
        'mem_kv_norm_g': gain(ks[14], (L, D_MODEL)),
        'mem_w_q': dense(ks[15], (L, D_MODEL, MEM_W), D_MODEL),
        'mem_w_kv': dense(ks[16], (L, D_MODEL, 2 * MEM_W), D_MODEL),
        'mem_q_norm_g': gain(ks[17], (L, MEM_DH)),
        'mem_k_norm_g': gain(ks[18], (L, MEM_DH)),
        'mem_w_o': dense(ks[19], (L, MEM_W, D_MODEL), MEM_W),
        'moe_norm_g': gain(ks[20], (L, D_MODEL)),
        'w_router': dense(ks[21], (L, D_MODEL, N_EXPERTS), D_MODEL),
        'b_router': small(ks[22], (L, N_EXPERTS), 0.01),
        'w_expert_up': dense(ks[23], (L, N_EXPERTS, D_MODEL, 2 * D_FF), D_MODEL),
        'b_expert_up': small(ks[24], (L, N_EXPERTS, 2 * D_FF), 0.02),
        'w_expert_down': dense(ks[25], (L, N_EXPERTS, D_FF, D_MODEL), D_FF),
        'b_expert_down': small(ks[26], (L, N_EXPERTS, D_MODEL), 0.02),
    }


def reference(x, mem, mix_norm_g, w_in, gla_alpha_up, gla_alpha_bias, gla_out_norm_g,
              fox_f_bias, fox_q_norm_g, fox_k_norm_g, w_branch_gla, w_branch_fox, w_out,
              mem_norm_g, mem_kv_norm_g, mem_w_q, mem_w_kv, mem_q_norm_g, mem_k_norm_g, mem_w_o,
              moe_norm_g, w_router, b_router, w_expert_up, b_expert_up, w_expert_down, b_expert_down):
    for l in range(DEPTH):
        x = mixer_block(x, mix_norm_g[l], w_in[l], gla_alpha_up[l], gla_alpha_bias[l], gla_out_norm_g[l],
                        fox_f_bias[l], fox_q_norm_g[l], fox_k_norm_g[l], w_branch_gla[l], w_branch_fox[l], w_out[l])
        x = memory_block(x, mem, mem_norm_g[l], mem_kv_norm_g[l], mem_w_q[l], mem_w_kv[l],
                         mem_q_norm_g[l], mem_k_norm_g[l], mem_w_o[l])
        x = moe_block(x, moe_norm_g[l], w_router[l], b_router[l], w_expert_up[l], b_expert_up[l],
                      w_expert_down[l], b_expert_down[l])
    return x
```

```cpp
#include <hip/hip_runtime.h>
#include <cstdio>
#include <cstdint>

#define GAS __attribute__((address_space(1)))
#define LAS __attribute__((address_space(3)))
typedef unsigned short bf16;
typedef unsigned v4u __attribute__((ext_vector_type(4)));
typedef unsigned v2u __attribute__((ext_vector_type(2)));
typedef float f32x4 __attribute__((ext_vector_type(4)));
typedef float f32x2 __attribute__((ext_vector_type(2)));
typedef short bf16x8 __attribute__((ext_vector_type(8)));

constexpr int T = 16384, DM = 2048, NB = 4, SEQ = 4096, MEML = 256;
constexpr float EPS = 1e-6f;
constexpr int INC = 16416, INCP = 16640;
constexpr int C_GQ = 0, C_GK = 1024, C_GV = 2048, C_GR = 4096, C_GA = 6144, C_FQ = 6160, C_FK = 8208, C_FV = 10256, C_FF = 12304, C_GG = 12320, C_GF = 14368;
constexpr int NE = 32, TOPK = 4, NASG = T * TOPK, PMAX = NASG + NE * 256;
constexpr int MAXRT = PMAX / 256;

__device__ __forceinline__ unsigned f2bf(float f) { unsigned u = __builtin_bit_cast(unsigned, f); return (u + 0x7fffu + ((u >> 16) & 1u)) >> 16; }
__device__ __forceinline__ unsigned pk2(float lo, float hi) { unsigned r; asm("v_cvt_pk_bf16_f32 %0, %1, %2" : "=v"(r) : "v"(lo), "v"(hi)); return r; }
__device__ __forceinline__ float bf2f(unsigned b) { return __builtin_bit_cast(float, b << 16); }
__device__ __forceinline__ float wave_sum(float v) {
#pragma unroll
    for (int o = 1; o < 64; o <<= 1) v += __shfl_xor(v, o);
    return v;
}
__device__ __forceinline__ float sigmoid_f(float x) { return __builtin_amdgcn_rcpf(1.0f + __expf(-x)); }
__device__ __forceinline__ float log_sigmoid_f(float x) { return fminf(x, 0.f) - __logf(1.0f + __expf(-fabsf(x))); }
#define LDS_WAIT() asm volatile("s_waitcnt lgkmcnt(0)" ::: "memory")
#define VM_WAIT() asm volatile("s_waitcnt vmcnt(0)" ::: "memory")
#define XB_TMO      128
#define XB_XCNT(j)  (256  + 64 * (j))
#define XB_XSUB(j)  (1280 + 64 * (j))
#define XB_XGEN(j)  (2304 + 64 * (j))
#define XB_TOP      3328
#define XB_TOPGEN   3392
#define XCD_BAR_WORDS 3456
#define XB_SPIN_CAP (1u << 18)

__device__ __forceinline__ unsigned xb_ld(unsigned* p)              { return __hip_atomic_load(p, __ATOMIC_RELAXED, __HIP_MEMORY_SCOPE_AGENT); }
__device__ __forceinline__ unsigned xb_add(unsigned* p, unsigned v) { return __hip_atomic_fetch_add(p, v, __ATOMIC_RELAXED, __HIP_MEMORY_SCOPE_AGENT); }
__device__ __forceinline__ unsigned xb_xcc_id() { return (unsigned)__builtin_amdgcn_s_getreg((3 << 11) | 20) & 0xFu; }
#define XB_SPIN(cond, bar) do { unsigned _sp = 0; while (cond) { __builtin_amdgcn_s_sleep(1); \
    if ((++_sp & 255u) == 0u) { if (xb_ld(&(bar)[XB_TMO])) break; if (_sp > XB_SPIN_CAP) { atomicAdd(&(bar)[XB_TMO], 1u); break; } } } } while (0)

struct XcdBarrier {
    unsigned* bar; unsigned x;
    volatile LAS unsigned* st;
};
__device__ __forceinline__ XcdBarrier xcd_barrier_post(unsigned* bar, volatile LAS unsigned* st) {
    XcdBarrier b; b.bar = bar; b.x = xb_xcc_id(); b.st = st;
    if (threadIdx.x == 0) (void)xb_add(&bar[XB_XCNT(b.x)], 1u);
    return b;
}
__device__ __forceinline__ void xcd_barrier_complete(unsigned* bar, unsigned x, unsigned& nloc, unsigned& nx) {
    const unsigned G = gridDim.x * gridDim.y * gridDim.z;
    unsigned sum, cnt, mine, sp = 0u;
    for (;;) {
        sum = 0u; cnt = 0u; mine = 0u;
#pragma unroll
        for (unsigned j = 0; j < 16; ++j) { const unsigned c = xb_ld(&bar[XB_XCNT(j)]); sum += c; cnt += (c > 0u) ? 1u : 0u; mine = (j == x) ? c : mine; }
        if (sum == G) break;
        __builtin_amdgcn_s_sleep(1);
        if ((++sp & 255u) == 0u) { if (xb_ld(&bar[XB_TMO])) break; if (sp > XB_SPIN_CAP) { atomicAdd(&bar[XB_TMO], 1u); break; } }
    }
    nloc = mine > 0u ? mine : 1u; nx = cnt > 0u ? cnt : 1u;
}
__device__ __forceinline__ void xcd_barrier(const XcdBarrier& b) {
    asm volatile("s_waitcnt vmcnt(0)" ::: "memory");
    __syncthreads();
    if (threadIdx.x == 0) {
        unsigned* bar = b.bar;
        __builtin_amdgcn_s_waitcnt(0);
        unsigned nloc = b.st[0], nx = b.st[1];
        if (nloc == 0u) { xcd_barrier_complete(bar, b.x, nloc, nx); b.st[0] = nloc; b.st[1] = nx; }
        const unsigned old = xb_add(&bar[XB_XSUB(b.x)], 1u);
        const unsigned gen = old / nloc;
        if (old + 1u == (gen + 1u) * nloc) {
            __builtin_amdgcn_fence(__ATOMIC_RELEASE, "agent");
            asm volatile("s_waitcnt vmcnt(0)" ::: "memory");
            const unsigned og = xb_add(&bar[XB_TOP], 1u);
            const unsigned tg = og / nx;
            if (og + 1u == (tg + 1u) * nx) xb_add(&bar[XB_TOPGEN], 1u);
            else XB_SPIN(xb_ld(&bar[XB_TOPGEN]) == tg, bar);
            __builtin_amdgcn_fence(__ATOMIC_ACQUIRE, "agent");
            xb_add(&bar[XB_XGEN(b.x)], 1u);
            asm volatile("s_waitcnt vmcnt(0)" ::: "memory");
        } else {
            XB_SPIN(xb_ld(&bar[XB_XGEN(b.x)]) == gen, bar);
            __builtin_amdgcn_fence(__ATOMIC_ACQUIRE, "agent");
            asm volatile("s_waitcnt vmcnt(0)" ::: "memory");
        }
    }
    __syncthreads();
}
namespace pg8 {
#define PG8_LAS __attribute__((address_space(3)))
typedef unsigned short bf16_t;
typedef short bf16x8 __attribute__((ext_vector_type(8)));
typedef float f32x4 __attribute__((ext_vector_type(4)));
typedef unsigned u32x4 __attribute__((ext_vector_type(4)));
constexpr int BM = 256, BK = 64, HALF = 128, HTB = HALF * BK * 2  , STAGE_BYTES = 8 * HTB, NXCD = 8, WGM = 8;

__host__ __device__ __forceinline__ int lds_byte(int r, int c) { const int st = (r >> 4) * 2 + (c >> 5), rr = r & 15, cc = c & 31, ob = rr * 64 + cc * 2; return st * 1024 + (ob ^ (((ob >> 9) & 1) << 5)); }
__host__ __device__ __forceinline__ void stage_rc(int b, int& R, int& C) { const int st = b / 1024, sb = b % 1024, swz = sb ^ (((sb >> 9) & 1) << 5); R = (st >> 1) * 16 + swz / 64; C = (st & 1) * 32 + (swz % 64) / 2; }
__host__ __device__ __forceinline__ int perm32(int rho) { const int n = rho >> 4, i = rho & 15; return 8 * (i >> 2) + 4 * n + (i & 3); }

struct Unit { int pm, pn, pb, kofs, sb; };
struct Gemm { const bf16_t* A; const bf16_t* Bt; int M, N, K, ld; };

struct StaticOrder {
    int nM, nN, nwg, G, c, i0 = 0, iend = 1 << 30;
    __host__ __device__ void init(int M, int N, int G_, int c_) { nM = M / BM; nN = N / BM; nwg = nM * nN; G = G_; c = c_; }
    __host__ __device__ bool next(int i, Unit& u) const {
        if (i + i0 >= iend) return false;
        const long L = (long)(i + i0) * G + c; if (L >= nwg) return false;
        int wgid = (int)L; { const int q = nwg / NXCD, r = nwg % NXCD, xcd = wgid % NXCD, off = wgid / NXCD; wgid = (xcd < r ? xcd * (q + 1) : r * (q + 1) + (xcd - r) * q) + off; }
        const int nig = WGM * nN, gid = wgid / nig, fm = gid * WGM, gsz = (nM - fm) < WGM ? (nM - fm) : WGM;
        u.pm = fm + ((wgid % nig) % gsz); u.pn = (wgid % nig) / gsz; u.pb = u.pn; u.kofs = 0; return true;
    }
    static constexpr bool SIDE = false;
    __device__ __forceinline__ void prefetch(const Unit&, int, int, int) const {}
    __device__ __forceinline__ void a_ready(const Unit&) const {}
    __device__ __forceinline__ void done(const Unit&) const {}
};

struct SplitOrder {
    int nM, nN, nS, Ks, G, c;
    __host__ __device__ bool next(int i, Unit& u) const {
        const long L = (long)i * G + c; if (L >= (long)nM * nN * nS) return false;
        const int s = (int)(L % nS), r = (int)(L / nS); u.pm = r / nN; const int pn = r % nN; u.pn = s * nN + pn; u.pb = pn; u.kofs = s * Ks; return true;
    }
    static constexpr bool SIDE = false;
    __device__ __forceinline__ void prefetch(const Unit&, int, int, int) const {}
    __device__ __forceinline__ void a_ready(const Unit&) const {}
    __device__ __forceinline__ void done(const Unit&) const {}
};

__device__ __forceinline__ unsigned cvt_pk_bf16(float lo, float hi) { unsigned r; asm volatile("v_cvt_pk_bf16_f32 %0, %1, %2" : "=v"(r) : "v"(lo), "v"(hi)); return r; }

struct EpiF32 {
    static constexpr bool PERM = false;
    float* C; int ldc; const float* bias;
    __device__ __forceinline__ void operator()(const f32x4 (&acc)[2][2][4][2], const Unit& u, int wr, int wc, int fr, int fq) const {
        const int row0 = u.pm * BM + wr * 64 + fr, col0 = u.pn * BM + wc * 32 + 4 * fq;
        f32x4 bv[2][2];
#pragma unroll
        for (int bj = 0; bj < 2; ++bj)
#pragma unroll
            for (int n = 0; n < 2; ++n) bv[bj][n] = bias ? *(const f32x4*)(bias + col0 + bj * HALF + n * 16) : (f32x4){0.f, 0.f, 0.f, 0.f};
#pragma unroll
        for (int ai = 0; ai < 2; ++ai)
#pragma unroll
            for (int m = 0; m < 4; ++m) { float* rowp = C + (size_t)(row0 + ai * HALF + m * 16) * ldc + col0;
#pragma unroll
                for (int bj = 0; bj < 2; ++bj)
#pragma unroll
                    for (int n = 0; n < 2; ++n) *(f32x4*)(rowp + bj * HALF + n * 16) = acc[ai][bj][m][n] + bv[bj][n]; }
    }
};

struct EpiN32 {
    static constexpr bool PERM = false;
    float* C; int ldc;
    __device__ __forceinline__ void operator()(const f32x4 (&acc)[2][2][4][2], const Unit& u, int wr, int wc, int fr, int fq) const {
        if (wc != 0) return;
        const int row0 = u.pm * BM + wr * 64 + fr;
#pragma unroll
        for (int ai = 0; ai < 2; ++ai)
#pragma unroll
            for (int m = 0; m < 4; ++m) { float* rowp = C + (size_t)(row0 + ai * HALF + m * 16) * ldc + 32 * u.pn + 4 * fq;
                *(f32x4*)rowp = acc[ai][0][m][0]; *(f32x4*)(rowp + 16) = acc[ai][0][m][1]; }
    }
};

template <class Epi, class Sched>
__device__ __forceinline__ void gemm_phase(PG8_LAS unsigned char* lds, const Gemm g, const Sched& S, const Epi& E) {
    const int tid = threadIdx.x, wid = __builtin_amdgcn_readfirstlane(tid >> 6), lane = tid & 63, wr = wid >> 2, wc = wid & 3, fr = lane & 15, fq = lane >> 4;
    const int K = g.K, nt = K / BK, LD = g.ld ? g.ld : g.K;
    unsigned voffA[2], voffB[2];
#pragma unroll
    for (int i = 0; i < 2; ++i) { int R, C; stage_rc(tid * 16 + i * 8192, R, C); const int Rb = Epi::PERM ? ((R & ~31) + perm32(R & 31)) : R;
        voffA[i] = (unsigned)(R * LD + C) * 2u; voffB[i] = (unsigned)(Rb * LD + C) * 2u; }
    const size_t kstep = (size_t)(BK * 2);
    const size_t hstep = (size_t)HALF * LD * 2;
    const size_t tstep = 2 * hstep;
    const unsigned ldsw = (unsigned)wid * 1024u;
    const int aoff = lds_byte(wr * 64 + fr, fq * 8), boff = lds_byte(wc * 32 + fr, fq * 8);
#define PG8_SA(b, h) (((b) * 2 + (h)) * HTB)
#define PG8_SB(b, h) ((4 + (b) * 2 + (h)) * HTB)
#define PG8_STAGE(bufoff, gbase, voff) do { _Pragma("unroll") for (int _i = 0; _i < 2; ++_i) \
        __builtin_amdgcn_global_load_lds((const unsigned*)((const char*)(gbase) + (voff)[_i]), (PG8_LAS unsigned*)(lds + (bufoff) + ldsw + _i * 8192), 16, 0, 0); } while (0)
#define PG8_LDA(dst, b, h) do { _Pragma("unroll") for (int m = 0; m < 4; ++m) _Pragma("unroll") for (int k = 0; k < 2; ++k) dst[m][k] = *(const PG8_LAS bf16x8*)(lds + PG8_SA(b, h) + aoff + m * 2048 + k * 1024); } while (0)
#define PG8_LDB(dst, b, h) do { _Pragma("unroll") for (int n = 0; n < 2; ++n) _Pragma("unroll") for (int k = 0; k < 2; ++k) dst[n][k] = *(const PG8_LAS bf16x8*)(lds + PG8_SB(b, h) + boff + n * 2048 + k * 1024); } while (0)
#define PG8_MMA(ai, bj, At, Bt) do { __builtin_amdgcn_s_setprio(1); _Pragma("unroll") for (int m = 0; m < 4; ++m) _Pragma("unroll") for (int n = 0; n < 2; ++n) _Pragma("unroll") for (int k = 0; k < 2; ++k) \
        acc[ai][bj][m][n] = __builtin_amdgcn_mfma_f32_16x16x32_bf16(Bt[n][k], At[m][k], acc[ai][bj][m][n], 0, 0, 0); __builtin_amdgcn_s_setprio(0); } while (0)
#define PG8_WAIT_V(n) asm volatile("s_waitcnt vmcnt(" #n ")" ::: "memory")
#define PG8_WAIT_L(n) asm volatile("s_waitcnt lgkmcnt(" #n ")" ::: "memory")
#define PG8_BAR __builtin_amdgcn_s_barrier()
#define PG8_SCHED __builtin_amdgcn_sched_barrier(0)
    Unit cur, nxt; int ui = 0;
    if (!S.next(0, cur)) return;
    f32x4 acc[2][2][4][2];
#pragma unroll
    for (int a = 0; a < 2; ++a)
#pragma unroll
        for (int b = 0; b < 2; ++b)
#pragma unroll
            for (int m = 0; m < 4; ++m)
#pragma unroll
                for (int n = 0; n < 2; ++n) acc[a][b][m][n] = (f32x4){0.f, 0.f, 0.f, 0.f};
    bf16x8 At[4][2], B0[2][2], B1[2][2];
    const char* cA = (const char*)g.A + (size_t)cur.pm * tstep + (size_t)cur.kofs * 2; const char* cB = (const char*)g.Bt + (size_t)cur.pb * tstep + (size_t)cur.kofs * 2;
    S.a_ready(cur); cur.sb = 0;
    if constexpr (Sched::SIDE) S.prefetch(cur, 0, wid, lane);
    PG8_STAGE(PG8_SB(0, 0), cB, voffB); PG8_STAGE(PG8_SA(0, 0), cA, voffA); PG8_STAGE(PG8_SB(0, 1), cB + hstep, voffB); PG8_STAGE(PG8_SA(0, 1), cA + hstep, voffA);
    if (wr == 1) PG8_BAR;
    PG8_WAIT_V(4); PG8_BAR;
    PG8_STAGE(PG8_SB(1, 0), cB + kstep, voffB); PG8_STAGE(PG8_SA(1, 0), cA + kstep, voffA); PG8_STAGE(PG8_SB(1, 1), cB + hstep + kstep, voffB);
    PG8_WAIT_V(6); PG8_BAR;
    for (;;) {
        const bool has_next = S.next(ui + 1, nxt); nxt.sb = cur.sb == 2 ? 0 : cur.sb + 1;
        if constexpr (Sched::SIDE) { if (has_next) S.prefetch(nxt, nxt.sb, wid, lane); }
        const char* nA = has_next ? (const char*)g.A + (size_t)nxt.pm * tstep + (size_t)nxt.kofs * 2 : cA; const char* nB = has_next ? (const char*)g.Bt + (size_t)nxt.pb * tstep + (size_t)nxt.kofs * 2 : cB;
        for (int t = 0; t < nt; t += 2) {
            const bool last = (t == nt - 2);
            const char* a1 = cA + (size_t)(t + 1) * kstep;
            const char* a2 = last ? nA : cA + (size_t)(t + 2) * kstep; const char* b2 = last ? nB : cB + (size_t)(t + 2) * kstep;
            const char* a3 = a2 + kstep; const char* b3 = b2 + kstep;
            if (last && has_next) S.a_ready(nxt);
            PG8_LDB(B0, 0, 0); PG8_SCHED; PG8_LDA(At, 0, 0); PG8_STAGE(PG8_SA(1, 1), a1 + hstep, voffA);
            PG8_WAIT_L(8); PG8_BAR; PG8_WAIT_L(0); PG8_MMA(0, 0, At, B0); PG8_BAR; PG8_SCHED;
            PG8_LDB(B1, 0, 1); PG8_STAGE(PG8_SB(0, 0), b2, voffB);
            PG8_BAR; PG8_WAIT_L(0); PG8_MMA(0, 1, At, B1); PG8_BAR;
            PG8_LDA(At, 0, 1); PG8_STAGE(PG8_SA(0, 0), a2, voffA);
            PG8_BAR; PG8_WAIT_L(0); PG8_MMA(1, 0, At, B0); PG8_BAR; PG8_SCHED;
            PG8_STAGE(PG8_SB(0, 1), b2 + hstep, voffB);
            PG8_WAIT_V(6); PG8_BAR; PG8_MMA(1, 1, At, B1); PG8_BAR;
            PG8_LDB(B0, 1, 0); PG8_SCHED; PG8_LDA(At, 1, 0); PG8_STAGE(PG8_SA(0, 1), a2 + hstep, voffA);
            PG8_WAIT_L(8); PG8_BAR; PG8_WAIT_L(0); PG8_MMA(0, 0, At, B0); PG8_BAR; PG8_SCHED;
            PG8_LDB(B1, 1, 1); PG8_STAGE(PG8_SB(1, 0), b3, voffB);
            PG8_BAR; PG8_WAIT_L(0); PG8_MMA(0, 1, At, B1); PG8_BAR;
            PG8_LDA(At, 1, 1); PG8_STAGE(PG8_SA(1, 0), a3, voffA);
            PG8_BAR; PG8_WAIT_L(0); PG8_MMA(1, 0, At, B0); PG8_BAR; PG8_SCHED;
            PG8_STAGE(PG8_SB(1, 1), b3 + hstep, voffB);
            PG8_WAIT_V(6); PG8_BAR; PG8_MMA(1, 1, At, B1); PG8_BAR;
        }
        E(acc, cur, wr, wc, fr, fq); S.done(cur);
        if (!has_next) break;
#pragma unroll
        for (int a = 0; a < 2; ++a)
#pragma unroll
            for (int b = 0; b < 2; ++b)
#pragma unroll
                for (int m = 0; m < 4; ++m)
#pragma unroll
                    for (int n = 0; n < 2; ++n) acc[a][b][m][n] = (f32x4){0.f, 0.f, 0.f, 0.f};
        cur = nxt; cA = nA; cB = nB; ++ui;
    }
    PG8_WAIT_V(0);
    if (wr == 0) PG8_BAR;
    PG8_BAR;
#undef PG8_SA
#undef PG8_SB
#undef PG8_STAGE
#undef PG8_LDA
#undef PG8_LDB
#undef PG8_MMA
#undef PG8_WAIT_V
#undef PG8_WAIT_L
#undef PG8_BAR
#undef PG8_SCHED
}
template <class Epi, class Sched>
__device__ __forceinline__ void gemm_phase_gather(PG8_LAS unsigned char* lds, const Gemm g, const Sched& S, const Epi& E) {
    const int tid = threadIdx.x, wid = __builtin_amdgcn_readfirstlane(tid >> 6), lane = tid & 63, wr = wid >> 2, wc = wid & 3, fr = lane & 15, fq = lane >> 4;
    const int K = g.K, nt = K / BK;
    unsigned voffB[2]; int RA[2], CA[2];
#pragma unroll
    for (int i = 0; i < 2; ++i) { int R, C; stage_rc(tid * 16 + i * 8192, R, C); const int Rb = Epi::PERM ? ((R & ~31) + perm32(R & 31)) : R;
        RA[i] = R; CA[i] = C * 2; voffB[i] = (unsigned)(Rb * K + C) * 2u; }
    unsigned va0[2], va1[2], vn0[2], vn1[2];
#define PG8_ROWS(u_, d0, d1) do { const PG8_LAS int* tk_ = S.tok_table((u_).sb); _Pragma("unroll") for (int _i = 0; _i < 2; ++_i) { d0[_i] = (unsigned)tk_[RA[_i]] * (unsigned)(K * 2) + (unsigned)CA[_i]; d1[_i] = (unsigned)tk_[HALF + RA[_i]] * (unsigned)(K * 2) + (unsigned)CA[_i]; } } while (0)
    const size_t kstep = (size_t)(BK * 2);
    const size_t hstep = (size_t)HALF * K * 2;
    const size_t tstep = 2 * hstep;
    const unsigned ldsw = (unsigned)wid * 1024u;
    const int aoff = lds_byte(wr * 64 + fr, fq * 8), boff = lds_byte(wc * 32 + fr, fq * 8);
#define PG8_SA(b, h) (((b) * 2 + (h)) * HTB)
#define PG8_SB(b, h) ((4 + (b) * 2 + (h)) * HTB)
#define PG8_STAGE(bufoff, gbase, voff) do { _Pragma("unroll") for (int _i = 0; _i < 2; ++_i) \
        __builtin_amdgcn_global_load_lds((const unsigned*)((const char*)(gbase) + (voff)[_i]), (PG8_LAS unsigned*)(lds + (bufoff) + ldsw + _i * 8192), 16, 0, 0); } while (0)
#define PG8_LDA(dst, b, h) do { _Pragma("unroll") for (int m = 0; m < 4; ++m) _Pragma("unroll") for (int k = 0; k < 2; ++k) dst[m][k] = *(const PG8_LAS bf16x8*)(lds + PG8_SA(b, h) + aoff + m * 2048 + k * 1024); } while (0)
#define PG8_LDB(dst, b, h) do { _Pragma("unroll") for (int n = 0; n < 2; ++n) _Pragma("unroll") for (int k = 0; k < 2; ++k) dst[n][k] = *(const PG8_LAS bf16x8*)(lds + PG8_SB(b, h) + boff + n * 2048 + k * 1024); } while (0)
#define PG8_MMA(ai, bj, At, Bt) do { __builtin_amdgcn_s_setprio(1); _Pragma("unroll") for (int m = 0; m < 4; ++m) _Pragma("unroll") for (int n = 0; n < 2; ++n) _Pragma("unroll") for (int k = 0; k < 2; ++k) \
        acc[ai][bj][m][n] = __builtin_amdgcn_mfma_f32_16x16x32_bf16(Bt[n][k], At[m][k], acc[ai][bj][m][n], 0, 0, 0); __builtin_amdgcn_s_setprio(0); } while (0)
#define PG8_WAIT_V(n) asm volatile("s_waitcnt vmcnt(" #n ")" ::: "memory")
#define PG8_WAIT_L(n) asm volatile("s_waitcnt lgkmcnt(" #n ")" ::: "memory")
#define PG8_BAR __builtin_amdgcn_s_barrier()
#define PG8_SCHED __builtin_amdgcn_sched_barrier(0)
    Unit cur, nxt; int ui = 0;
    if (!S.next(0, cur)) return;
    f32x4 acc[2][2][4][2];
#pragma unroll
    for (int a = 0; a < 2; ++a)
#pragma unroll
        for (int b = 0; b < 2; ++b)
#pragma unroll
            for (int m = 0; m < 4; ++m)
#pragma unroll
                for (int n = 0; n < 2; ++n) acc[a][b][m][n] = (f32x4){0.f, 0.f, 0.f, 0.f};
    bf16x8 At[4][2], B0[2][2], B1[2][2];
    const char* cA = (const char*)g.A; const char* cB = (const char*)g.Bt + (size_t)cur.pb * tstep;
    S.a_ready(cur); cur.sb = 0;
    S.prefetch(cur, 0, wid, lane); PG8_WAIT_V(0); __syncthreads();
    PG8_ROWS(cur, va0, va1);
    PG8_STAGE(PG8_SB(0, 0), cB, voffB); PG8_STAGE(PG8_SA(0, 0), cA, va0); PG8_STAGE(PG8_SB(0, 1), cB + hstep, voffB); PG8_STAGE(PG8_SA(0, 1), cA, va1);
    if (wr == 1) PG8_BAR;
    PG8_WAIT_V(4); PG8_BAR;
    PG8_STAGE(PG8_SB(1, 0), cB + kstep, voffB); PG8_STAGE(PG8_SA(1, 0), cA + kstep, va0); PG8_STAGE(PG8_SB(1, 1), cB + hstep + kstep, voffB);
    PG8_WAIT_V(6); PG8_BAR;
    for (;;) {
        const bool has_next = S.next(ui + 1, nxt); nxt.sb = cur.sb == 2 ? 0 : cur.sb + 1;
        const char* nB = has_next ? (const char*)g.Bt + (size_t)nxt.pb * tstep : cB;
        if (has_next) S.prefetch(nxt, nxt.sb, wid, lane);
        for (int t = 0; t < nt; t += 2) {
            const bool last = (t == nt - 2);
            const char* a1 = cA + (size_t)(t + 1) * kstep;
            const char* a2 = last ? cA : cA + (size_t)(t + 2) * kstep; const char* b2 = last ? nB : cB + (size_t)(t + 2) * kstep;
            int tkr0[2], tkr1[2];
            { const PG8_LAS int* tk_ = S.tok_table(nxt.sb);
#pragma unroll
              for (int _i = 0; _i < 2; ++_i) { tkr0[_i] = tk_[RA[_i]]; tkr1[_i] = tk_[HALF + RA[_i]]; } }
            PG8_SCHED;
            const char* a3 = a2 + kstep; const char* b3 = b2 + kstep;
            if (last && has_next) S.a_ready(nxt);
            PG8_LDB(B0, 0, 0); PG8_SCHED; PG8_LDA(At, 0, 0); PG8_STAGE(PG8_SA(1, 1), a1, va1);
            PG8_WAIT_L(8); PG8_BAR; PG8_WAIT_L(0); PG8_MMA(0, 0, At, B0); PG8_BAR; PG8_SCHED;
            PG8_LDB(B1, 0, 1); PG8_STAGE(PG8_SB(0, 0), b2, voffB);
            PG8_BAR; PG8_WAIT_L(0); PG8_MMA(0, 1, At, B1); PG8_BAR;
            unsigned x0[2], x1[2];
#pragma unroll
            for (int _i = 0; _i < 2; ++_i) { vn0[_i] = has_next ? (unsigned)tkr0[_i] * (unsigned)(K * 2) + (unsigned)CA[_i] : va0[_i]; vn1[_i] = has_next ? (unsigned)tkr1[_i] * (unsigned)(K * 2) + (unsigned)CA[_i] : va1[_i];
                x0[_i] = last ? vn0[_i] : va0[_i]; x1[_i] = last ? vn1[_i] : va1[_i]; }
            PG8_SCHED;
            PG8_LDA(At, 0, 1); PG8_STAGE(PG8_SA(0, 0), a2, x0);
            PG8_BAR; PG8_WAIT_L(0); PG8_MMA(1, 0, At, B0); PG8_BAR; PG8_SCHED;
            PG8_STAGE(PG8_SB(0, 1), b2 + hstep, voffB);
            PG8_WAIT_V(6); PG8_BAR; PG8_MMA(1, 1, At, B1); PG8_BAR;
            PG8_LDB(B0, 1, 0); PG8_SCHED; PG8_LDA(At, 1, 0); PG8_STAGE(PG8_SA(0, 1), a2, x1);
            PG8_WAIT_L(8); PG8_BAR; PG8_WAIT_L(0); PG8_MMA(0, 0, At, B0); PG8_BAR; PG8_SCHED;
            PG8_LDB(B1, 1, 1); PG8_STAGE(PG8_SB(1, 0), b3, voffB);
            PG8_BAR; PG8_WAIT_L(0); PG8_MMA(0, 1, At, B1); PG8_BAR;
            PG8_LDA(At, 1, 1); PG8_STAGE(PG8_SA(1, 0), a3, x0);
            PG8_BAR; PG8_WAIT_L(0); PG8_MMA(1, 0, At, B0); PG8_BAR; PG8_SCHED;
            PG8_STAGE(PG8_SB(1, 1), b3 + hstep, voffB);
            PG8_WAIT_V(6); PG8_BAR; PG8_MMA(1, 1, At, B1); PG8_BAR;
        }
        E(acc, cur, wr, wc, fr, fq); S.done(cur);
        if (!has_next) break;
#pragma unroll
        for (int a = 0; a < 2; ++a)
#pragma unroll
            for (int b = 0; b < 2; ++b)
#pragma unroll
                for (int m = 0; m < 4; ++m)
#pragma unroll
                    for (int n = 0; n < 2; ++n) acc[a][b][m][n] = (f32x4){0.f, 0.f, 0.f, 0.f};
        cur = nxt; cB = nB; ++ui;
#pragma unroll
        for (int _i = 0; _i < 2; ++_i) { va0[_i] = vn0[_i]; va1[_i] = vn1[_i]; }
    }
    PG8_WAIT_V(0);
    if (wr == 0) PG8_BAR;
    PG8_BAR;
#undef PG8_ROWS
#undef PG8_SA
#undef PG8_SB
#undef PG8_STAGE
#undef PG8_LDA
#undef PG8_LDB
#undef PG8_MMA
#undef PG8_WAIT_V
#undef PG8_WAIT_L
#undef PG8_BAR
#undef PG8_SCHED
}
}
namespace fa {
constexpr float SCALE = 0.08838834764831845f;
constexpr float THR = 8.f;
constexpr int D = 128, NW = 8, QBLK = 32, KVBLK = 64, QB = NW * QBLK;
constexpr int SHM_V = KVBLK * D * 2, SHM_K = KVBLK * D * 2;
constexpr int OFF_WS = 2 * SHM_V + 2 * SHM_K, OFF_BIAS = OFF_WS + NW * 64 * 4, LDS_BYTES = OFF_BIAS + 2 * 256;
typedef short s16x4 __attribute__((ext_vector_type(4)));
typedef float f32x16 __attribute__((ext_vector_type(16)));
typedef unsigned u32x4 __attribute__((ext_vector_type(4)));

#define KSWZ(row, colB) ((row) * 256 + ((colB) ^ (((row) & 7) << 4)))
#define SBAR() __builtin_amdgcn_sched_barrier(0)
__device__ __forceinline__ int v_st(int k, int c) { const int kk = (k & ~0xC) | ((k & 4) << 1) | ((k & 8) >> 1); return ((kk >> 3) * 4 + (c >> 5)) * 512 + ((kk & 7) * 32 + (c & 31)) * 2; }
__device__ __forceinline__ int v_rd_base(int lane) { return ((lane & 3) << 3) | (((lane >> 2) & 3) << 6) | (((lane >> 4) & 1) << 5) | (((lane >> 5) & 1) << 8); }
constexpr int v_rd_off(int d0, int ks, int half) { return d0 * 512 + ks * 4096 + half * 2048; }
__device__ __forceinline__ int crow(int r, int hi) { return (r & 3) + 8 * (r >> 2) + 4 * hi; }
__device__ __forceinline__ unsigned cvtpk(float lo, float hi) { unsigned r; asm volatile("v_cvt_pk_bf16_f32 %0, %1, %2" : "=v"(r) : "v"(lo), "v"(hi)); return r; }
__device__ __forceinline__ bf16x8 load8(const bf16* p) { return *reinterpret_cast<const bf16x8*>(p); }
__device__ __forceinline__ void mask_tile(f32x16& p0, f32x16& p1, int dq, unsigned W) {
    const float NEG = -__builtin_inff();
#pragma unroll
    for (int r = 0; r < 16; ++r) {
        const int c = (r & 3) + 8 * (r >> 2);
        if ((unsigned)(dq - c) >= W) p0[r] = NEG;
        if ((unsigned)(dq - c - 32) >= W) p1[r] = NEG;
    }
}
__device__ __forceinline__ void partialSM(f32x16& p0, f32x16& p1, float& m_reg, float& mn, float& alpha) {
    float pmax = p0[0]; for (int r = 1; r < 16; ++r) pmax = fmaxf(pmax, p0[r]); for (int r = 0; r < 16; ++r) pmax = fmaxf(pmax, p1[r]);
    { auto rr = __builtin_amdgcn_permlane32_swap(__float_as_uint(pmax), __float_as_uint(pmax), false, false);
      pmax = fmaxf(__uint_as_float(rr[0]), __uint_as_float(rr[1])); }
    constexpr float C2 = 1.4426950408889634f * SCALE;
    if (__builtin_expect(__all((pmax - m_reg) * SCALE <= THR), 1)) { mn = m_reg; alpha = 1.f; }
    else { mn = fmaxf(m_reg, pmax); alpha = __builtin_amdgcn_exp2f((m_reg - mn) * C2); m_reg = mn; }
    const float mnL = -mn * C2;
    for (int r = 0; r < 16; ++r) p0[r] = fmaf(p0[r], C2, mnL); for (int r = 0; r < 16; ++r) p1[r] = fmaf(p1[r], C2, mnL);
    for (int r = 0; r < 16; ++r) p0[r] = __builtin_amdgcn_exp2f(p0[r]);
}
__device__ __forceinline__ void finishSM(f32x16& p0, f32x16& p1, float alpha, float& l_reg, bf16x8& pa0, bf16x8& pa1, bf16x8& pa2, bf16x8& pa3) {
    for (int r = 0; r < 16; ++r) p1[r] = __builtin_amdgcn_exp2f(p1[r]);
    float ps = 0; for (int r = 0; r < 16; ++r) ps += p0[r]; for (int r = 0; r < 16; ++r) ps += p1[r];
    { auto rr = __builtin_amdgcn_permlane32_swap(__float_as_uint(ps), __float_as_uint(ps), false, false);
      ps = __uint_as_float(rr[0]) + __uint_as_float(rr[1]); }
    l_reg = l_reg * alpha + ps;
#define PK4(P, B_, OUT) do { unsigned a0 = cvtpk(P[B_+0], P[B_+1]), a1 = cvtpk(P[B_+2], P[B_+3]);                          \
        unsigned b0 = cvtpk(P[B_+4], P[B_+5]), b1 = cvtpk(P[B_+6], P[B_+7]);                                             \
        auto r0 = __builtin_amdgcn_permlane32_swap(a0, b0, false, false); auto r1 = __builtin_amdgcn_permlane32_swap(a1, b1, false, false); \
        u32x4 w = {r0[0], r1[0], r0[1], r1[1]}; OUT = *reinterpret_cast<bf16x8*>(&w); } while (0)
    PK4(p0, 0, pa0); PK4(p0, 8, pa1); PK4(p1, 0, pa2); PK4(p1, 8, pa3);
#undef PK4
}
template <int KB, bool BIAS>
__device__ __forceinline__ void qkt(f32x16& p0, f32x16& p1, const char* K_lds, const char* B_lds, int r32, int hi, const bf16x8* qr) {
    if constexpr (BIAS) {
        const f32x4* bl = reinterpret_cast<const f32x4*>(B_lds + KB * 256 + hi * 16);
        const f32x4 a0 = bl[0], a1 = bl[2], a2 = bl[4], a3 = bl[6];
        p0 = (f32x16){a0.x, a0.y, a0.z, a0.w, a1.x, a1.y, a1.z, a1.w, a2.x, a2.y, a2.z, a2.w, a3.x, a3.y, a3.z, a3.w};
        const f32x4 c0 = bl[8], c1 = bl[10], c2 = bl[12], c3 = bl[14];
        p1 = (f32x16){c0.x, c0.y, c0.z, c0.w, c1.x, c1.y, c1.z, c1.w, c2.x, c2.y, c2.z, c2.w, c3.x, c3.y, c3.z, c3.w};
    } else { p0 = f32x16{}; p1 = f32x16{}; }
    const char* kb[4];
#pragma unroll
    for (int dd = 0; dd < 4; ++dd) kb[dd] = K_lds + KB * SHM_K + KSWZ(r32, (dd * 16 + hi * 8) * 2);
#pragma unroll
    for (int d0 = 0; d0 < 8; ++d0) { const char* a = kb[d0 & 3] + (d0 >> 2) * 128;
        bf16x8 b0 = *reinterpret_cast<const bf16x8*>(a);
        bf16x8 b1 = *reinterpret_cast<const bf16x8*>(a + 32 * 256);
        p0 = __builtin_amdgcn_mfma_f32_32x32x16_bf16(b0, qr[d0], p0, 0, 0, 0);
        p1 = __builtin_amdgcn_mfma_f32_32x32x16_bf16(b1, qr[d0], p1, 0, 0, 0); }
}
template <int KB>
__device__ __forceinline__ void add_bias(f32x16& p0, f32x16& p1, const char* B_lds, int hi) {
    const f32x4* bl = reinterpret_cast<const f32x4*>(B_lds + KB * 256 + hi * 16);
#pragma unroll
    for (int g = 0; g < 4; ++g) { const f32x4 a = bl[2 * g], c = bl[8 + 2 * g];
        p0[4 * g + 0] += a.x; p0[4 * g + 1] += a.y; p0[4 * g + 2] += a.z; p0[4 * g + 3] += a.w;
        p1[4 * g + 0] += c.x; p1[4 * g + 1] += c.y; p1[4 * g + 2] += c.z; p1[4 * g + 3] += c.w; }
}
template <int VB>
__device__ __forceinline__ void pv_tile(f32x16* o, int vb0, bf16x8 pa0, bf16x8 pa1, bf16x8 pa2, bf16x8 pa3) {
#define TRRD(dst, off) asm volatile("ds_read_b64_tr_b16 %0, %1 offset:%2" : "=&v"(dst) : "v"(vb0), "i"(off) : "memory")
#define PV_D0(d0) do { s16x4 l0, l1, l2, l3, h0, h1, h2, h3; constexpr int b_ = VB * SHM_V + v_rd_off(d0, 0, 0);   \
        TRRD(l0, b_); TRRD(h0, b_ + 2048); TRRD(l1, b_ + 4096); TRRD(h1, b_ + 6144); TRRD(l2, b_ + 8192); TRRD(h2, b_ + 10240); TRRD(l3, b_ + 12288); TRRD(h3, b_ + 14336); \
        asm volatile("s_waitcnt lgkmcnt(0)" ::: "memory"); SBAR();   \
        o[d0] = __builtin_amdgcn_mfma_f32_32x32x16_bf16(pa0, (bf16x8){l0[0], l0[1], l0[2], l0[3], h0[0], h0[1], h0[2], h0[3]}, o[d0], 0, 0, 0);   \
        o[d0] = __builtin_amdgcn_mfma_f32_32x32x16_bf16(pa1, (bf16x8){l1[0], l1[1], l1[2], l1[3], h1[0], h1[1], h1[2], h1[3]}, o[d0], 0, 0, 0);   \
        o[d0] = __builtin_amdgcn_mfma_f32_32x32x16_bf16(pa2, (bf16x8){l2[0], l2[1], l2[2], l2[3], h2[0], h2[1], h2[2], h2[3]}, o[d0], 0, 0, 0);   \
        o[d0] = __builtin_amdgcn_mfma_f32_32x32x16_bf16(pa3, (bf16x8){l3[0], l3[1], l3[2], l3[3], h3[0], h3[1], h3[2], h3[3]}, o[d0], 0, 0, 0); } while (0)
    PV_D0(0); PV_D0(1); PV_D0(2); PV_D0(3);
#undef PV_D0
#undef TRRD
}

struct BlockRef { const bf16* Q; const bf16* K; const bf16* V; const float* Bk; bf16* O; int P0; };
struct Seam { bf16x8 qr[8]; bf16x8 st_v0, st_v1, st_k0, st_k1; };
__device__ __forceinline__ int swa_jlo(int P0, int W) { const int lowk = P0 - W + 1; return lowk > 0 ? lowk / KVBLK : 0; }

#define ROWK(p, k0, rr) ((p) + (size_t)((k0) + (rr)) * KS + sc)
#define ROWV(p, k0, rr) ((p) + (size_t)((k0) + (rr)) * VS + sc)
#define VMW() asm volatile("s_waitcnt vmcnt(0)" ::: "memory")
#define VMWN(n) asm volatile("s_waitcnt vmcnt(%0)" :: "i"(n) : "memory")
#define SLOAD_H(R_, k0, bfb) do { S.st_v0 = load8(ROWV((R_).V, k0, sr)); S.st_v1 = load8(ROWV((R_).V, k0, 32 + sr));              \
                         S.st_k0 = load8(ROWK((R_).K, k0, sr)); S.st_k1 = load8(ROWK((R_).K, k0, 32 + sr));                  \
                         if constexpr (BIAS) { if (wid == 0) __builtin_amdgcn_global_load_lds((const unsigned*)((R_).Bk + (k0) + lane), (LAS unsigned*)((LAS char*)B_lds + (bfb) * 256), 4, 0, 0); } } while (0)
#define SWRITE_HK(bf) do { *(bf16x8*)(K_lds + (bf) * SHM_K + kws) = S.st_k0; *(bf16x8*)(K_lds + (bf) * SHM_K + kws + 32 * 256) = S.st_k1; } while (0)
#define SWRITE_HV(bf) do { *(bf16x8*)(V_lds + (bf) * SHM_V + vst0) = S.st_v0; *(bf16x8*)(V_lds + (bf) * SHM_V + vst1) = S.st_v1; } while (0)
#define SWRITE_H(bf) do { SWRITE_HV(bf); SWRITE_HK(bf); } while (0)

template <bool BIAS, int QS, int KS, int VS, int OS>
__device__ __forceinline__ void attn_prime(const BlockRef& cur, int W, char* lds, Seam& S) {
    const int tid = threadIdx.x, wid = __builtin_amdgcn_readfirstlane(tid >> 6), lane = tid & 63, r32 = lane & 31, hi = lane >> 5;
    const int sr = tid >> 4, sc = (tid & 15) * 8, kws = KSWZ(sr, sc * 2); char* K_lds = lds + 2 * SHM_V; char* B_lds = lds + OFF_BIAS;
    const int kb0 = swa_jlo(cur.P0, W) * KVBLK;
    for (int d0 = 0; d0 < 8; ++d0) S.qr[d0] = load8(cur.Q + (size_t)(wid * QBLK + r32) * QS + d0 * 16 + hi * 8);
    SLOAD_H(cur, kb0, 0); VMW(); SWRITE_HK(0);
    __syncthreads();
}
template <bool BIAS, int QS, int KS, int VS, int OS>
__device__ __forceinline__ void attn_block(const BlockRef& cur, const BlockRef& nxt, int skv, int W, char* lds, Seam& S) {
    int tid_ = threadIdx.x; asm volatile("" : "+v"(tid_));
    const int tid = tid_, wid = __builtin_amdgcn_readfirstlane(tid >> 6), lane = tid & 63, r32 = lane & 31, hi = lane >> 5;
    const int j_lo = swa_jlo(cur.P0, W);
    int j_hi = (cur.P0 + QB - 1) / KVBLK + 1; if (j_hi > skv / KVBLK) j_hi = skv / KVBLK;
    const int NT = j_hi - j_lo;
    const int kbn = swa_jlo(nxt.P0, W) * KVBLK;
    const int qlo = cur.P0 + wid * QBLK, qm = qlo + r32 - 4 * hi;
    char* V_lds = lds; char* K_lds = lds + 2 * SHM_V; char* B_lds = lds + OFF_BIAS;
    float* ws = (float*)(lds + OFF_WS) + wid * 64; float* li_l = ws, * al_l = ws + 32;
    float m_reg = -1e30f, l_reg = 0; f32x16 o[4] = {};
    const int sr = tid >> 4, sc = (tid & 15) * 8, vst0 = v_st(sr, sc), vst1 = v_st(32 + sr, sc), kws = KSWZ(sr, sc * 2);
    const int vb0 = (int)(uintptr_t)V_lds + v_rd_base(lane);
#define RESC(a) do { if (__any((a) < 1.f)) { if (hi == 0) al_l[r32] = (a); asm volatile("s_waitcnt lgkmcnt(0)" ::: "memory");              \
                     for (int d_ = 0; d_ < 4; ++d_) for (int r = 0; r < 16; ++r) o[d_][r] *= al_l[crow(r, hi)]; } } while (0)
#define KBASE(t) ((j_lo + (t)) * KVBLK)
#define MASKT(P0_, P1_, t, KB_) do { const int kb_ = KBASE(t); if (kb_ + KVBLK - 1 > qlo || kb_ <= qlo + QBLK - 1 - W) mask_tile(P0_, P1_, qm - kb_, (unsigned)W); } while (0)
    constexpr int NQL = 8;
#define SEAM_K0() do { VMWN(NQL); SWRITE_HK(0); SBAR(); } while (0)
    f32x16 pA0, pA1, pB0, pB1; float mnA, mnB, alA, alB; bf16x8 pa0, pa1, pa2, pa3;
    SWRITE_HV(0); SBAR();
    if (NT > 1) { SLOAD_H(cur, KBASE(1), 1); }
    SBAR(); qkt<0, BIAS>(pA0, pA1, K_lds, B_lds, r32, hi, S.qr);
    MASKT(pA0, pA1, 0, 0); partialSM(pA0, pA1, m_reg, mnA, alA);
    if (NT > 1) { VMW(); SWRITE_H(1); }
    __syncthreads();
#define HALF_STEP(PX0, PX1, mnX, alX, PY0, PY1, alY, t, KB, VB, SB) do {                                                      \
        SBAR(); qkt<KB, BIAS>(PX0, PX1, K_lds, B_lds, r32, hi, S.qr);                                                         \
        finishSM(PY0, PY1, alY, l_reg, pa0, pa1, pa2, pa3); SBAR();                                                           \
        if ((t) + 1 < NT) { SLOAD_H(cur, KBASE((t) + 1), SB); SBAR(); }                                                           \
        pv_tile<VB>(o, vb0, pa0, pa1, pa2, pa3); MASKT(PX0, PX1, (t), KB); partialSM(PX0, PX1, m_reg, mnX, alX);                  \
        __syncthreads();                                                                                                      \
        if ((t) + 1 < NT) { VMW(); SWRITE_H(SB); }                                                                            \
        RESC(alX); __syncthreads(); } while (0)
    for (int t = 1; t + 1 < NT; t += 2) {
        HALF_STEP(pB0, pB1, mnB, alB, pA0, pA1, alA, t, 1, 0, 0);
        HALF_STEP(pA0, pA1, mnA, alA, pB0, pB1, alB, t + 1, 0, 1, 1);
    }
    const bool even = (NT & 1) == 0;
    if (even) { SBAR(); qkt<1, BIAS>(pB0, pB1, K_lds, B_lds, r32, hi, S.qr); SBAR(); }
    SLOAD_H(nxt, kbn, 0); SBAR();
#pragma unroll
    for (int d0 = 0; d0 < 8; ++d0) S.qr[d0] = load8(nxt.Q + (size_t)(wid * QBLK + r32) * QS + d0 * 16 + hi * 8);
    SBAR();
    finishSM(pA0, pA1, alA, l_reg, pa0, pa1, pa2, pa3); SBAR();
    pv_tile<0>(o, vb0, pa0, pa1, pa2, pa3);
    if (even) { MASKT(pB0, pB1, NT - 1, 1); partialSM(pB0, pB1, m_reg, mnB, alB); __syncthreads(); RESC(alB);
        finishSM(pB0, pB1, alB, l_reg, pa0, pa1, pa2, pa3); SBAR(); pv_tile<1>(o, vb0, pa0, pa1, pa2, pa3); }
    SBAR(); SEAM_K0();
    if (hi == 0) li_l[r32] = l_reg; asm volatile("s_waitcnt lgkmcnt(0)" ::: "memory");
    float rli[16];
#pragma unroll
    for (int r = 0; r < 16; ++r) rli[r] = __builtin_amdgcn_rcpf(li_l[crow(r, hi)]);
    int tid_e = threadIdx.x; asm volatile("" : "+v"(tid_e)); const int lane_e = tid_e & 63;
    const int r32e = lane_e & 31, hie = lane_e >> 5;
    bf16* Ow = cur.O + (size_t)(wid * QBLK + 4 * hie) * OS + r32e;
#pragma unroll
    for (int r = 0; r < 16; ++r) { const int orow = (r & 3) + 8 * (r >> 2);
#pragma unroll
        for (int d0 = 0; d0 < 4; ++d0) { const float v = o[d0][r] * rli[r];
            const float vn = __shfl_xor(v, 1);
            if ((r32e & 1) == 0) *(unsigned*)(Ow + (size_t)orow * OS + d0 * 32) = cvtpk(v, vn); } }
    __syncthreads();
#undef RESC
#undef KBASE
#undef MASKT
#undef SEAM_K0
#undef HALF_STEP
}
#undef ROWK
#undef ROWV
#undef VMW
#undef VMWN
#undef SLOAD_H
#undef SWRITE_HK
#undef SWRITE_HV
#undef SWRITE_H
#undef KSWZ
#undef SBAR
}
namespace gla {
typedef float f32x16 __attribute__((ext_vector_type(16)));
typedef short s16x4 __attribute__((ext_vector_type(4)));
constexpr int CH = 64, NCH = SEQ / CH, DK = 256, DV = 512, NH = 4;
constexpr int L_QK = 0, QK_BYTES = 32768, NQK = 3;
constexpr int L_VA = NQK * QK_BYTES, VA_BYTES = 25600;
constexpr int LDS_BYTES = L_VA + 2 * VA_BYTES;

__device__ __forceinline__ unsigned swz(unsigned row) { return ((row & 3u) << 2) | ((row >> 2) & 3u); }
__device__ __forceinline__ unsigned off_b(unsigned row, unsigned ch) { return 256u * row + 16u * (ch ^ swz(row)); }
__device__ __forceinline__ unsigned row_read_addr(unsigned lane, unsigned s) { return off_b(lane & 31u, 2u * s + (lane >> 5)); }
__device__ __forceinline__ unsigned tr_read_addr(unsigned lane, unsigned c, unsigned ks, unsigned t) {
    const unsigned h = lane >> 5, blk = (lane >> 4) & 1u, q = (lane & 15u) >> 2, p = lane & 3u;
    return off_b(16u * ks + 8u * h + 4u * t + q, 4u * c + 2u * blk + (p >> 1)) + 8u * (p & 1u);
}
__device__ __forceinline__ unsigned cvtpk(float lo, float hi) { unsigned r; asm volatile("v_cvt_pk_bf16_f32 %0, %1, %2" : "=v"(r) : "v"(lo), "v"(hi)); return r; }
#define GLA_TRRD(dst, addr) asm volatile("ds_read_b64_tr_b16 %0, %1" : "=&v"(dst) : "v"(addr) : "memory")
#define GLA_LWAIT() do { asm volatile("s_waitcnt lgkmcnt(0)" ::: "memory"); __builtin_amdgcn_sched_barrier(0); } while (0)

__device__ __forceinline__ void apass_job(const bf16* QT, const bf16* KT, bf16* AT, int job, int lane) {
    const int tile = job % 3, cc = job / 3, c = cc & (NCH - 1), bh = cc >> 6;
    const int tm = tile ? 1 : 0, tn = tile == 2 ? 1 : 0, r32 = lane & 31, h = lane >> 5;
    const bf16* qrow = QT + ((size_t)bh * SEQ + c * CH + 32 * tm + r32) * DK + 8 * h;
    const bf16* krow = KT + ((size_t)bh * SEQ + c * CH + 32 * tn + r32) * DK + 8 * h;
    f32x16 acc = {};
#pragma unroll
    for (int kb = 0; kb < 4; ++kb) {
        bf16x8 qa[4], ka[4];
#pragma unroll
        for (int k = 0; k < 4; ++k) { qa[k] = *(const bf16x8*)(qrow + 16 * (4 * kb + k)); ka[k] = *(const bf16x8*)(krow + 16 * (4 * kb + k)); }
#pragma unroll
        for (int k = 0; k < 4; ++k) acc = __builtin_amdgcn_mfma_f32_32x32x16_bf16(ka[k], qa[k], acc, 0, 0, 0);
    }
    const int t = 32 * tm + r32;
    bf16* dst = AT + (((size_t)bh * NCH + c) * CH + t) * CH + 32 * tn + 4 * h;
#pragma unroll
    for (int g = 0; g < 4; ++g) {
        const int s0 = 32 * tn + 8 * g + 4 * h;
        float v[4];
#pragma unroll
        for (int e = 0; e < 4; ++e) v[e] = (s0 + e <= t) ? acc[4 * g + e] : 0.f;
        *(v2u*)(dst + 8 * g) = (v2u){cvtpk(v[0], v[1]), cvtpk(v[2], v[3])};
    }
}

struct ScanRef { const bf16* QT; const bf16* KT; const bf16* VG; const bf16* AT; const float* EBL; float* O; };

__device__ __forceinline__ void dma_qk(const ScanRef& R, LAS unsigned char* lds, int n, int nb, int hw, int lane_) {
    int lane = lane_; asm volatile("" : "+v"(lane));
    const int c = n >> 1, hh = n & 1; LAS unsigned char* buf = lds + L_QK + nb * QK_BYTES;
#pragma unroll
    for (int i = 0; i < 8; ++i) {
        const int j = i * 4 + hw;
        const int img = j >> 3, j8 = j & 7, row = 4 * j8 + (lane >> 4), ch = (lane & 15) ^ (int)swz((unsigned)row);
        const bf16* src = ((img >> 1) ? R.KT : R.QT) + ((size_t)(c * CH + 32 * (img & 1) + row)) * DK + 128 * hh + 8 * ch;
        __builtin_amdgcn_global_load_lds((const unsigned*)src, (LAS unsigned*)(buf + img * 8192 + j8 * 1024), 16, 0, 0);
    }
}
__device__ __forceinline__ void dma_va(const ScanRef& R, LAS unsigned char* lds, int c, int hw, int lane_) {
    int lane = lane_; asm volatile("" : "+v"(lane));
    LAS unsigned char* buf = lds + L_VA + (c & 1) * VA_BYTES;
#pragma unroll
    for (int i = 0; i < 7; ++i) {
        const int j = i * 4 + hw;
        const int j8 = j & 7, row = 4 * j8 + (lane >> 4), ch = (lane & 15) ^ (int)swz((unsigned)row);
        if (j < 16) {
            const bf16* src = R.VG + ((size_t)(c * CH + 32 * (j >> 3) + row)) * DV + 8 * ch;
            __builtin_amdgcn_global_load_lds((const unsigned*)src, (LAS unsigned*)(buf + (j >> 3) * 8192 + j8 * 1024), 16, 0, 0);
        } else if (j < 24) {
            const int t = row + 32 * (ch >> 3), s0 = 8 * (ch & 7);
            const bf16* src = R.AT + ((size_t)c * CH + t) * CH + s0;
            __builtin_amdgcn_global_load_lds((const unsigned*)src, (LAS unsigned*)(buf + 16384 + j8 * 1024), 16, 0, 0);
        } else {
            const float* src = R.EBL + (size_t)c * DK + 4 * lane;
            __builtin_amdgcn_global_load_lds((const unsigned*)src, (LAS unsigned*)(buf + 24576), 16, 0, 0);
        }
    }
}

__device__ __forceinline__ unsigned vxor(unsigned a, const unsigned k) { unsigned r; asm volatile("v_xor_b32 %0, %1, %2" : "=v"(r) : "i"(k), "v"(a)); return r; }
#define GLA_TRRDO(dst, addr, off) asm volatile("ds_read_b64_tr_b16 %0, %1 offset:%2" : "=&v"(dst) : "v"(addr), "i"(off) : "memory")
#define GLA_LWAITN(n) do { asm volatile("s_waitcnt lgkmcnt(" #n ")" ::: "memory"); __builtin_amdgcn_sched_barrier(0); } while (0)
template <int HH>
__device__ __forceinline__ void scan_half(f32x16 (&S)[8], f32x16 (&acc)[2], bf16x8 (&vf)[4], unsigned qk, unsigned va, int w, float* Orow) {
    int t_ = threadIdx.x; asm volatile("" : "+v"(t_));
    const unsigned lane = (unsigned)t_ & 63u, r32 = lane & 31u, h = lane >> 5, blk = (lane >> 4) & 1u, q = (lane & 15u) >> 2, p = lane & 3u;
    const unsigned sw = swz(r32);
    const unsigned qbase = 256u * r32 + (sw << 4) + 8u * h + qk;
    const unsigned abase = (256u * r32 + (sw << 4)) ^ (h << 4);
    const unsigned tr0 = 256u * (8u * h + q) + 8u * (p & 1u) + 16u * ((2u * blk + (p >> 1)) ^ (2u * h)) + 64u * q;
    const unsigned tr1 = 256u * (8u * h + 4u + q) + 8u * (p & 1u) + 16u * ((2u * blk + (p >> 1)) ^ (2u * h + 1u)) + 64u * q;
    const unsigned kb0 = tr0 + qk + 16384u, kb1 = tr1 + qk + 16384u;
    s16x4 loA[4], hiA[4];
#define GLA_LOADK(il, lo, hi) do { const unsigned k0_ = vxor(kb0, (unsigned)((il) << 6)), k1_ = vxor(kb1, (unsigned)((il) << 6)); \
        _Pragma("unroll") for (int kk = 0; kk < 4; ++kk) { GLA_TRRDO(lo[kk], k0_, (kk >> 1) * 8192 + (kk & 1) * 4096); GLA_TRRDO(hi[kk], k1_, (kk >> 1) * 8192 + (kk & 1) * 4096); } } while (0)
#define GLA_MMAK(il, lo, hi) do { f32x16& X = S[4 * HH + (il)]; \
        _Pragma("unroll") for (int kk = 0; kk < 4; ++kk) X = __builtin_amdgcn_mfma_f32_32x32x16_bf16((bf16x8){lo[kk][0], lo[kk][1], lo[kk][2], lo[kk][3], hi[kk][0], hi[kk][1], hi[kk][2], hi[kk][3]}, vf[kk], X, 0, 0, 0); } while (0)
#define GLA_SCALE(il) do { f32x16& X = S[4 * HH + (il)]; \
        const LAS float* eb = (const LAS float*)(uintptr_t)(va + 24576u + 4u * (32u * (4 * HH + (il)) + 4u * h)); \
        _Pragma("unroll") for (int g = 0; g < 4; ++g) { const f32x4 e = *(const LAS f32x4*)(eb + 8 * g); X[4 * g + 0] *= e.x; X[4 * g + 1] *= e.y; X[4 * g + 2] *= e.z; X[4 * g + 3] *= e.w; } } while (0)
    if constexpr (HH == 0) {
        const unsigned v0 = (tr0 ^ ((unsigned)w << 6)) + va, v1 = (tr1 ^ ((unsigned)w << 6)) + va;
        s16x4 lo[4], hi[4];
#pragma unroll
        for (int kk = 0; kk < 4; ++kk) { GLA_TRRDO(lo[kk], v0, (kk >> 1) * 8192 + (kk & 1) * 4096); GLA_TRRDO(hi[kk], v1, (kk >> 1) * 8192 + (kk & 1) * 4096); }
        GLA_LWAITN(0);
#pragma unroll
        for (int kk = 0; kk < 4; ++kk) vf[kk] = (bf16x8){lo[kk][0], lo[kk][1], lo[kk][2], lo[kk][3], hi[kk][0], hi[kk][1], hi[kk][2], hi[kk][3]};
        acc[0] = f32x16{}; acc[1] = f32x16{};
        const unsigned ab = abase + va + 16384u;
#pragma unroll
        for (int m = 0; m < 2; ++m)
#pragma unroll
            for (int kk = 0; kk < 2 + 2 * m; ++kk) { const bf16x8 a = *(const LAS bf16x8*)(uintptr_t)vxor(ab, (unsigned)((4 * m + kk) << 5)); acc[m] = __builtin_amdgcn_mfma_f32_32x32x16_bf16(a, vf[kk], acc[m], 0, 0, 0); }
    }
    GLA_LOADK(0, loA, hiA);
#pragma unroll
    for (int il = 0; il < 4; ++il) {
        const f32x16& X = S[4 * HH + il];
#pragma unroll
        for (int s2 = 0; s2 < 2; ++s2) {
            const v4u bw = {cvtpk(X[8 * s2 + 0], X[8 * s2 + 1]), cvtpk(X[8 * s2 + 2], X[8 * s2 + 3]), cvtpk(X[8 * s2 + 4], X[8 * s2 + 5]), cvtpk(X[8 * s2 + 6], X[8 * s2 + 7])};
            const bf16x8 bfr = __builtin_bit_cast(bf16x8, bw);
            const unsigned a0 = vxor(qbase, (unsigned)((4 * il + 2 * s2) << 4)), a1 = vxor(qbase, (unsigned)((4 * il + 2 * s2 + 1) << 4));
#pragma unroll
            for (int m = 0; m < 2; ++m) {
                const v2u p0 = *(const LAS v2u*)(uintptr_t)(a0 + m * 8192), p1 = *(const LAS v2u*)(uintptr_t)(a1 + m * 8192);
                const v4u aw = {p0.x, p0.y, p1.x, p1.y};
                acc[m] = __builtin_amdgcn_mfma_f32_32x32x16_bf16(__builtin_bit_cast(bf16x8, aw), bfr, acc[m], 0, 0, 0);
            }
        }
    }
    if constexpr (HH == 1) {
        float* ob = Orow + (size_t)(4u * h) * DM + 32 * w + r32;
#pragma unroll
        for (int m = 0; m < 2; ++m)
#pragma unroll
            for (int r = 0; r < 16; ++r) ob[(size_t)(32 * m + (r & 3) + 8 * (r >> 2)) * DM] = acc[m][r];
    }
    GLA_LWAITN(0); GLA_MMAK(0, loA, hiA); __builtin_amdgcn_sched_barrier(0); GLA_LOADK(1, loA, hiA); GLA_SCALE(0);
    GLA_LWAITN(0); GLA_MMAK(1, loA, hiA); __builtin_amdgcn_sched_barrier(0); GLA_LOADK(2, loA, hiA); GLA_SCALE(1);
    GLA_LWAITN(0); GLA_MMAK(2, loA, hiA); __builtin_amdgcn_sched_barrier(0); GLA_LOADK(3, loA, hiA); GLA_SCALE(2);
    GLA_LWAITN(0); GLA_MMAK(3, loA, hiA); GLA_SCALE(3);
#undef GLA_LOADK
#undef GLA_MMAK
#undef GLA_SCALE
}

__device__ __forceinline__ void scan_item(const ScanRef& R, LAS unsigned char* lds) {
    int tid_ = threadIdx.x; asm volatile("" : "+v"(tid_));
    const int tid = tid_, wid = __builtin_amdgcn_readfirstlane(tid >> 6), lane = tid & 63;
    __syncthreads();
#define GLA_BAR() do { asm volatile("s_waitcnt lgkmcnt(0)" ::: "memory"); __builtin_amdgcn_s_barrier(); asm volatile("" ::: "memory"); } while (0)
    if (wid >= 4) {
        const int hw = wid & 3; int nb = 0;
        dma_qk(R, lds, 0, 0, hw, lane); dma_qk(R, lds, 1, 1, hw, lane); dma_va(R, lds, 0, hw, lane); asm volatile("s_waitcnt vmcnt(0)" ::: "memory");
        for (int c = 0; c < NCH; ++c) {
            GLA_BAR();
            { const int nb2 = nb >= 1 ? nb - 1 : 2;
              if (c + 1 < NCH) { dma_qk(R, lds, 2 * c + 2, nb2, hw, lane); dma_va(R, lds, c + 1, hw, lane); asm volatile("s_waitcnt vmcnt(15)" ::: "memory"); }
              else asm volatile("s_waitcnt vmcnt(0)" ::: "memory"); }
            nb = nb == 2 ? 0 : nb + 1;
            GLA_BAR();
            { const int nb2 = nb >= 1 ? nb - 1 : 2;
              if (c + 1 < NCH) { dma_qk(R, lds, 2 * c + 3, nb2, hw, lane); asm volatile("s_waitcnt vmcnt(8)" ::: "memory"); }
              else asm volatile("s_waitcnt vmcnt(0)" ::: "memory"); }
            nb = nb == 2 ? 0 : nb + 1;
        }
        GLA_BAR();
    } else {
        f32x16 S[8]; f32x16 acc[2]; bf16x8 vf[4]; int nb = 0;
#pragma unroll
        for (int i = 0; i < 8; ++i) S[i] = f32x16{};
        acc[0] = f32x16{}; acc[1] = f32x16{};
#pragma unroll
        for (int i = 0; i < 4; ++i) vf[i] = bf16x8{};
        for (int c = 0; c < NCH; ++c) {
            const unsigned va = (unsigned)(L_VA + (c & 1) * VA_BYTES);
            GLA_BAR();
            scan_half<0>(S, acc, vf, (unsigned)(L_QK + nb * QK_BYTES), va, wid, R.O + (size_t)c * CH * DM);
            nb = nb == 2 ? 0 : nb + 1;
            GLA_BAR();
            scan_half<1>(S, acc, vf, (unsigned)(L_QK + nb * QK_BYTES), va, wid, R.O + (size_t)c * CH * DM);
            nb = nb == 2 ? 0 : nb + 1;
        }
        GLA_BAR();
    }
#undef GLA_BAR
}
#undef GLA_TRRD
#undef GLA_TRRDO
#undef GLA_LWAIT
#undef GLA_LWAITN
}
constexpr int NWAVES = 8;
constexpr int LDS_BYTES = 163840;
constexpr int RING_BYTES = 131072;
constexpr int CTLW = 159744;

constexpr size_t MiB = (size_t)1 << 20;
constexpr size_t WS_CTL = 0, CTL_BYTES = 1 * MiB;
constexpr size_t WS_WTIN = CTL_BYTES;
constexpr size_t WS_WTBG = WS_WTIN + (size_t)INCP * DM * 2;
constexpr size_t WS_WTBF = WS_WTBG + (size_t)DM * DM * 2;
constexpr size_t WS_WTOUT = WS_WTBF + (size_t)DM * DM * 2;
constexpr size_t WS_WTMQ = WS_WTOUT + (size_t)DM * DM * 2;
constexpr size_t WS_WTMKV = WS_WTMQ + (size_t)512 * DM * 2;
constexpr size_t WS_WTMO = WS_WTMKV + (size_t)1024 * DM * 2;
constexpr size_t WS_WTUP = WS_WTMO + (size_t)DM * 512 * 2;
constexpr size_t WS_WTDN = WS_WTUP + (size_t)NE * 4096 * DM * 2;
constexpr size_t WS_WRT = WS_WTDN + (size_t)NE * DM * DM * 2;
constexpr size_t WS_QT = WS_WRT + (size_t)256 * DM * 2;
constexpr size_t WS_KT = WS_QT + (size_t)T * 1024 * 2;
constexpr size_t WS_VG = WS_KT + (size_t)T * 1024 * 2;
constexpr size_t WS_SG = WS_VG + (size_t)T * DM * 2;
constexpr size_t WS_FQH = WS_SG + (size_t)T * DM * 2;
constexpr size_t WS_FKH = WS_FQH + (size_t)T * DM * 2;
constexpr size_t WS_FVH = WS_FKH + (size_t)T * DM * 2;
constexpr size_t WS_GG = WS_FVH + (size_t)T * DM * 2;
constexpr size_t WS_GF = WS_GG + (size_t)T * DM * 2;
constexpr size_t WS_YB = WS_QT;
static_assert(WS_GF + (size_t)T * DM * 2 - WS_QT >= (size_t)PMAX * DM * 2, "YB overlay");
constexpr size_t WS_OGLA = WS_GF + (size_t)T * DM * 2;
constexpr size_t WS_Y2 = WS_OGLA + (size_t)T * DM * 4;
constexpr size_t WS_H = WS_Y2 + (size_t)T * DM * 4;
constexpr size_t WS_ACT = WS_OGLA;
static_assert(WS_H + (size_t)T * DM * 2 - WS_OGLA >= (size_t)PMAX * DM * 2, "ACT overlay");
constexpr size_t WS_Y1 = WS_H + (size_t)T * DM * 2;
constexpr size_t WS_X1 = WS_Y1 + (size_t)T * DM * 4;
constexpr size_t WS_X2 = WS_X1 + (size_t)T * DM * 4;
constexpr size_t WS_ATT = WS_X2 + (size_t)T * DM * 4;
constexpr size_t WS_ON = WS_ATT + (size_t)T * DM * 2;
constexpr size_t WS_MRG = WS_ON + (size_t)T * DM * 2;
constexpr size_t WS_H2 = WS_MRG + (size_t)T * DM * 2;
constexpr size_t WS_XS = WS_H2 + (size_t)T * DM * 2;
constexpr size_t WS_OM = WS_XS + (size_t)T * DM * 2;
constexpr size_t WS_MN = WS_OM + (size_t)T * 512 * 2;
constexpr size_t WS_QM = WS_MN + (size_t)1024 * DM * 2;
constexpr size_t WS_KV = WS_QM + (size_t)T * 1024 * 4;
constexpr size_t WS_ASG = WS_KV + (size_t)1024 * 4096 * 4;
constexpr size_t WS_TOKL = WS_ASG + (size_t)NASG * 8;
constexpr size_t WS_WL = WS_TOKL + (size_t)NE * T * 4;
constexpr size_t WS_RSL = WS_WL + (size_t)NE * T * 4;
constexpr size_t WS_RSS1 = WS_RSL + (size_t)NE * T * 4;
constexpr size_t WS_RSS2 = WS_RSS1 + (size_t)T * 32 * 4;
constexpr size_t WS_LOG = WS_RSS2 + (size_t)T * 32 * 4;
constexpr size_t WS_EBL = WS_LOG + (size_t)T * 128 * 4;
constexpr size_t WS_AT = WS_EBL + (size_t)16 * 64 * 256 * 4;
constexpr size_t WS_GAFF = WS_AT + (size_t)16 * 64 * 64 * 64 * 2;
constexpr size_t WS_CB = WS_GAFF + (size_t)T * 128 * 4;
constexpr size_t WS_QMB = WS_CB + (size_t)NB * 16 * SEQ * 4;
constexpr size_t WS_KNB = WS_QMB + (size_t)T * 512 * 2;
constexpr size_t WS_VB = WS_KNB + (size_t)NB * 4 * MEML * 128 * 2;
constexpr size_t WS_END = WS_VB + (size_t)NB * 4 * MEML * 128 * 2;
constexpr int CW_CNT = 0, CW_NT = 64, CW_FOXQ = 128  , CW_GLA = 1024  , CW_BAR = 4096;

struct Args { const float* in[27]; float* out; unsigned char* ws; int ph_lo, ph_hi; };
struct Frame { LAS unsigned char* lds; int tid, lane, wave, G, bid, gw, ngw; };

__device__ __forceinline__ void p0_transpose_item(const float* W, int K, int N, bf16* WT, LAS float* scr, int item, int lane) {
    const int nblk = N / 32, kb = item / nblk, nb = item % nblk, k0 = 64 * kb, n0 = 32 * nb;
#pragma unroll 8
    for (int i = 0; i < 32; ++i) { const int kk = 2 * i + (lane >> 5); scr[kk * 33 + (lane & 31)] = W[(size_t)(k0 + kk) * N + n0 + (lane & 31)]; }
    LDS_WAIT(); asm volatile("" ::: "memory");
    const int c = lane & 7;
#pragma unroll
    for (int j = 0; j < 4; ++j) { const int n = (lane >> 3) + 8 * j; const LAS float* s = scr + (8 * c) * 33 + n;
        v4u o; o.x = pk2(s[0 * 33], s[1 * 33]); o.y = pk2(s[2 * 33], s[3 * 33]); o.z = pk2(s[4 * 33], s[5 * 33]); o.w = pk2(s[6 * 33], s[7 * 33]);
        *(v4u*)(WT + (size_t)(n0 + n) * K + k0 + 8 * c) = o; }
    LDS_WAIT(); asm volatile("" ::: "memory");
}
__device__ __forceinline__ void transpose_job(Frame& F, const float* W, int K, int N, int batch, bf16* WT) {
    LAS float* scr = (LAS float*)(F.lds + F.wave * 16384);
    const int per = (K / 64) * (N / 32); const long total = (long)per * batch;
    for (long it = F.gw; it < total; it += F.ngw) { const int e = (int)(it / per), r = (int)(it % per);
        p0_transpose_item(W + (size_t)e * K * N, K, N, WT + (size_t)e * N * K, scr, r, F.lane); }
}
__device__ __forceinline__ void rms_row_bf16(const float* xrow, const float* g, bf16* orow, int lane) {
    const f32x4* xr = (const f32x4*)xrow + lane; const f32x4* gr = (const f32x4*)g + lane;
    f32x4 v[8]; float s = 0.f;
#pragma unroll
    for (int j = 0; j < 8; ++j) { v[j] = xr[64 * j]; s += (v[j].x * v[j].x + v[j].y * v[j].y) + (v[j].z * v[j].z + v[j].w * v[j].w); }
    const float r = 1.0f / sqrtf(wave_sum(s) * (1.f / DM) + EPS);
    v2u* o8 = (v2u*)orow + lane;
#pragma unroll
    for (int j = 0; j < 8; ++j) { const f32x4 gg = gr[64 * j]; v2u w; w.x = pk2(v[j].x * r * gg.x, v[j].y * r * gg.y); w.y = pk2(v[j].z * r * gg.z, v[j].w * r * gg.w); o8[64 * j] = w; }
}

__device__ __forceinline__ void rms_rows2_bf16(const float* xa, const float* xb, const float* g, bf16* oa, bf16* ob, int lane) {
    const f32x4* pa = (const f32x4*)xa + lane; const f32x4* pb = (const f32x4*)xb + lane; const f32x4* gr = (const f32x4*)g + lane;
    f32x4 va[8], vb[8]; float sa = 0.f, sb = 0.f;
#pragma unroll
    for (int j = 0; j < 8; ++j) va[j] = __builtin_nontemporal_load(pa + 64 * j);
#pragma unroll
    for (int j = 0; j < 8; ++j) vb[j] = __builtin_nontemporal_load(pb + 64 * j);
#pragma unroll
    for (int j = 0; j < 8; ++j) { sa += (va[j].x * va[j].x + va[j].y * va[j].y) + (va[j].z * va[j].z + va[j].w * va[j].w); sb += (vb[j].x * vb[j].x + vb[j].y * vb[j].y) + (vb[j].z * vb[j].z + vb[j].w * vb[j].w); }
    const float ra = __builtin_amdgcn_rsqf(wave_sum(sa) * (1.f / DM) + EPS), rb = __builtin_amdgcn_rsqf(wave_sum(sb) * (1.f / DM) + EPS);
    v2u* o8a = (v2u*)oa + lane; v2u* o8b = (v2u*)ob + lane;
#pragma unroll
    for (int j = 0; j < 8; ++j) { const f32x4 gg = gr[64 * j];
        __builtin_nontemporal_store((v2u){pk2(va[j].x * ra * gg.x, va[j].y * ra * gg.y), pk2(va[j].z * ra * gg.z, va[j].w * ra * gg.w)}, o8a + 64 * j);
        __builtin_nontemporal_store((v2u){pk2(vb[j].x * rb * gg.x, vb[j].y * rb * gg.y), pk2(vb[j].z * rb * gg.z, vb[j].w * rb * gg.w)}, o8b + 64 * j); }
}

__device__ __forceinline__ void naive_attn_row(const float* qrow, const float* Kb, size_t kstride, const float* Vb, size_t vstride, const float* cb, float ct, int nk, float scale,
                                               int lane, float& o0, float& o1) {
    const f32x2 q = *(const f32x2*)(qrow + 2 * lane);
    float m = -1e30f, l = 0.f, a0 = 0.f, a1 = 0.f;
#pragma unroll 4
    for (int s = 0; s < nk; ++s) {
        const f32x2 kk = *(const f32x2*)(Kb + (size_t)s * kstride + 2 * lane);
        const f32x2 vv = *(const f32x2*)(Vb + (size_t)s * vstride + 2 * lane);
        float d = wave_sum(q.x * kk.x + q.y * kk.y) * scale;
        if (cb) d += ct - cb[s];
        const float mn = fmaxf(m, d), alpha = __expf(m - mn), p = __expf(d - mn);
        l = l * alpha + p; a0 = a0 * alpha + p * vv.x; a1 = a1 * alpha + p * vv.y; m = mn;
    }
    o0 = a0 / l; o1 = a1 / l;
}

__device__ __forceinline__ int win_row(int n) { return n < 6144 ? n : n < 6160 ? 16384 + (n - 6144) : n < 12304 ? n - 16 : n < 12320 ? 16400 + (n - 12304) : n - 32; }
__device__ __forceinline__ void transpose_win(Frame& F, const float* W, bf16* WT) {
    LAS float* scr = (LAS float*)(F.lds + F.wave * 16384);
    constexpr int K = DM, N = INC, total = (K / 64) * 2;
    for (int it = F.gw; it < total; it += F.ngw) {
        const int kb = it >> 1, k0 = 64 * kb, n0 = (it & 1) ? 12304 : 6144, lane = F.lane;
#pragma unroll 8
        for (int i = 0; i < 16; ++i) { const int kk = 4 * i + (lane >> 4); scr[kk * 17 + (lane & 15)] = W[(size_t)(k0 + kk) * N + n0 + (lane & 15)]; }
        LDS_WAIT(); asm volatile("" ::: "memory");
        const int c = lane & 7, r0 = win_row(n0);
#pragma unroll
        for (int j = 0; j < 2; ++j) { const int n = (lane >> 3) + 8 * j; const LAS float* sp = scr + (8 * c) * 17 + n;
            v4u o; o.x = pk2(sp[0 * 17], sp[1 * 17]); o.y = pk2(sp[2 * 17], sp[3 * 17]); o.z = pk2(sp[4 * 17], sp[5 * 17]); o.w = pk2(sp[6 * 17], sp[7 * 17]);
            *(v4u*)(WT + (size_t)(r0 + n) * K + k0 + 8 * c) = o; }
        LDS_WAIT(); asm volatile("" ::: "memory");
    }
}
__device__ __forceinline__ void transpose_win64(LAS unsigned char* lds, const float* W, bf16* WT, int gw, int ngw) {
    int t_ = threadIdx.x; asm volatile("" : "+v"(t_));
    const int wid = __builtin_amdgcn_readfirstlane(t_ >> 6), lane = t_ & 63;
    LAS unsigned char* tile = lds + wid * 19456;
    const unsigned tbase = (unsigned)(size_t)tile;
    const int lr = lane >> 4, lc = lane & 15, g = lane >> 4, q = (lane & 15) >> 2, p = lane & 3;
    const unsigned wr_off = (unsigned)(lr * 160 + lc * 8), tr_off = (unsigned)(q * 160 + (g * 16 + 4 * p) * 2);
    const unsigned ldo = (unsigned)(lr * INC * 4 + lc * 16), sto = (unsigned)((lane >> 3) * (DM * 2) + (lane & 7) * 16);
    constexpr int total = (DM / 64) * 256; constexpr unsigned rs = 4u * INC * 4u;
#define TW_SRC(it_, sp_, dp_) do { const int kb_ = (it_) >> 8, d0_ = 64 * ((it_) & 255), n0_ = d0_ + (d0_ < 6144 ? 0 : d0_ < 12288 ? 16 : 32); \
        sp_ = (const char*)W + ((size_t)(64 * kb_) * INC + n0_) * 4; dp_ = (char*)WT + ((size_t)d0_ * DM + 64 * kb_) * 2; } while (0)
#define TW_LOAD(R_, sp_) do { _Pragma("unroll") for (int i = 0; i < 16; ++i) R_[i] = __builtin_nontemporal_load((const f32x4*)(sp_ + (ldo + (unsigned)i * rs))); } while (0)
#define TW_PROC(R_, dp_) do { \
        _Pragma("unroll") for (int i = 0; i < 16; ++i) { const v2u w = {pk2(R_[i].x, R_[i].y), pk2(R_[i].z, R_[i].w)}; *(LAS v2u*)(tile + wr_off + i * 640) = w; } \
        asm volatile("s_waitcnt lgkmcnt(0)" ::: "memory"); \
        _Pragma("unroll") for (int hb_ = 0; hb_ < 2; ++hb_) { v2u ta_[4], tb_[4]; \
            _Pragma("unroll") for (int jj = 0; jj < 4; ++jj) { \
                asm volatile("ds_read_b64_tr_b16 %0, %1 offset:%2" : "=&v"(ta_[jj]) : "v"(tbase + tr_off), "i"((4 * hb_ + jj) * 1280) : "memory"); \
                asm volatile("ds_read_b64_tr_b16 %0, %1 offset:%2" : "=&v"(tb_[jj]) : "v"(tbase + tr_off), "i"((4 * hb_ + jj) * 1280 + 640) : "memory"); } \
            asm volatile("s_waitcnt lgkmcnt(0)" : "+v"(ta_[0]), "+v"(ta_[1]), "+v"(ta_[2]), "+v"(ta_[3]), "+v"(tb_[0]), "+v"(tb_[1]), "+v"(tb_[2]), "+v"(tb_[3]) :: "memory"); \
            _Pragma("unroll") for (int jj = 0; jj < 4; ++jj) *(LAS v4u*)(tile + 10240 + lane * 144 + (4 * hb_ + jj) * 16) = (v4u){ta_[jj].x, ta_[jj].y, tb_[jj].x, tb_[jj].y}; } \
        asm volatile("s_waitcnt lgkmcnt(0)" ::: "memory"); \
        _Pragma("unroll") for (int hf_ = 0; hf_ < 2; ++hf_) { v4u ow_[4]; \
            _Pragma("unroll") for (int s_ = 0; s_ < 4; ++s_) ow_[s_] = *(const LAS v4u*)(tile + 10240 + (8 * (4 * hf_ + s_) + (lane >> 3)) * 144 + (lane & 7) * 16); \
            _Pragma("unroll") for (int s_ = 0; s_ < 4; ++s_) __builtin_nontemporal_store(ow_[s_], (v4u*)(dp_ + (sto + (unsigned)(8 * (4 * hf_ + s_)) * (unsigned)(DM * 2)))); \
            asm volatile("" ::: "memory"); } \
        asm volatile("s_waitcnt lgkmcnt(0)" ::: "memory"); } while (0)
    f32x4 RA[16], RB[16]; const char* sA; const char* sB; char* dA; char* dB;
    int it = gw;
    if (it < total) { TW_SRC(it, sA, dA); TW_LOAD(RA, sA); }
    while (it < total) {
        const int i1 = it + ngw, i2 = it + 2 * ngw;
        if (i1 < total) { TW_SRC(i1, sB, dB); TW_LOAD(RB, sB); }
        TW_PROC(RA, dA);
        if (i1 >= total) break;
        if (i2 < total) { TW_SRC(i2, sA, dA); TW_LOAD(RA, sA); }
        TW_PROC(RB, dB);
        it = i2;
    }
#undef TW_SRC
#undef TW_LOAD
#undef TW_PROC
}
__device__ __forceinline__ void transpose64(LAS unsigned char* lds, const float* W, int K, int N, bf16* WT, int gw, int ngw) {
    int t_ = threadIdx.x; asm volatile("" : "+v"(t_));
    const int wid = __builtin_amdgcn_readfirstlane(t_ >> 6), lane = t_ & 63;
    LAS unsigned char* tile = lds + wid * 19456;
    const unsigned tbase = (unsigned)(size_t)tile;
    const int lr = lane >> 4, lc = lane & 15, g = lane >> 4, q = (lane & 15) >> 2, p = lane & 3;
    const unsigned wr_off = (unsigned)(lr * 160 + lc * 8), tr_off = (unsigned)(q * 160 + (g * 16 + 4 * p) * 2);
    const unsigned ldo = (unsigned)(lr * N * 4 + lc * 16), sto = (unsigned)((lane >> 3) * (K * 2) + (lane & 7) * 16), rs = 16u * (unsigned)N, ds8 = 8u * (unsigned)(K * 2);
    const int nbk = N >> 6, total = (K >> 6) * nbk;
#define TG_SRC(it_, sp_, dp_) do { const int kb_ = (it_) / nbk, nb_ = (it_) - kb_ * nbk; \
        sp_ = (const char*)W + ((size_t)(64 * kb_) * N + 64 * nb_) * 4; dp_ = (char*)WT + ((size_t)(64 * nb_) * K + 64 * kb_) * 2; } while (0)
#define TG_LOAD(R_, sp_) do { _Pragma("unroll") for (int i = 0; i < 16; ++i) R_[i] = __builtin_nontemporal_load((const f32x4*)(sp_ + (ldo + (unsigned)i * rs))); } while (0)
#define TG_PROC(R_, dp_) do { \
        _Pragma("unroll") for (int i = 0; i < 16; ++i) { const v2u w = {pk2(R_[i].x, R_[i].y), pk2(R_[i].z, R_[i].w)}; *(LAS v2u*)(tile + wr_off + i * 640) = w; } \
        asm volatile("s_waitcnt lgkmcnt(0)" ::: "memory"); \
        _Pragma("unroll") for (int hb_ = 0; hb_ < 2; ++hb_) { v2u ta_[4], tb_[4]; \
            _Pragma("unroll") for (int jj = 0; jj < 4; ++jj) { \
                asm volatile("ds_read_b64_tr_b16 %0, %1 offset:%2" : "=&v"(ta_[jj]) : "v"(tbase + tr_off), "i"((4 * hb_ + jj) * 1280) : "memory"); \
                asm volatile("ds_read_b64_tr_b16 %0, %1 offset:%2" : "=&v"(tb_[jj]) : "v"(tbase + tr_off), "i"((4 * hb_ + jj) * 1280 + 640) : "memory"); } \
            asm volatile("s_waitcnt lgkmcnt(0)" : "+v"(ta_[0]), "+v"(ta_[1]), "+v"(ta_[2]), "+v"(ta_[3]), "+v"(tb_[0]), "+v"(tb_[1]), "+v"(tb_[2]), "+v"(tb_[3]) :: "memory"); \
            _Pragma("unroll") for (int jj = 0; jj < 4; ++jj) *(LAS v4u*)(tile + 10240 + lane * 144 + (4 * hb_ + jj) * 16) = (v4u){ta_[jj].x, ta_[jj].y, tb_[jj].x, tb_[jj].y}; } \
        asm volatile("s_waitcnt lgkmcnt(0)" ::: "memory"); \
        _Pragma("unroll") for (int hf_ = 0; hf_ < 2; ++hf_) { v4u ow_[4]; \
            _Pragma("unroll") for (int s_ = 0; s_ < 4; ++s_) ow_[s_] = *(const LAS v4u*)(tile + 10240 + (8 * (4 * hf_ + s_) + (lane >> 3)) * 144 + (lane & 7) * 16); \
            _Pragma("unroll") for (int s_ = 0; s_ < 4; ++s_) *(v4u*)(dp_ + (sto + (unsigned)(4 * hf_ + s_) * ds8)) = ow_[s_]; \
            asm volatile("" ::: "memory"); } \
        asm volatile("s_waitcnt lgkmcnt(0)" ::: "memory"); } while (0)
    f32x4 RA[16], RB[16]; const char* sA; const char* sB; char* dA; char* dB;
    int it = gw;
    if (it < total) { TG_SRC(it, sA, dA); TG_LOAD(RA, sA); }
    while (it < total) {
        const int i1 = it + ngw, i2 = it + 2 * ngw;
        if (i1 < total) { TG_SRC(i1, sB, dB); TG_LOAD(RB, sB); }
        TG_PROC(RA, dA);
        if (i1 >= total) break;
        if (i2 < total) { TG_SRC(i2, sA, dA); TG_LOAD(RA, sA); }
        TG_PROC(RB, dB);
        it = i2;
    }
#undef TG_SRC
#undef TG_LOAD
#undef TG_PROC
}
struct EpiInProj {
    static constexpr bool PERM = true;
    bf16 *QT, *VG, *SG, *FQ, *GG; float* GAFF;
    __device__ __forceinline__ void operator()(const f32x4 (&acc)[2][2][4][2], const pg8::Unit& u, int wr, int wc, int fr, int fq) const {
        const int pn = u.pn, row0 = u.pm * 256 + wr * 64 + fr, b = row0 >> 12, s0 = row0 & (SEQ - 1), cl = wc * 32 + 8 * fq;
        if (pn == 64) {
            if (wc == 0) {
#pragma unroll
                for (int ai = 0; ai < 2; ++ai)
#pragma unroll
                    for (int m = 0; m < 4; ++m) { float* d = GAFF + (size_t)(row0 + ai * 128 + m * 16) * 32 + 8 * fq; *(f32x4*)d = acc[ai][0][m][0]; *(f32x4*)(d + 4) = acc[ai][0][m][1]; }
            }
            return;
        }
        bf16* base0; bf16* base1; int rs, act = 0;
        if (pn < 8)       { base0 = QT + (size_t)(pn >> 2) * ((size_t)T * 1024) + (size_t)(b * 4 + (pn & 3)) * SEQ * 256 + cl; base1 = base0 + 128; rs = 256; }
        else if (pn < 16) { const int t = pn - 8; base0 = VG + (size_t)(b * 4 + (t >> 1)) * SEQ * 512 + 256 * (t & 1) + cl; base1 = base0 + 128; rs = 512; }
        else if (pn < 24) { base0 = SG + (size_t)b * SEQ * DM + 256 * (pn - 16) + cl; base1 = base0 + 128; rs = DM; act = 1; }
        else if (pn < 48) { const int t = (pn - 24) & 7; base0 = FQ + (size_t)((pn - 24) >> 3) * ((size_t)T * DM) + (size_t)(b * 16 + 2 * t) * SEQ * 128 + cl; base1 = base0 + (size_t)SEQ * 128; rs = 128; }
        else              { base0 = GG + (size_t)((pn - 48) >> 3) * ((size_t)T * DM) + (size_t)b * SEQ * DM + 256 * ((pn - 48) & 7) + cl; base1 = base0 + 128; rs = DM; act = 2; }
#pragma unroll
        for (int ai = 0; ai < 2; ++ai)
#pragma unroll
            for (int m = 0; m < 4; ++m) { const size_t ro = (size_t)(s0 + ai * 128 + m * 16) * rs;
#pragma unroll
                for (int bj = 0; bj < 2; ++bj) { f32x4 v0 = acc[ai][bj][m][0], v1 = acc[ai][bj][m][1];
                    if (act == 1) {
#pragma unroll
                        for (int j = 0; j < 4; ++j) { v0[j] = v0[j] * sigmoid_f(v0[j]); v1[j] = v1[j] * sigmoid_f(v1[j]); } }
                    else if (act == 2) {
#pragma unroll
                        for (int j = 0; j < 4; ++j) { v0[j] = sigmoid_f(v0[j]); v1[j] = sigmoid_f(v1[j]); } }
                    v4u w; w.x = pg8::cvt_pk_bf16(v0[0], v0[1]); w.y = pg8::cvt_pk_bf16(v0[2], v0[3]); w.z = pg8::cvt_pk_bf16(v1[0], v1[1]); w.w = pg8::cvt_pk_bf16(v1[2], v1[3]);
                    *(v4u*)((bj ? base1 : base0) + ro) = w; } }
    }
};


template <int STAGE> struct EpiGate {
    static constexpr bool PERM = true;
    bf16* Y; const bf16* G; bf16* M;
    __device__ __forceinline__ void operator()(const f32x4 (&acc)[2][2][4][2], const pg8::Unit& u, int wr, int wc, int fr, int fq) const {
        const size_t o00 = (size_t)(u.pm * 256 + wr * 64 + fr) * DM + u.pn * 256 + wc * 32 + 8 * fq;
#pragma unroll
        for (int ai = 0; ai < 2; ++ai) {
            v4u gw[4][2], yw[4][2];
#pragma unroll
            for (int m = 0; m < 4; ++m)
#pragma unroll
                for (int bj = 0; bj < 2; ++bj) { const size_t o = o00 + (size_t)(ai * 128 + m * 16) * DM + 128 * bj; gw[m][bj] = *(const v4u*)(G + o); if (STAGE == 1) yw[m][bj] = *(const v4u*)(Y + o); }
#pragma unroll
            for (int m = 0; m < 4; ++m)
#pragma unroll
                for (int bj = 0; bj < 2; ++bj) { const size_t o = o00 + (size_t)(ai * 128 + m * 16) * DM + 128 * bj; const v4u g = gw[m][bj];
                    const f32x4 g0 = {bf2f(g.x & 0xffffu), bf2f(g.x >> 16), bf2f(g.y & 0xffffu), bf2f(g.y >> 16)}, g1 = {bf2f(g.z & 0xffffu), bf2f(g.z >> 16), bf2f(g.w & 0xffffu), bf2f(g.w >> 16)};
                    f32x4 v0 = acc[ai][bj][m][0] * g0, v1 = acc[ai][bj][m][1] * g1;
                    if (STAGE == 1) { const v4u y = yw[m][bj]; v0 += (f32x4){bf2f(y.x & 0xffffu), bf2f(y.x >> 16), bf2f(y.y & 0xffffu), bf2f(y.y >> 16)}; v1 += (f32x4){bf2f(y.z & 0xffffu), bf2f(y.z >> 16), bf2f(y.w & 0xffffu), bf2f(y.w >> 16)}; }
                    *(v4u*)((STAGE == 0 ? Y : M) + o) = (v4u){pg8::cvt_pk_bf16(v0[0], v0[1]), pg8::cvt_pk_bf16(v0[2], v0[3]), pg8::cvt_pk_bf16(v1[0], v1[1]), pg8::cvt_pk_bf16(v1[2], v1[3])}; }
        }
    }
};
template <bool XBF16, bool BBF16> struct EpiRes {
    static constexpr bool PERM = true;
    const float* base; float* X; const float* gain; bf16* H; float* RSS;
    __device__ __forceinline__ void operator()(const f32x4 (&acc)[2][2][4][2], const pg8::Unit& u, int wr, int wc, int fr, int fq) const {
        const int row0 = u.pm * 256 + wr * 64 + fr, col0 = u.pn * 256 + wc * 32 + 8 * fq;
        f32x4 gv[2][2];
#pragma unroll
        for (int bj = 0; bj < 2; ++bj) { gv[bj][0] = *(const f32x4*)(gain + col0 + 128 * bj); gv[bj][1] = *(const f32x4*)(gain + col0 + 128 * bj + 4); }
#pragma unroll
        for (int ai = 0; ai < 2; ++ai) {
            f32x4 b0[4][2], b1[4][2];
#pragma unroll
            for (int m = 0; m < 4; ++m)
#pragma unroll
                for (int bj = 0; bj < 2; ++bj) { const size_t o = (size_t)(row0 + ai * 128 + m * 16) * DM + col0 + 128 * bj;
                    if (BBF16) { const v4u w = *(const v4u*)((const bf16*)base + o); b0[m][bj] = (f32x4){bf2f(w.x & 0xffffu), bf2f(w.x >> 16), bf2f(w.y & 0xffffu), bf2f(w.y >> 16)}; b1[m][bj] = (f32x4){bf2f(w.z & 0xffffu), bf2f(w.z >> 16), bf2f(w.w & 0xffffu), bf2f(w.w >> 16)}; }
                    else { b0[m][bj] = *(const f32x4*)(base + o); b1[m][bj] = *(const f32x4*)(base + o + 4); } }
#pragma unroll
            for (int m = 0; m < 4; ++m) { const int row = row0 + ai * 128 + m * 16; float ss = 0.f;
#pragma unroll
                for (int bj = 0; bj < 2; ++bj) { const size_t o = (size_t)row * DM + col0 + 128 * bj;
                    const f32x4 v0 = acc[ai][bj][m][0] + b0[m][bj], v1 = acc[ai][bj][m][1] + b1[m][bj];
                    if (XBF16) *(v4u*)((bf16*)X + o) = (v4u){pg8::cvt_pk_bf16(v0[0], v0[1]), pg8::cvt_pk_bf16(v0[2], v0[3]), pg8::cvt_pk_bf16(v1[0], v1[1]), pg8::cvt_pk_bf16(v1[2], v1[3])};
                    else { *(f32x4*)(X + o) = v0; *(f32x4*)(X + o + 4) = v1; }
                    ss += (v0[0] * v0[0] + v0[1] * v0[1] + v0[2] * v0[2] + v0[3] * v0[3]) + (v1[0] * v1[0] + v1[1] * v1[1] + v1[2] * v1[2] + v1[3] * v1[3]);
                    const f32x4 h0 = v0 * gv[bj][0], h1 = v1 * gv[bj][1];
                    *(v4u*)(H + o) = (v4u){pg8::cvt_pk_bf16(h0[0], h0[1]), pg8::cvt_pk_bf16(h0[2], h0[3]), pg8::cvt_pk_bf16(h1[0], h1[1]), pg8::cvt_pk_bf16(h1[2], h1[3])}; }
                ss += __shfl_xor(ss, 16); ss += __shfl_xor(ss, 32);
                if (fq == 0) RSS[(size_t)row * 32 + u.pn * 4 + wc] = ss; }
        }
    }
};

constexpr int MT_BASE = CTLW + 1024, MT_NRT = MT_BASE, MT_CNT = MT_BASE + 16, MT_PBASE = MT_CNT + 32 * 4, MT_TE = MT_PBASE + 36 * 4, MT_TP = MT_TE + MAXRT * 4, MT_END = MT_TP + MAXRT * 4;
static_assert(MT_END <= LDS_BYTES && gla::LDS_BYTES <= CTLW && fa::LDS_BYTES <= CTLW, "LDS map");
__device__ __forceinline__ void moe_tables(LAS unsigned char* lds, unsigned* ctl) {
    LAS int* nrt = (LAS int*)(lds + MT_NRT); LAS int* cnt = (LAS int*)(lds + MT_CNT); LAS int* pbase = (LAS int*)(lds + MT_PBASE); LAS int* te = (LAS int*)(lds + MT_TE); LAS int* tp = (LAS int*)(lds + MT_TP);
    __syncthreads();
    if (threadIdx.x < 64) {
        const int lane = threadIdx.x;
        const int c = lane < NE ? (int)xb_ld(ctl + CW_CNT + lane) : 0;
        const int nt = (c + 255) >> 8;
        int pre = nt;
#pragma unroll
        for (int o = 1; o < 32; o <<= 1) { const int y = __shfl_up(pre, o); if (lane >= o) pre += y; }
        const int first = pre - nt;
        if (lane < NE) { cnt[lane] = c; pbase[lane] = first * 256; for (int k = 0; k < nt; ++k) { te[first + k] = lane; tp[first + k] = k * 256; } }
        if (lane == NE - 1) { pbase[NE] = pre * 256; nrt[0] = pre; } }
    __syncthreads();
}
constexpr int SIDE_OFF = RING_BYTES, SIDE_STRIDE = 3072;
static_assert(SIDE_OFF + 3 * SIDE_STRIDE <= CTLW, "side tables");
template <bool UP> struct MoeOrder {
    static constexpr bool SIDE = true;
    LAS unsigned char* lds; const int* tokl; const float* rowscale; const float* bias; int nN, G, c;
    __device__ __forceinline__ bool next(int i, pg8::Unit& u) const {
        const int nrt = *(const LAS int*)(lds + MT_NRT); int rt, pn;
        if (G == 256) { const int x = c & 7, j = c >> 3, s = i * 8 + x, parts = nN >> 2, rg = s / parts, ph = s - rg * parts;
            rt = 8 * rg + (j >> 2); pn = 4 * ph + (j & 3); if (rt >= nrt) return false; }
        else { const long L = (long)i * G + c; if (L >= (long)nrt * nN) return false; rt = (int)(L / nN); pn = (int)(L % nN); }
        u.pm = rt; u.pn = pn; u.pb = ((const LAS int*)(lds + MT_TE))[rt] * nN + pn; u.kofs = 0; return true;
    }
    __device__ __forceinline__ void prefetch(const pg8::Unit& u, int sb, int wid, int lane) const {
        if (wid != 0) return;
        const int e = ((const LAS int*)(lds + MT_TE))[u.pm], p0 = ((const LAS int*)(lds + MT_TP))[u.pm];
        LAS unsigned char* dst = lds + SIDE_OFF + sb * SIDE_STRIDE;
        if (UP) __builtin_amdgcn_global_load_lds((const unsigned*)(tokl + (size_t)e * T + p0 + 4 * lane), (LAS unsigned*)dst, 16, 0, 0);
        __builtin_amdgcn_global_load_lds((const unsigned*)(rowscale + (size_t)e * T + p0 + 4 * lane), (LAS unsigned*)(dst + 1024), 16, 0, 0);
        const float* bsrc = UP ? bias + (size_t)e * 4096 + 128 * u.pn + (lane < 32 ? 4 * lane : 2048 + 4 * (lane - 32)) : bias + (size_t)e * DM + 256 * u.pn + 4 * lane;
        __builtin_amdgcn_global_load_lds((const unsigned*)bsrc, (LAS unsigned*)(dst + 2048), 16, 0, 0);
    }
    __device__ __forceinline__ const LAS int* tok_table(int sb) const { return (const LAS int*)(lds + SIDE_OFF + sb * SIDE_STRIDE); }
    __device__ __forceinline__ void a_ready(const pg8::Unit&) const {}
    __device__ __forceinline__ void done(const pg8::Unit&) const {}
};
struct EpiSwiglu {
    static constexpr bool PERM = true;
    bf16* act; LAS unsigned char* lds;
    __device__ __forceinline__ void operator()(const f32x4 (&acc)[2][2][4][2], const pg8::Unit& u, int wr, int wc, int fr, int fq) const {
        const int col = 128 * u.pn + wc * 32 + 8 * fq;
        const LAS unsigned char* side = lds + SIDE_OFF + u.sb * SIDE_STRIDE;
        const LAS float* rrow = (const LAS float*)(side + 1024) + wr * 64 + fr;
        const LAS float* bg = (const LAS float*)(side + 2048) + wc * 32 + 8 * fq;
        const f32x4 bg0 = *(const LAS f32x4*)bg, bg1 = *(const LAS f32x4*)(bg + 4), bl0 = *(const LAS f32x4*)(bg + 128), bl1 = *(const LAS f32x4*)(bg + 132);
        bf16* dst = act + (size_t)(u.pm * 256 + wr * 64 + fr) * DM + col;
#pragma unroll
        for (int ai = 0; ai < 2; ++ai)
#pragma unroll
            for (int m = 0; m < 4; ++m) {
                const float rs = rrow[ai * 128 + m * 16];
                const f32x4 g0 = acc[ai][0][m][0] * rs + bg0, g1 = acc[ai][0][m][1] * rs + bg1, l0 = acc[ai][1][m][0] * rs + bl0, l1 = acc[ai][1][m][1] * rs + bl1;
                float o[8];
#pragma unroll
                for (int j = 0; j < 4; ++j) { const float ga = fminf(g0[j], 7.f), gb = fminf(g1[j], 7.f), la_ = fminf(fmaxf(l0[j], -7.f), 7.f), lb = fminf(fmaxf(l1[j], -7.f), 7.f);
                    o[j] = ga * sigmoid_f(1.702f * ga) * (la_ + 1.f); o[4 + j] = gb * sigmoid_f(1.702f * gb) * (lb + 1.f); }
                *(v4u*)(dst + (size_t)(ai * 128 + m * 16) * DM) = (v4u){pg8::cvt_pk_bf16(o[0], o[1]), pg8::cvt_pk_bf16(o[2], o[3]), pg8::cvt_pk_bf16(o[4], o[5]), pg8::cvt_pk_bf16(o[6], o[7])};
            }
    }
};
struct EpiDown {
    static constexpr bool PERM = true;
    bf16* yb; LAS unsigned char* lds;
    __device__ __forceinline__ void operator()(const f32x4 (&acc)[2][2][4][2], const pg8::Unit& u, int wr, int wc, int fr, int fq) const {
        const int col = 256 * u.pn + wc * 32 + 8 * fq;
        const LAS unsigned char* side = lds + SIDE_OFF + u.sb * SIDE_STRIDE;
        const LAS float* wrow = (const LAS float*)(side + 1024) + wr * 64 + fr;
        const LAS float* bb = (const LAS float*)(side + 2048) + wc * 32 + 8 * fq; f32x4 bv[2][2];
#pragma unroll
        for (int bj = 0; bj < 2; ++bj) { bv[bj][0] = *(const LAS f32x4*)(bb + 128 * bj); bv[bj][1] = *(const LAS f32x4*)(bb + 128 * bj + 4); }
        bf16* dst = yb + (size_t)(u.pm * 256 + wr * 64 + fr) * DM + col;
#pragma unroll
        for (int ai = 0; ai < 2; ++ai)
#pragma unroll
            for (int m = 0; m < 4; ++m) { const float gt = wrow[ai * 128 + m * 16];
#pragma unroll
                for (int bj = 0; bj < 2; ++bj) { const f32x4 v0 = (acc[ai][bj][m][0] + bv[bj][0]) * gt, v1 = (acc[ai][bj][m][1] + bv[bj][1]) * gt;
                    *(v4u*)(dst + (size_t)(ai * 128 + m * 16) * DM + 128 * bj) = (v4u){pg8::cvt_pk_bf16(v0[0], v0[1]), pg8::cvt_pk_bf16(v0[2], v0[3]), pg8::cvt_pk_bf16(v1[0], v1[1]), pg8::cvt_pk_bf16(v1[2], v1[3])}; } }
    }
};
__device__ __forceinline__ void transpose_job_up(Frame& F, const float* W, bf16* WT) {
    LAS float* scr = (LAS float*)(F.lds + F.wave * 16384);
    constexpr int K = DM, N = 4096, per = (K / 64) * (N / 32); const long total = (long)per * NE;
    for (long it = F.gw; it < total; it += F.ngw) { const int e = (int)(it / per), item = (int)(it % per), lane = F.lane;
        const float* Wp = W + (size_t)e * K * N; bf16* WTp = WT + (size_t)e * N * K;
        const int nblk = N / 32, kb = item / nblk, nb = item % nblk, k0 = 64 * kb, n0 = 32 * nb;
        const int m0 = n0 & 2047, r0 = 256 * (m0 >> 7) + (n0 >= 2048 ? 128 : 0) + (m0 & 127);
#pragma unroll 8
        for (int i = 0; i < 32; ++i) { const int kk = 2 * i + (lane >> 5); scr[kk * 33 + (lane & 31)] = Wp[(size_t)(k0 + kk) * N + n0 + (lane & 31)]; }
        LDS_WAIT(); asm volatile("" ::: "memory");
        const int c = lane & 7;
#pragma unroll
        for (int j = 0; j < 4; ++j) { const int n = (lane >> 3) + 8 * j; const LAS float* sp = scr + (8 * c) * 33 + n;
            v4u o; o.x = pk2(sp[0 * 33], sp[1 * 33]); o.y = pk2(sp[2 * 33], sp[3 * 33]); o.z = pk2(sp[4 * 33], sp[5 * 33]); o.w = pk2(sp[6 * 33], sp[7 * 33]);
            *(v4u*)(WTp + (size_t)(r0 + n) * K + k0 + 8 * c) = o; }
        LDS_WAIT(); asm volatile("" ::: "memory");
    }
}


__device__ __forceinline__ void convert_expert_share(LAS unsigned char* lds, const float* Wup, const float* Wdn, bf16* WtUp, bf16* WtDn, int sh) {
    int t_ = threadIdx.x; asm volatile("" : "+v"(t_));
    const int wid = __builtin_amdgcn_readfirstlane(t_ >> 6), lane = t_ & 63;
    const int e = sh >> 3, part = sh & 7;
    LAS unsigned char* tile = lds + wid * 19456;
    const unsigned tbase = (unsigned)(size_t)tile;
    const int lr = lane >> 4, lc = lane & 15;
    const int g = lane >> 4, q = (lane & 15) >> 2, p = lane & 3;
    const unsigned wr_off = (unsigned)(lr * 160 + lc * 8), tr_off = (unsigned)(q * 160 + (g * 16 + 4 * p) * 2);
#define CES_SRC(it_, src_, N_, n0_, k0_, dst_, up_) do { const int it__ = (it_); \
        if (it__ < 32) { const int id = it__ * 8 + wid, kb = id >> 3, nb = id & 7; N_ = 4096; n0_ = part * 512 + nb * 64; k0_ = kb * 64; src_ = Wup + (size_t)e * DM * 4096; dst_ = WtUp + (size_t)e * 4096 * DM; up_ = true; } \
        else { const int id = (it__ - 32) * 8 + wid, kb = id >> 2, nb = id & 3; N_ = DM; n0_ = part * 256 + nb * 64; k0_ = kb * 64; src_ = Wdn + (size_t)e * DM * DM; dst_ = WtDn + (size_t)e * DM * DM; up_ = false; } } while (0)
#define CES_LOAD(R_, src_, N_, n0_, k0_) do { _Pragma("unroll") for (int i = 0; i < 16; ++i) R_[i] = __builtin_nontemporal_load((const f32x4*)(src_ + (size_t)(k0_ + 4 * i + lr) * N_ + n0_ + 4 * lc)); } while (0)
#define CES_PROC(R_, dst_, UP_, n0_, k0_) do { \
        _Pragma("unroll") for (int i = 0; i < 16; ++i) { const v2u w = {pk2(R_[i].x, R_[i].y), pk2(R_[i].z, R_[i].w)}; *(LAS v2u*)(tile + wr_off + i * 640) = w; } \
        asm volatile("s_waitcnt lgkmcnt(0)" ::: "memory"); \
          \
        _Pragma("unroll") for (int hb_ = 0; hb_ < 2; ++hb_) { v2u ta_[4], tb_[4]; \
            _Pragma("unroll") for (int jj = 0; jj < 4; ++jj) { \
                asm volatile("ds_read_b64_tr_b16 %0, %1 offset:%2" : "=&v"(ta_[jj]) : "v"(tbase + tr_off), "i"((4 * hb_ + jj) * 1280) : "memory"); \
                asm volatile("ds_read_b64_tr_b16 %0, %1 offset:%2" : "=&v"(tb_[jj]) : "v"(tbase + tr_off), "i"((4 * hb_ + jj) * 1280 + 640) : "memory"); } \
            asm volatile("s_waitcnt lgkmcnt(0)" : "+v"(ta_[0]), "+v"(ta_[1]), "+v"(ta_[2]), "+v"(ta_[3]), "+v"(tb_[0]), "+v"(tb_[1]), "+v"(tb_[2]), "+v"(tb_[3]) :: "memory"); \
            _Pragma("unroll") for (int jj = 0; jj < 4; ++jj) *(LAS v4u*)(tile + 10240 + lane * 144 + (4 * hb_ + jj) * 16) = (v4u){ta_[jj].x, ta_[jj].y, tb_[jj].x, tb_[jj].y}; } \
        asm volatile("s_waitcnt lgkmcnt(0)" ::: "memory"); \
          \
        _Pragma("unroll") for (int hf_ = 0; hf_ < 2; ++hf_) { v4u ow_[4]; \
            _Pragma("unroll") for (int s_ = 0; s_ < 4; ++s_) ow_[s_] = *(const LAS v4u*)(tile + 10240 + (8 * (4 * hf_ + s_) + (lane >> 3)) * 144 + (lane & 7) * 16); \
            _Pragma("unroll") for (int s_ = 0; s_ < 4; ++s_) { const int n = n0_ + 8 * (4 * hf_ + s_) + (lane >> 3); \
                const int m0 = n & 2047, drow = UP_ ? 256 * (m0 >> 7) + (n >= 2048 ? 128 : 0) + (m0 & 127) : n; \
                __builtin_nontemporal_store(ow_[s_], (v4u*)(dst_ + (size_t)drow * DM + k0_ + 8 * (lane & 7))); } \
            asm volatile("" ::: "memory"); } \
        asm volatile("s_waitcnt lgkmcnt(0)" ::: "memory"); } while (0)
    f32x4 RA[16], RB[16], RC[16];
    const float* sA; const float* sB; const float* sC; bf16* dA; bf16* dB; bf16* dC; int NA, NB_, NC, n0A, n0B, n0C, k0A, k0B, k0C; bool uA, uB, uC;
    CES_SRC(0, sA, NA, n0A, k0A, dA, uA); CES_LOAD(RA, sA, NA, n0A, k0A);
    CES_SRC(1, sB, NB_, n0B, k0B, dB, uB); CES_LOAD(RB, sB, NB_, n0B, k0B);
    for (int it = 0; it < 48; it += 3) {
        CES_SRC(it + 2, sC, NC, n0C, k0C, dC, uC); CES_LOAD(RC, sC, NC, n0C, k0C);
        CES_PROC(RA, dA, uA, n0A, k0A);
        if (it + 3 < 48) { CES_SRC(it + 3, sA, NA, n0A, k0A, dA, uA); CES_LOAD(RA, sA, NA, n0A, k0A); }
        CES_PROC(RB, dB, uB, n0B, k0B);
        if (it + 4 < 48) { CES_SRC(it + 4, sB, NB_, n0B, k0B, dB, uB); CES_LOAD(RB, sB, NB_, n0B, k0B); }
        CES_PROC(RC, dC, uC, n0C, k0C);
    }
#undef CES_SRC
#undef CES_LOAD
#undef CES_PROC
}

__global__ void __launch_bounds__(NWAVES * 64, 2) mk_fwd(Args args) {
    extern __shared__ __attribute__((aligned(16))) unsigned char lds_raw[];
    Frame F;
    F.lds = (LAS unsigned char*)lds_raw;
    F.tid = threadIdx.x; F.lane = F.tid & 63; F.wave = __builtin_amdgcn_readfirstlane(F.tid >> 6);
    F.G = gridDim.x; F.bid = blockIdx.x; F.gw = F.bid * NWAVES + F.wave; F.ngw = F.G * NWAVES;
    unsigned char* ws = args.ws;
    unsigned* ctl = (unsigned*)(ws + WS_CTL);
    for (int u = F.tid; u < (LDS_BYTES - CTLW) / 4; u += NWAVES * 64) ((LAS unsigned*)(F.lds + CTLW))[u] = 0u;
    __syncthreads();
    XcdBarrier bar = xcd_barrier_post(ctl + CW_BAR, (volatile LAS unsigned*)(F.lds + CTLW + 64));
#define GRID_BAR(k) do { if (IN(k) && IN((k) + 1)) xcd_barrier(bar); } while (0)
    const float* x = args.in[0]; const float* mem = args.in[1];
    bf16* WtIn = (bf16*)(ws + WS_WTIN); bf16* WtBg = (bf16*)(ws + WS_WTBG); bf16* WtBf = (bf16*)(ws + WS_WTBF); bf16* WtOut = (bf16*)(ws + WS_WTOUT);
    bf16* WtMq = (bf16*)(ws + WS_WTMQ); bf16* WtMkv = (bf16*)(ws + WS_WTMKV); bf16* WtMo = (bf16*)(ws + WS_WTMO); bf16* WtUp = (bf16*)(ws + WS_WTUP); bf16* WtDn = (bf16*)(ws + WS_WTDN);
    bf16* WrT = (bf16*)(ws + WS_WRT); bf16* yb = (bf16*)(ws + WS_YB); int* tokl = (int*)(ws + WS_TOKL); float* wl = (float*)(ws + WS_WL); float* rsl = (float*)(ws + WS_RSL); float* RSS1 = (float*)(ws + WS_RSS1); float* RSS2 = (float*)(ws + WS_RSS2); float* logits = (float*)(ws + WS_LOG);
    bf16* QT = (bf16*)(ws + WS_QT); bf16* KT = (bf16*)(ws + WS_KT); bf16* VG = (bf16*)(ws + WS_VG); float* EBL = (float*)(ws + WS_EBL); bf16* AT = (bf16*)(ws + WS_AT);
    bf16* SG = (bf16*)(ws + WS_SG); bf16* GG = (bf16*)(ws + WS_GG); bf16* GF = (bf16*)(ws + WS_GF); float* GAFF = (float*)(ws + WS_GAFF);
    float* ogla = (float*)(ws + WS_OGLA); float* Y1 = (float*)(ws + WS_Y1); float* Y2 = (float*)(ws + WS_Y2); float* X1 = (float*)(ws + WS_X1); float* X2 = (float*)(ws + WS_X2);
    bf16* hb = (bf16*)(ws + WS_H); bf16* attb = (bf16*)(ws + WS_ATT); bf16* onb = (bf16*)(ws + WS_ON); bf16* mrg = (bf16*)(ws + WS_MRG); bf16* h2 = (bf16*)(ws + WS_H2); bf16* xs = (bf16*)(ws + WS_XS);
    bf16* om = (bf16*)(ws + WS_OM); bf16* mn = (bf16*)(ws + WS_MN); float* qm = (float*)(ws + WS_QM); float* kv = (float*)(ws + WS_KV);
    bf16* act = (bf16*)(ws + WS_ACT);
    int* asg_e = (int*)(ws + WS_ASG); int* asg_pos = asg_e + NASG;
    bf16* fqh = (bf16*)(ws + WS_FQH); bf16* fkh = (bf16*)(ws + WS_FKH); bf16* fvh = (bf16*)(ws + WS_FVH); float* cbias = (float*)(ws + WS_CB);
    bf16* qmb = (bf16*)(ws + WS_QMB); bf16* knb = (bf16*)(ws + WS_KNB); bf16* vb = (bf16*)(ws + WS_VB);
    const int lo = args.ph_lo, hi = args.ph_hi;
#define IN(k) (lo <= (k) && (k) < hi)
#define REFRESH() do { int t_ = threadIdx.x; asm volatile("" : "+v"(t_)); F.tid = t_; F.lane = t_ & 63; F.wave = __builtin_amdgcn_readfirstlane(t_ >> 6); F.gw = F.bid * NWAVES + F.wave; } while (0)

    if (IN(0)) { REFRESH();
        transpose_win64(F.lds, args.in[3], WtIn, F.gw, F.ngw);
        __syncthreads();
        transpose_win(F, args.in[3], WtIn);
        { v4u* z = (v4u*)(WtIn + (size_t)(64 * 256 + 32) * DM); const int nz = (INCP - INC) * DM / 8; for (int i = F.bid * 512 + F.tid; i < nz; i += F.G * 512) z[i] = (v4u){0u, 0u, 0u, 0u}; }
        for (int m = F.gw; m < T; m += 2 * F.ngw) {
            const int m2 = m + F.ngw;
            if (m2 < T) rms_rows2_bf16(x + (size_t)m * DM, x + (size_t)m2 * DM, args.in[2], hb + (size_t)m * DM, hb + (size_t)m2 * DM, F.lane);
            else rms_row_bf16(x + (size_t)m * DM, args.in[2], hb + (size_t)m * DM, F.lane); }
    }
    GRID_BAR(0);
    if (IN(1)) { REFRESH();
        pg8::Gemm g{hb, WtIn, T, 16384, DM}; pg8::StaticOrder S; S.init(T, 16384, F.G, F.bid);
        EpiInProj E{QT, VG, SG, fqh, GG, GAFF};
        { const int r0 = F.bid & 15; pg8::StaticOrder Sa = S; Sa.iend = r0;
          pg8::gemm_phase<EpiInProj, pg8::StaticOrder>(F.lds, g, Sa, E);
          __syncthreads();
          for (int sh = F.bid; sh < 256; sh += F.G) convert_expert_share(F.lds, args.in[23], args.in[25], WtUp, WtDn, sh);
          __syncthreads();
          transpose64(F.lds, args.in[10], DM, DM, WtBg, F.gw, F.ngw);
          transpose64(F.lds, args.in[11], DM, DM, WtBf, F.gw, F.ngw);
          transpose64(F.lds, args.in[12], DM, DM, WtOut, F.gw, F.ngw);
          transpose64(F.lds, args.in[15], DM, 512, WtMq, F.gw, F.ngw);
          transpose64(F.lds, args.in[16], DM, 1024, WtMkv, F.gw, F.ngw);
          transpose64(F.lds, args.in[19], 512, DM, WtMo, F.gw, F.ngw);
          __syncthreads();
          transpose_job(F, args.in[21], DM, NE, 1, WrT);
          { v4u* z = (v4u*)tokl; const int nz = NE * T / 4; for (int i = F.bid * 512 + F.tid; i < nz; i += F.G * 512) z[i] = (v4u){0u, 0u, 0u, 0u}; }
          { v4u* z = (v4u*)(WrT + (size_t)NE * DM); const int nz = (256 - NE) * DM / 8; for (int i = F.bid * 512 + F.tid; i < nz; i += F.G * 512) z[i] = (v4u){0u, 0u, 0u, 0u}; }
          for (int m = F.gw; m < NB * MEML; m += F.ngw) rms_row_bf16(mem + (size_t)m * DM, args.in[14], mn + (size_t)m * DM, F.lane);
          __syncthreads();
          S.i0 = r0; }
        static_assert(WS_KT == WS_QT + (size_t)T * 1024 * 2 && WS_FKH == WS_FQH + (size_t)T * DM * 2 && WS_FVH == WS_FKH + (size_t)T * DM * 2 && WS_GF == WS_GG + (size_t)T * DM * 2, "epilogue pointer arithmetic");
        pg8::gemm_phase<EpiInProj, pg8::StaticOrder>(F.lds, g, S, E);
        { pg8::Gemm g2{hb, WtIn + (size_t)16384 * DM, T, 256, 512, DM}; pg8::SplitOrder S2{64, 1, 4, 512, F.G, F.bid}; pg8::EpiN32 E2{GAFF, 128};
          pg8::gemm_phase<pg8::EpiN32, pg8::SplitOrder>(F.lds, g2, S2, E2); }
    }
    GRID_BAR(1);
    if (IN(2)) { REFRESH();
        const float* aup = args.in[4]; const float* abias = args.in[5];
        LAS float* gaL = (LAS float*)F.lds;
        LAS float* bL = (LAS float*)(F.lds + 4096);
        for (int job = F.bid; job < 16 * 64; job += F.G) {
            const int bh = job >> 6, c = job & 63, b = bh >> 2, h = bh & 3; const size_t tok0 = (size_t)b * SEQ + c * 64;
            __syncthreads();
            if (F.tid < 256) { const float* gp_ = GAFF + (tok0 + (F.tid >> 2)) * 128 + 4 * (F.tid & 3); *(LAS f32x4*)(gaL + (F.tid >> 2) * 16 + 4 * (F.tid & 3)) = (*(const f32x4*)gp_ + *(const f32x4*)(gp_ + 32)) + (*(const f32x4*)(gp_ + 64) + *(const f32x4*)(gp_ + 96)); }
            __syncthreads();
            const int k = F.tid & 255, half = F.tid >> 8;
            { float au[16];
#pragma unroll
              for (int r = 0; r < 16; ++r) au[r] = aup[r * 1024 + h * 256 + k];
              const float ab = abias[h * 256 + k]; float run = 0.f;
#pragma unroll 4
              for (int tt = 0; tt < 32; ++tt) { const int t = 32 * half + tt; float a = ab;
#pragma unroll
                for (int r4 = 0; r4 < 4; ++r4) { const f32x4 g4 = *(const LAS f32x4*)(gaL + t * 16 + 4 * r4); a += g4.x * au[4 * r4] + g4.y * au[4 * r4 + 1] + g4.z * au[4 * r4 + 2] + g4.w * au[4 * r4 + 3]; }
                run += log_sigmoid_f(a) * (1.0f / 16.0f); bL[t * 256 + k] = run; } }
            __syncthreads();
            { const float add = half ? bL[31 * 256 + k] : 0.f;
              __syncthreads();
              if (half) {
#pragma unroll 8
                for (int tt = 0; tt < 32; ++tt) bL[(32 + tt) * 256 + k] += add; } }
            __syncthreads();
            if (F.tid < 256) EBL[((size_t)bh * 64 + c) * 256 + F.tid] = __expf(bL[63 * 256 + F.tid]);
            { bf16* qb = QT + ((size_t)bh * SEQ + c * 64) * 256; bf16* kb = KT + ((size_t)bh * SEQ + c * 64) * 256;
              v4u qv[4], kv_[4];
#pragma unroll
              for (int i = 0; i < 4; ++i) { const int it = F.tid + 512 * i, t = it >> 5, cg = it & 31; qv[i] = *(const v4u*)(qb + t * 256 + 8 * cg); kv_[i] = *(const v4u*)(kb + t * 256 + 8 * cg); }
#pragma unroll
              for (int i = 0; i < 4; ++i) { const int it = F.tid + 512 * i, t = it >> 5, cg = it & 31;
                const f32x4 b0 = *(const LAS f32x4*)(bL + t * 256 + 8 * cg), b1 = *(const LAS f32x4*)(bL + t * 256 + 8 * cg + 4);
                const float eb[8] = {__expf(b0.x), __expf(b0.y), __expf(b0.z), __expf(b0.w), __expf(b1.x), __expf(b1.y), __expf(b1.z), __expf(b1.w)};
                const unsigned qw[4] = {qv[i].x, qv[i].y, qv[i].z, qv[i].w}, kw[4] = {kv_[i].x, kv_[i].y, kv_[i].z, kv_[i].w}; unsigned qo[4], ko[4];
#pragma unroll
                for (int j = 0; j < 4; ++j) { const float e0 = eb[2 * j], e1 = eb[2 * j + 1];
                    qo[j] = pk2(bf2f(qw[j] & 0xffffu) * e0 * (1.0f / 16.0f), bf2f(qw[j] >> 16) * e1 * (1.0f / 16.0f));
                    ko[j] = pk2(bf2f(kw[j] & 0xffffu) * __builtin_amdgcn_rcpf(e0), bf2f(kw[j] >> 16) * __builtin_amdgcn_rcpf(e1)); }
                *(v4u*)(qb + t * 256 + 8 * cg) = (v4u){qo[0], qo[1], qo[2], qo[3]}; *(v4u*)(kb + t * 256 + 8 * cg) = (v4u){ko[0], ko[1], ko[2], ko[3]}; } }
            VM_WAIT(); __syncthreads();
            if (F.wave < 3) gla::apass_job(QT, KT, AT, job * 3 + F.wave, F.lane);
        }
        for (int job = F.bid - (F.G - 64); job >= 0 && job < NB * 16; job += F.G) {
            const int b = job >> 4, h = job & 15; const float fb = args.in[7][h];
            LAS double* wsum = (LAS double*)(F.lds + 4096 + 65536);
            float xv[8];
#pragma unroll
            for (int j = 0; j < 8; ++j) { const float* gp_ = GAFF + (size_t)(b * SEQ + 8 * F.tid + j) * 128 + 16 + h; xv[j] = log_sigmoid_f((gp_[0] + gp_[32]) + (gp_[64] + gp_[96]) + fb); }
            double loc = 0.0;
#pragma unroll
            for (int j = 0; j < 8; ++j) loc += (double)xv[j];
            double pre = loc;
#pragma unroll
            for (int o = 1; o < 64; o <<= 1) { const double y = __shfl_up(pre, o); if (F.lane >= o) pre += y; }
            __syncthreads();
            if (F.lane == 63) wsum[F.wave] = pre;
            __syncthreads();
            double run = pre - loc;
            for (int w = 0; w < F.wave; ++w) run += wsum[w];
#pragma unroll
            for (int j = 0; j < 8; ++j) { run += (double)xv[j]; cbias[(size_t)(b * 16 + h) * SEQ + 8 * F.tid + j] = (float)(-run * (double)(1.0f / fa::SCALE)); }
        }
        { int tl_ = threadIdx.x; asm volatile("" : "+v"(tl_));
          const int l16 = tl_ & 15, rsub = (tl_ & 63) >> 4;
          const f32x4 gq0 = *(const f32x4*)(args.in[8] + 8 * l16), gq1 = *(const f32x4*)(args.in[8] + 8 * l16 + 4), gk0 = *(const f32x4*)(args.in[9] + 8 * l16), gk1 = *(const f32x4*)(args.in[9] + 8 * l16 + 4);
#define QKN_LOAD(W_, r0_) do { _Pragma("unroll") for (int i = 0; i < 4; ++i) W_[i] = *(const v4u*)(fqh + (size_t)((r0_) + 4 * i + rsub) * 128 + 8 * l16); } while (0)
#define QKN_PROC(W_, r0_) do { const bool isk_ = (r0_) >= T * 16; const f32x4 g0 = isk_ ? gk0 : gq0, g1 = isk_ ? gk1 : gq1; \
            _Pragma("unroll") for (int i = 0; i < 4; ++i) { \
                float v[8] = {bf2f(W_[i].x & 0xffffu), bf2f(W_[i].x >> 16), bf2f(W_[i].y & 0xffffu), bf2f(W_[i].y >> 16), bf2f(W_[i].z & 0xffffu), bf2f(W_[i].z >> 16), bf2f(W_[i].w & 0xffffu), bf2f(W_[i].w >> 16)}; \
                float ss = 0.f; \
                _Pragma("unroll") for (int j = 0; j < 8; ++j) ss += v[j] * v[j]; \
                ss += __shfl_xor(ss, 1); ss += __shfl_xor(ss, 2); ss += __shfl_xor(ss, 4); ss += __shfl_xor(ss, 8); \
                const float r = 1.0f / sqrtf(ss * (1.f / 128.f) + EPS); \
                *(v4u*)(fqh + (size_t)((r0_) + 4 * i + rsub) * 128 + 8 * l16) = (v4u){pk2(v[0] * r * g0.x, v[1] * r * g0.y), pk2(v[2] * r * g0.z, v[3] * r * g0.w), pk2(v[4] * r * g1.x, v[5] * r * g1.y), pk2(v[6] * r * g1.z, v[7] * r * g1.w)}; } } while (0)
          const int step = F.ngw * 16, end = T * 32;
          v4u wa[4], wb[4];
          int r0 = F.gw * 16;
          if (r0 < end) { QKN_LOAD(wa, r0);
            for (;;) {
              const int r1 = r0 + step, r2 = r1 + step;
              if (r1 < end) QKN_LOAD(wb, r1);
              QKN_PROC(wa, r0);
              if (r1 >= end) break;
              if (r2 < end) QKN_LOAD(wa, r2);
              QKN_PROC(wb, r1);
              if (r2 >= end) break;
              r0 = r2;
            } }
#undef QKN_LOAD
#undef QKN_PROC
        }
    }
    GRID_BAR(2);
    if (IN(3)) { REFRESH();
        for (int item = F.bid; item < 64; item += F.G) {
            const int bh = item >> 2, grp = item & 3, b = bh >> 2, h = bh & 3;
            gla::ScanRef R{QT + (size_t)bh * SEQ * 256, KT + (size_t)bh * SEQ * 256, VG + (size_t)bh * SEQ * 512 + 128 * grp, AT + (size_t)bh * 64 * 64 * 64, EBL + (size_t)bh * 64 * 256,
                           ogla + (size_t)b * SEQ * DM + h * 512 + 128 * grp};
            gla::scan_item(R, F.lds);
            VM_WAIT(); __syncthreads();
            if (F.tid == 0) {
                unsigned* cw = ctl + CW_GLA + 64 * bh;
                __builtin_amdgcn_fence(__ATOMIC_RELEASE, "agent"); VM_WAIT();
                (void)xb_add(cw, 1u);
                unsigned sp = 0; while (xb_ld(cw) < 4u) { __builtin_amdgcn_s_sleep(2); if (++sp > (1u << 20)) { atomicAdd(ctl + CW_BAR + XB_TMO, 1u); break; } }
                __builtin_amdgcn_fence(__ATOMIC_ACQUIRE, "agent"); VM_WAIT();
            }
            __syncthreads();
            { const float* gp = args.in[6] + F.lane * 8; const f32x4 gq0 = *(const f32x4*)gp, gq1 = *(const f32x4*)(gp + 4);
              for (int tt = F.wave * 4; tt < 1024; tt += NWAVES * 4) {
                f32x4 v0[4], v1[4]; v4u sgw[4];
#pragma unroll
                for (int i = 0; i < 4; ++i) { const size_t o = ((size_t)b * SEQ + grp * 1024 + tt + i) * DM + h * 512 + F.lane * 8; v0[i] = *(const f32x4*)(ogla + o); v1[i] = *(const f32x4*)(ogla + o + 4); sgw[i] = *(const v4u*)(SG + o); }
#pragma unroll
                for (int i = 0; i < 4; ++i) { const size_t o = ((size_t)b * SEQ + grp * 1024 + tt + i) * DM + h * 512 + F.lane * 8;
                    const float ss = (v0[i].x * v0[i].x + v0[i].y * v0[i].y + v0[i].z * v0[i].z + v0[i].w * v0[i].w) + (v1[i].x * v1[i].x + v1[i].y * v1[i].y + v1[i].z * v1[i].z + v1[i].w * v1[i].w);
                    const float r = 1.0f / sqrtf(wave_sum(ss) * (1.f / 512.f) + EPS);
                    const float sg[8] = {bf2f(sgw[i].x & 0xffffu), bf2f(sgw[i].x >> 16), bf2f(sgw[i].y & 0xffffu), bf2f(sgw[i].y >> 16), bf2f(sgw[i].z & 0xffffu), bf2f(sgw[i].z >> 16), bf2f(sgw[i].w & 0xffffu), bf2f(sgw[i].w >> 16)};
                    *(v4u*)(onb + o) = (v4u){pk2(v0[i].x * r * gq0.x * sg[0], v0[i].y * r * gq0.y * sg[1]), pk2(v0[i].z * r * gq0.z * sg[2], v0[i].w * r * gq0.w * sg[3]),
                                             pk2(v1[i].x * r * gq1.x * sg[4], v1[i].y * r * gq1.y * sg[5]), pk2(v1[i].z * r * gq1.z * sg[6], v1[i].w * r * gq1.w * sg[7])}; } } }
        }
        __syncthreads();
        {
            constexpr int total = NB * 16 * 16, per_q = total / 8;
            volatile LAS int* qs = (volatile LAS int*)(F.lds + CTLW + 256);
            const unsigned myq = xb_xcc_id() & 7u;
#define FOX_FETCH(dst_) do { int got_ = total; for (unsigned k_ = 0; k_ < 8u; ++k_) { const unsigned q_ = (myq + k_) & 7u; \
                if (xb_ld(ctl + CW_FOXQ + 64 * q_) < (unsigned)per_q) { const unsigned v_ = atomicAdd(ctl + CW_FOXQ + 64 * q_, 1u); if (v_ < (unsigned)per_q) { got_ = (int)(q_ * per_q + v_); break; } } } (dst_) = got_; } while (0)
            if (F.tid == 0) { int a_, b_; FOX_FETCH(a_); FOX_FETCH(b_); qs[2] = a_; qs[3] = b_; }
            __syncthreads();
            int L = __builtin_amdgcn_readfirstlane(qs[2]), Ln = __builtin_amdgcn_readfirstlane(qs[3]), it = 0;
            if (L < total) {
#define FOX_REF(R_, L_) do { const int q_ = (L_) / per_q, i_ = (L_) - q_ * per_q, qb_ = 15 - (i_ >> 3), bh_ = (i_ & 7) * 8 + q_, b_ = bh_ >> 4, h_ = bh_ & 15; \
                (R_).Q = fqh + ((size_t)bh_ * SEQ + qb_ * 256) * 128; (R_).K = fkh + (size_t)bh_ * SEQ * 128; (R_).V = fvh + (size_t)bh_ * SEQ * 128; (R_).Bk = cbias + (size_t)bh_ * SEQ; \
                (R_).O = attb + ((size_t)(b_ * SEQ + qb_ * 256)) * DM + h_ * 128; (R_).P0 = qb_ * 256; } while (0)
                fa::BlockRef cur, nxt; fa::Seam S;
                FOX_REF(cur, L);
                fa::attn_prime<true, 128, 128, 128, DM>(cur, SEQ, (char*)lds_raw, S);
                for (;;) {
                    const bool last = Ln >= total;
                    if (last) nxt = cur; else FOX_REF(nxt, Ln);
                    if (F.tid == 0 && !last) { int a_; FOX_FETCH(a_); qs[it & 1] = a_; }
                    fa::attn_block<true, 128, 128, 128, DM>(cur, nxt, SEQ, SEQ, (char*)lds_raw, S);
                    if (last) break;
                    cur = nxt; L = Ln; Ln = __builtin_amdgcn_readfirstlane(qs[it & 1]); ++it;
                }
#undef FOX_REF
#undef FOX_FETCH
            }
        }
    }
    GRID_BAR(3);
    if (IN(5)) { REFRESH();
        { pg8::Gemm g{onb, WtBg, T, DM, DM}; pg8::StaticOrder S; S.init(T, DM, F.G, F.bid); EpiGate<0> E{(bf16*)Y1, GG, nullptr}; pg8::gemm_phase<EpiGate<0>, pg8::StaticOrder>(F.lds, g, S, E); }
        { pg8::Gemm g{attb, WtBf, T, DM, DM}; pg8::StaticOrder S; S.init(T, DM, F.G, F.bid); EpiGate<1> E{(bf16*)Y1, GF, mrg}; pg8::gemm_phase<EpiGate<1>, pg8::StaticOrder>(F.lds, g, S, E); }
    }
    GRID_BAR(5);
    if (IN(7)) { REFRESH(); pg8::Gemm g{mrg, WtOut, T, DM, DM}; pg8::StaticOrder S; S.init(T, DM, F.G, F.bid); EpiRes<true, false> E{x, X1, args.in[13], h2, RSS1}; pg8::gemm_phase<EpiRes<true, false>, pg8::StaticOrder>(F.lds, g, S, E); }
    GRID_BAR(7);
    if (IN(9)) { REFRESH();
        { pg8::Gemm g{h2, WtMq, T, 512, 1024, DM}; pg8::SplitOrder S{64, 2, 2, 1024, F.G, F.bid}; pg8::EpiF32 E{qm, 1024, nullptr}; pg8::gemm_phase<pg8::EpiF32, pg8::SplitOrder>(F.lds, g, S, E); }
        { pg8::Gemm g{mn, WtMkv, 1024, 1024, 512, DM}; pg8::SplitOrder S{4, 4, 4, 512, F.G, F.bid}; pg8::EpiF32 E{kv, 4096, nullptr}; pg8::gemm_phase<pg8::EpiF32, pg8::SplitOrder>(F.lds, g, S, E); }
    }
    GRID_BAR(9);
    if (IN(10)) { REFRESH();
        const int l16 = F.lane & 15, rsub = F.lane >> 4;
        for (int r0 = F.gw * 16; r0 < T * 4 + 1024 * 4; r0 += F.ngw * 16) {
            const bool isq = r0 < T * 4; const float* gp = args.in[isq ? 17 : 18] + 8 * l16; const f32x4 g0 = *(const f32x4*)gp, g1 = *(const f32x4*)(gp + 4);
            f32x4 a0[4], a1[4], c0[4], c1[4];
#pragma unroll
            for (int i = 0; i < 4; ++i) { const int r = (isq ? r0 : r0 - T * 4) + 4 * i + rsub, h = r & 3, row = r >> 2;
                if (isq) { const float* src = qm + (size_t)row * 1024 + h * 128 + 8 * l16; a0[i] = *(const f32x4*)src + *(const f32x4*)(src + 512); a1[i] = *(const f32x4*)(src + 4) + *(const f32x4*)(src + 516); }
                else { const float* src = kv + (size_t)row * 4096 + h * 128 + 8 * l16;
                    a0[i] = (*(const f32x4*)src + *(const f32x4*)(src + 1024)) + (*(const f32x4*)(src + 2048) + *(const f32x4*)(src + 3072));
                    a1[i] = (*(const f32x4*)(src + 4) + *(const f32x4*)(src + 1028)) + (*(const f32x4*)(src + 2052) + *(const f32x4*)(src + 3076));
                    c0[i] = (*(const f32x4*)(src + 512) + *(const f32x4*)(src + 1536)) + (*(const f32x4*)(src + 2560) + *(const f32x4*)(src + 3584));
                    c1[i] = (*(const f32x4*)(src + 516) + *(const f32x4*)(src + 1540)) + (*(const f32x4*)(src + 2564) + *(const f32x4*)(src + 3588)); } }
#pragma unroll
            for (int i = 0; i < 4; ++i) { const int r = (isq ? r0 : r0 - T * 4) + 4 * i + rsub, h = r & 3, row = r >> 2;
                float ss = (a0[i].x * a0[i].x + a0[i].y * a0[i].y + a0[i].z * a0[i].z + a0[i].w * a0[i].w) + (a1[i].x * a1[i].x + a1[i].y * a1[i].y + a1[i].z * a1[i].z + a1[i].w * a1[i].w);
                ss += __shfl_xor(ss, 1); ss += __shfl_xor(ss, 2); ss += __shfl_xor(ss, 4); ss += __shfl_xor(ss, 8);
                float epsq = EPS;
                if (isq) { const f32x2 p2 = *(const f32x2*)(RSS1 + (size_t)row * 32 + 2 * l16); float ms = p2.x + p2.y; ms += __shfl_xor(ms, 1); ms += __shfl_xor(ms, 2); ms += __shfl_xor(ms, 4); ms += __shfl_xor(ms, 8); epsq = EPS * (ms * (1.f / DM) + EPS); }
                const float rr = 1.0f / sqrtf(ss * (1.f / 128.f) + epsq);
                const v4u w = {pk2(a0[i].x * rr * g0.x, a0[i].y * rr * g0.y), pk2(a0[i].z * rr * g0.z, a0[i].w * rr * g0.w), pk2(a1[i].x * rr * g1.x, a1[i].y * rr * g1.y), pk2(a1[i].z * rr * g1.z, a1[i].w * rr * g1.w)};
                if (isq) *(v4u*)(qmb + (size_t)row * 512 + h * 128 + 8 * l16) = w;
                else { const size_t o = ((size_t)((row >> 8) * 4 + h) * MEML + (row & 255)) * 128 + 8 * l16; *(v4u*)(knb + o) = w;
                       *(v4u*)(vb + o) = (v4u){pk2(c0[i].x, c0[i].y), pk2(c0[i].z, c0[i].w), pk2(c1[i].x, c1[i].y), pk2(c1[i].z, c1[i].w)}; } }
        }
    }
    GRID_BAR(10);
    if (IN(11)) { REFRESH();
        {
            constexpr int total = NB * 4 * 16; const int stride = F.G; int L = F.bid;
            if (L < total) {
#define MEM_REF(R_, L_) do { const int bh_ = (L_) >> 4, qb_ = (L_) & 15, b_ = bh_ >> 2, h_ = bh_ & 3; \
                (R_).Q = qmb + ((size_t)(b_ * SEQ + qb_ * 256)) * 512 + h_ * 128; (R_).K = knb + (size_t)bh_ * MEML * 128; (R_).V = vb + (size_t)bh_ * MEML * 128; (R_).Bk = nullptr; \
                (R_).O = om + ((size_t)(b_ * SEQ + qb_ * 256)) * 512 + h_ * 128; (R_).P0 = MEML; } while (0)
                fa::BlockRef cur, nxt; fa::Seam S;
                MEM_REF(cur, L);
                fa::attn_prime<false, 512, 128, 128, 512>(cur, 1 << 30, (char*)lds_raw, S);
                for (;;) {
                    const bool more_item = L + stride < total; const int Ln = more_item ? L + stride : L;
                    if (!more_item) nxt = cur; else MEM_REF(nxt, Ln);
                    fa::attn_block<false, 512, 128, 128, 512>(cur, nxt, MEML, 1 << 30, (char*)lds_raw, S);
                    if (!more_item) break;
                    cur = nxt; L = Ln;
                }
#undef MEM_REF
            }
        }
    }
    GRID_BAR(11);
    if (IN(12)) { REFRESH(); pg8::Gemm g{om, WtMo, T, DM, 512}; pg8::StaticOrder S; S.init(T, DM, F.G, F.bid); EpiRes<true, true> E{X1, X2, args.in[20], xs, RSS2}; pg8::gemm_phase<EpiRes<true, true>, pg8::StaticOrder>(F.lds, g, S, E); }
    GRID_BAR(12);
    if (IN(15)) { REFRESH();
        const float* br = args.in[22];
        LAS int* hist = (LAS int*)F.lds; LAS int* gbase = hist + NE;
        LAS float* part = (LAS float*)(F.lds + 1024);
        for (int m0 = F.bid * 64; m0 < T; m0 += F.G * 64) {
            __syncthreads();
            if (F.tid < NE) hist[F.tid] = 0;
            { const int fr = F.lane & 15, fq = F.lane >> 4;
              f32x4 acc[4][2];
#pragma unroll
              for (int tb = 0; tb < 4; ++tb)
#pragma unroll
                  for (int eb = 0; eb < 2; ++eb) acc[tb][eb] = (f32x4){0.f, 0.f, 0.f, 0.f};
              const bf16* ap = xs + (size_t)(m0 + fr) * DM + 256 * F.wave + 8 * fq;
              const bf16* bp = WrT + (size_t)fr * DM + 256 * F.wave + 8 * fq;
              bf16x8 a[8][4], bw[8][2];
#pragma unroll
              for (int ks = 0; ks < 8; ++ks) {
#pragma unroll
                  for (int tb = 0; tb < 4; ++tb) a[ks][tb] = *(const bf16x8*)(ap + (size_t)tb * 16 * DM + ks * 32);
#pragma unroll
                  for (int eb = 0; eb < 2; ++eb) bw[ks][eb] = *(const bf16x8*)(bp + (size_t)eb * 16 * DM + ks * 32); }
#pragma unroll
              for (int ks = 0; ks < 8; ++ks)
#pragma unroll
                  for (int tb = 0; tb < 4; ++tb)
#pragma unroll
                      for (int eb = 0; eb < 2; ++eb) acc[tb][eb] = __builtin_amdgcn_mfma_f32_16x16x32_bf16(a[ks][tb], bw[ks][eb], acc[tb][eb], 0, 0, 0);
#pragma unroll
              for (int tb = 0; tb < 4; ++tb)
#pragma unroll
                  for (int eb = 0; eb < 2; ++eb)
#pragma unroll
                      for (int i = 0; i < 4; ++i) part[(F.wave * 64 + tb * 16 + 4 * fq + i) * 32 + eb * 16 + fr] = acc[tb][eb][i]; }
            __syncthreads();
            int ti[TOPK], rk[TOPK]; float gt[TOPK], rstd = 0.f; const int m = m0 + F.tid;
            if (F.tid < 64) {
                float ms = 0.f;
#pragma unroll
                for (int q = 0; q < 8; ++q) { const f32x4 p4 = *(const f32x4*)(RSS2 + (size_t)m * 32 + 4 * q); ms += (p4.x + p4.y) + (p4.z + p4.w); }
                rstd = 1.0f / sqrtf(ms * (1.f / DM) + EPS);
                float lg[NE];
#pragma unroll
                for (int q = 0; q < 8; ++q) { const LAS float* lp_ = part + F.tid * 32 + 4 * q;
                    const f32x4 l4 = ((*(const LAS f32x4*)lp_ + *(const LAS f32x4*)(lp_ + 2048)) + (*(const LAS f32x4*)(lp_ + 4096) + *(const LAS f32x4*)(lp_ + 6144)))
                                   + ((*(const LAS f32x4*)(lp_ + 8192) + *(const LAS f32x4*)(lp_ + 10240)) + (*(const LAS f32x4*)(lp_ + 12288) + *(const LAS f32x4*)(lp_ + 14336))), b4 = *(const f32x4*)(br + 4 * q);
                    lg[4 * q] = l4.x * rstd + b4.x; lg[4 * q + 1] = l4.y * rstd + b4.y; lg[4 * q + 2] = l4.z * rstd + b4.z; lg[4 * q + 3] = l4.w * rstd + b4.w; }
                unsigned taken = 0u; float tv[TOPK];
#pragma unroll
                for (int k = 0; k < TOPK; ++k) { float best = -3.0e38f; int bi = 0;
#pragma unroll
                    for (int e = 0; e < NE; ++e) { const bool ok = !((taken >> e) & 1u) && lg[e] > best; best = ok ? lg[e] : best; bi = ok ? e : bi; }
                    taken |= 1u << bi; tv[k] = best; ti[k] = bi; }
                float ps = 0.f;
#pragma unroll
                for (int k = 0; k < TOPK; ++k) { gt[k] = __expf(tv[k] - tv[0]); ps += gt[k]; }
#pragma unroll
                for (int k = 0; k < TOPK; ++k) { gt[k] /= ps; rk[k] = __hip_atomic_fetch_add(&hist[ti[k]], 1, __ATOMIC_RELAXED, __HIP_MEMORY_SCOPE_WORKGROUP); }
            }
            __syncthreads();
            if (F.tid < NE) gbase[F.tid] = (int)atomicAdd(ctl + CW_CNT + F.tid, (unsigned)hist[F.tid]);
            __syncthreads();
            if (F.tid < 64) {
#pragma unroll
                for (int k = 0; k < TOPK; ++k) { const int pos = gbase[ti[k]] + rk[k]; asg_e[m * TOPK + k] = ti[k]; asg_pos[m * TOPK + k] = pos;
                    const size_t li = (size_t)ti[k] * T + pos; tokl[li] = m; wl[li] = gt[k]; rsl[li] = rstd; }
            }
        }
    }
    GRID_BAR(15);
    if (IN(16)) { REFRESH();
        moe_tables(F.lds, ctl);
        pg8::Gemm g{xs, WtUp, PMAX, 4096, DM}; MoeOrder<true> S{F.lds, tokl, rsl, args.in[24], 16, F.G, F.bid}; EpiSwiglu E{act, F.lds};
        pg8::gemm_phase_gather<EpiSwiglu, MoeOrder<true>>(F.lds, g, S, E);
    }
    GRID_BAR(16);
    if (IN(17)) { REFRESH();
        moe_tables(F.lds, ctl);
        pg8::Gemm g{act, WtDn, PMAX, DM, DM}; MoeOrder<false> S{F.lds, tokl, wl, args.in[26], 8, F.G, F.bid}; EpiDown E{yb, F.lds};
        pg8::gemm_phase<EpiDown, MoeOrder<false>>(F.lds, g, S, E);
    }
    GRID_BAR(17);
    if (IN(18)) { REFRESH();
        moe_tables(F.lds, ctl);
        const LAS int* pbase = (const LAS int*)(F.lds + MT_PBASE);
        for (int t = F.gw; t < T; t += F.ngw) {
            int slot[TOPK];
#pragma unroll
            for (int k = 0; k < TOPK; ++k) slot[k] = pbase[asg_e[t * TOPK + k]] + asg_pos[t * TOPK + k];
            f32x4 o0[4], o1[4]; v4u w[4][TOPK];
#pragma unroll
            for (int p = 0; p < 4; ++p) { const int j = 512 * p + 8 * F.lane; { const v4u xw = *(const v4u*)((const bf16*)X2 + (size_t)t * DM + j); o0[p] = (f32x4){bf2f(xw.x & 0xffffu), bf2f(xw.x >> 16), bf2f(xw.y & 0xffffu), bf2f(xw.y >> 16)}; o1[p] = (f32x4){bf2f(xw.z & 0xffffu), bf2f(xw.z >> 16), bf2f(xw.w & 0xffffu), bf2f(xw.w >> 16)}; }
#pragma unroll
                for (int k = 0; k < TOPK; ++k) w[p][k] = *(const v4u*)(yb + (size_t)slot[k] * DM + j); }
#pragma unroll
            for (int p = 0; p < 4; ++p) { const int j = 512 * p + 8 * F.lane;
#pragma unroll
                for (int k = 0; k < TOPK; ++k) { const v4u q = w[p][k];
                    o0[p].x += bf2f(q.x & 0xffffu); o0[p].y += bf2f(q.x >> 16); o0[p].z += bf2f(q.y & 0xffffu); o0[p].w += bf2f(q.y >> 16);
                    o1[p].x += bf2f(q.z & 0xffffu); o1[p].y += bf2f(q.z >> 16); o1[p].z += bf2f(q.w & 0xffffu); o1[p].w += bf2f(q.w >> 16); }
                *(f32x4*)(args.out + (size_t)t * DM + j) = o0[p]; *(f32x4*)(args.out + (size_t)t * DM + j + 4) = o1[p]; }
        }
    }
#undef IN
}

constexpr int NPHASE = 19;
extern "C" void kernel_launch(void* const* d_in, const int* in_sizes, int n_in, void* d_out, int out_size, void* d_ws, size_t ws_size, hipStream_t stream) {
    static int grid = 0;
    static_assert(WS_END <= (size_t)4290 * 1000 * 1000, "d_ws map too large");
    if (grid == 0) {
        if (n_in != 27 || out_size != T * DM || ws_size < WS_END) { fprintf(stderr, "kernel_launch: unexpected shapes (n_in %d, out %d, ws %zu, need %zu)\n", n_in, out_size, ws_size, (size_t)WS_END); grid = -1; return; }
        int dev = 0, cus = 0, per_cu = 0;
        if (hipGetDevice(&dev) != hipSuccess || hipDeviceGetAttribute(&cus, hipDeviceAttributeMultiprocessorCount, dev) != hipSuccess) { grid = -1; return; }
        if (hipFuncSetAttribute((const void*)mk_fwd, hipFuncAttributeMaxDynamicSharedMemorySize, LDS_BYTES) != hipSuccess) { fprintf(stderr, "kernel_launch: hipFuncSetAttribute failed\n"); grid = -1; return; }
        if (hipOccupancyMaxActiveBlocksPerMultiprocessor(&per_cu, (const void*)mk_fwd, NWAVES * 64, LDS_BYTES) != hipSuccess || per_cu < 1) fprintf(stderr, "kernel_launch: occupancy query says %d\n", per_cu);
        (void)hipGetLastError();
        grid = cus;
    }
    if (grid < 0) return;
    (void)hipMemsetAsync((char*)d_ws + WS_CTL, 0, CTL_BYTES, stream);
    Args a{};
    for (int i = 0; i < 27; ++i) a.in[i] = (const float*)d_in[i];
    a.out = (float*)d_out; a.ws = (unsigned char*)d_ws;
    #ifndef MK_PER_PHASE
    a.ph_lo = 0; a.ph_hi = NPHASE; hipLaunchKernelGGL(mk_fwd, dim3(grid), dim3(NWAVES * 64), LDS_BYTES, stream, a);
#ifdef PROBE_LO
    (void)hipMemsetAsync((char*)d_ws + WS_CTL, 0, CTL_BYTES, stream);
    a.ph_lo = PROBE_LO; a.ph_hi = PROBE_HI; hipLaunchKernelGGL(mk_fwd, dim3(grid), dim3(NWAVES * 64), LDS_BYTES, stream, a);
#endif
#else
    for (int p = 0; p < NPHASE; ++p) { a.ph_lo = p; a.ph_hi = p + 1; hipLaunchKernelGGL(mk_fwd, dim3(grid), dim3(NWAVES * 64), LDS_BYTES, stream, a); }
#endif
}
```

```cpp
#include <hip/hip_runtime.h>
#include <cstdio>
#include <cstdint>

#define GAS __attribute__((address_space(1)))
#define LAS __attribute__((address_space(3)))
typedef unsigned short bf16;
typedef unsigned v4u __attribute__((ext_vector_type(4)));
typedef unsigned v2u __attribute__((ext_vector_type(2)));
typedef float f32x4 __attribute__((ext_vector_type(4)));
typedef float f32x2 __attribute__((ext_vector_type(2)));
typedef short bf16x8 __attribute__((ext_vector_type(8)));

constexpr int T = 16384, DM = 2048, NB = 4, SEQ = 4096, MEML = 256;
constexpr float EPS = 1e-6f;
constexpr int INC = 16416, INCP = 16640;
constexpr int C_GQ = 0, C_GK = 1024, C_GV = 2048, C_GR = 4096, C_GA = 6144, C_FQ = 6160, C_FK = 8208, C_FV = 10256, C_FF = 12304, C_GG = 12320, C_GF = 14368;
constexpr int NE = 32, TOPK = 4, NASG = T * TOPK, PMAX = NASG + NE * 256;
constexpr int MAXRT = PMAX / 256;

__device__ __forceinline__ unsigned f2bf(float f) { unsigned u = __builtin_bit_cast(unsigned, f); return (u + 0x7fffu + ((u >> 16) & 1u)) >> 16; }
__device__ __forceinline__ unsigned pk2(float lo, float hi) { unsigned r; asm("v_cvt_pk_bf16_f32 %0, %1, %2" : "=v"(r) : "v"(lo), "v"(hi)); return r; }
__device__ __forceinline__ float bf2f(unsigned b) { return __builtin_bit_cast(float, b << 16); }
__device__ __forceinline__ float wave_sum(float v) {
#pragma unroll
    for (int o = 1; o < 64; o <<= 1) v += __shfl_xor(v, o);
    return v;
}
__device__ __forceinline__ float sigmoid_f(float x) { return __builtin_amdgcn_rcpf(1.0f + __expf(-x)); }
__device__ __forceinline__ float log_sigmoid_f(float x) { return fminf(x, 0.f) - __logf(1.0f + __expf(-fabsf(x))); }
#define LDS_WAIT() asm volatile("s_waitcnt lgkmcnt(0)" ::: "memory")
#define VM_WAIT() asm volatile("s_waitcnt vmcnt(0)" ::: "memory")
#define XB_TMO      128
#define XB_XCNT(j)  (256  + 64 * (j))
#define XB_XSUB(j)  (1280 + 64 * (j))
#define XB_XGEN(j)  (2304 + 64 * (j))
#define XB_TOP      3328
#define XB_TOPGEN   3392
#define XCD_BAR_WORDS 3456
#define XB_SPIN_CAP (1u << 18)

__device__ __forceinline__ unsigned xb_ld(unsigned* p)              { return __hip_atomic_load(p, __ATOMIC_RELAXED, __HIP_MEMORY_SCOPE_AGENT); }
__device__ __forceinline__ unsigned xb_add(unsigned* p, unsigned v) { return __hip_atomic_fetch_add(p, v, __ATOMIC_RELAXED, __HIP_MEMORY_SCOPE_AGENT); }
__device__ __forceinline__ unsigned xb_xcc_id() { return (unsigned)__builtin_amdgcn_s_getreg((3 << 11) | 20) & 0xFu; }
#define XB_SPIN(cond, bar) do { unsigned _sp = 0; while (cond) { __builtin_amdgcn_s_sleep(1); \
    if ((++_sp & 255u) == 0u) { if (xb_ld(&(bar)[XB_TMO])) break; if (_sp > XB_SPIN_CAP) { atomicAdd(&(bar)[XB_TMO], 1u); break; } } } } while (0)

struct XcdBarrier {
    unsigned* bar; unsigned x;
    volatile LAS unsigned* st;
};
__device__ __forceinline__ XcdBarrier xcd_barrier_post(unsigned* bar, volatile LAS unsigned* st) {
    XcdBarrier b; b.bar = bar; b.x = xb_xcc_id(); b.st = st;
    if (threadIdx.x == 0) (void)xb_add(&bar[XB_XCNT(b.x)], 1u);
    return b;
}
__device__ __forceinline__ void xcd_barrier_complete(unsigned* bar, unsigned x, unsigned& nloc, unsigned& nx) {
    const unsigned G = gridDim.x * gridDim.y * gridDim.z;
    unsigned sum, cnt, mine, sp = 0u;
    for (;;) {
        sum = 0u; cnt = 0u; mine = 0u;
#pragma unroll
        for (unsigned j = 0; j < 16; ++j) { const unsigned c = xb_ld(&bar[XB_XCNT(j)]); sum += c; cnt += (c > 0u) ? 1u : 0u; mine = (j == x) ? c : mine; }
        if (sum == G) break;
        __builtin_amdgcn_s_sleep(1);
        if ((++sp & 255u) == 0u) { if (xb_ld(&bar[XB_TMO])) break; if (sp > XB_SPIN_CAP) { atomicAdd(&bar[XB_TMO], 1u); break; } }
    }
    nloc = mine > 0u ? mine : 1u; nx = cnt > 0u ? cnt : 1u;
}
__device__ __forceinline__ void xcd_barrier(const XcdBarrier& b) {
    asm volatile("s_waitcnt vmcnt(0)" ::: "memory");
    __syncthreads();
    if (threadIdx.x == 0) {
        unsigned* bar = b.bar;
        __builtin_amdgcn_s_waitcnt(0);
        unsigned nloc = b.st[0], nx = b.st[1];
        if (nloc == 0u) { xcd_barrier_complete(bar, b.x, nloc, nx); b.st[0] = nloc; b.st[1] = nx; }
        const unsigned old = xb_add(&bar[XB_XSUB(b.x)], 1u);
        const unsigned gen = old / nloc;
        if (old + 1u == (gen + 1u) * nloc) {
            __builtin_amdgcn_fence(__ATOMIC_RELEASE, "agent");
            asm volatile("s_waitcnt vmcnt(0)" ::: "memory");
            const unsigned og = xb_add(&bar[XB_TOP], 1u);
            const unsigned tg = og / nx;
            if (og + 1u == (tg + 1u) * nx) xb_add(&bar[XB_TOPGEN], 1u);
            else XB_SPIN(xb_ld(&bar[XB_TOPGEN]) == tg, bar);
            __builtin_amdgcn_fence(__ATOMIC_ACQUIRE, "agent");
            xb_add(&bar[XB_XGEN(b.x)], 1u);
            asm volatile("s_waitcnt vmcnt(0)" ::: "memory");
        } else {
            XB_SPIN(xb_ld(&bar[XB_XGEN(b.x)]) == gen, bar);
            __builtin_amdgcn_fence(__ATOMIC_ACQUIRE, "agent");
            asm volatile("s_waitcnt vmcnt(0)" ::: "memory");
        }
    }
    __syncthreads();
}
namespace pg8 {
#define PG8_LAS __attribute__((address_space(3)))
typedef unsigned short bf16_t;
typedef short bf16x8 __attribute__((ext_vector_type(8)));
typedef float f32x4 __attribute__((ext_vector_type(4)));
typedef unsigned u32x4 __attribute__((ext_vector_type(4)));
constexpr int BM = 256, BK = 64, HALF = 128, HTB = HALF * BK * 2  , STAGE_BYTES = 8 * HTB, NXCD = 8, WGM = 8;

__host__ __device__ __forceinline__ int lds_byte(int r, int c) { const int st = (r >> 4) * 2 + (c >> 5), rr = r & 15, cc = c & 31, ob = rr * 64 + cc * 2; return st * 1024 + (ob ^ (((ob >> 9) & 1) << 5)); }
__host__ __device__ __forceinline__ void stage_rc(int b, int& R, int& C) { const int st = b / 1024, sb = b % 1024, swz = sb ^ (((sb >> 9) & 1) << 5); R = (st >> 1) * 16 + swz / 64; C = (st & 1) * 32 + (swz % 64) / 2; }
__host__ __device__ __forceinline__ int perm32(int rho) { const int n = rho >> 4, i = rho & 15; return 8 * (i >> 2) + 4 * n + (i & 3); }

struct Unit { int pm, pn, pb, kofs, sb; };
struct Gemm { const bf16_t* A; const bf16_t* Bt; int M, N, K, ld; };

struct StaticOrder {
    int nM, nN, nwg, G, c, i0 = 0, iend = 1 << 30;
    __host__ __device__ void init(int M, int N, int G_, int c_) { nM = M / BM; nN = N / BM; nwg = nM * nN; G = G_; c = c_; }
    __host__ __device__ bool next(int i, Unit& u) const {
        if (i + i0 >= iend) return false;
        const long L = (long)(i + i0) * G + c; if (L >= nwg) return false;
        int wgid = (int)L; { const int q = nwg / NXCD, r = nwg % NXCD, xcd = wgid % NXCD, off = wgid / NXCD; wgid = (xcd < r ? xcd * (q + 1) : r * (q + 1) + (xcd - r) * q) + off; }
        const int nig = WGM * nN, gid = wgid / nig, fm = gid * WGM, gsz = (nM - fm) < WGM ? (nM - fm) : WGM;
        u.pm = fm + ((wgid % nig) % gsz); u.pn = (wgid % nig) / gsz; u.pb = u.pn; u.kofs = 0; return true;
    }
    static constexpr bool SIDE = false;
    __device__ __forceinline__ void prefetch(const Unit&, int, int, int) const {}
    __device__ __forceinline__ void a_ready(const Unit&) const {}
    __device__ __forceinline__ void done(const Unit&) const {}
};

struct SplitOrder {
    int nM, nN, nS, Ks, G, c;
    __host__ __device__ bool next(int i, Unit& u) const {
        const long L = (long)i * G + c; if (L >= (long)nM * nN * nS) return false;
        const int s = (int)(L % nS), r = (int)(L / nS); u.pm = r / nN; const int pn = r % nN; u.pn = s * nN + pn; u.pb = pn; u.kofs = s * Ks; return true;
    }
    static constexpr bool SIDE = false;
    __device__ __forceinline__ void prefetch(const Unit&, int, int, int) const {}
    __device__ __forceinline__ void a_ready(const Unit&) const {}
    __device__ __forceinline__ void done(const Unit&) const {}
};

__device__ __forceinline__ unsigned cvt_pk_bf16(float lo, float hi) { unsigned r; asm volatile("v_cvt_pk_bf16_f32 %0, %1, %2" : "=v"(r) : "v"(lo), "v"(hi)); return r; }

struct EpiF32 {
    static constexpr bool PERM = false;
    float* C; int ldc; const float* bias;
    __device__ __forceinline__ void operator()(const f32x4 (&acc)[2][2][4][2], const Unit& u, int wr, int wc, int fr, int fq) const {
        const int row0 = u.pm * BM + wr * 64 + fr, col0 = u.pn * BM + wc * 32 + 4 * fq;
        f32x4 bv[2][2];
#pragma unroll
        for (int bj = 0; bj < 2; ++bj)
#pragma unroll
            for (int n = 0; n < 2; ++n) bv[bj][n] = bias ? *(const f32x4*)(bias + col0 + bj * HALF + n * 16) : (f32x4){0.f, 0.f, 0.f, 0.f};
#pragma unroll
        for (int ai = 0; ai < 2; ++ai)
#pragma unroll
            for (int m = 0; m < 4; ++m) { float* rowp = C + (size_t)(row0 + ai * HALF + m * 16) * ldc + col0;
#pragma unroll
                for (int bj = 0; bj < 2; ++bj)
#pragma unroll
                    for (int n = 0; n < 2; ++n) *(f32x4*)(rowp + bj * HALF + n * 16) = acc[ai][bj][m][n] + bv[bj][n]; }
    }
};

struct EpiN32 {
    static constexpr bool PERM = false;
    float* C; int ldc;
    __device__ __forceinline__ void operator()(const f32x4 (&acc)[2][2][4][2], const Unit& u, int wr, int wc, int fr, int fq) const {
        if (wc != 0) return;
        const int row0 = u.pm * BM + wr * 64 + fr;
#pragma unroll
        for (int ai = 0; ai < 2; ++ai)
#pragma unroll
            for (int m = 0; m < 4; ++m) { float* rowp = C + (size_t)(row0 + ai * HALF + m * 16) * ldc + 32 * u.pn + 4 * fq;
                *(f32x4*)rowp = acc[ai][0][m][0]; *(f32x4*)(rowp + 16) = acc[ai][0][m][1]; }
    }
};

template <class Epi, class Sched>
__device__ __forceinline__ void gemm_phase(PG8_LAS unsigned char* lds, const Gemm g, const Sched& S, const Epi& E) {
    const int tid = threadIdx.x, wid = __builtin_amdgcn_readfirstlane(tid >> 6), lane = tid & 63, wr = wid >> 2, wc = wid & 3, fr = lane & 15, fq = lane >> 4;
    const int K = g.K, nt = K / BK, LD = g.ld ? g.ld : g.K;
    unsigned voffA[2], voffB[2];
#pragma unroll
    for (int i = 0; i < 2; ++i) { int R, C; stage_rc(tid * 16 + i * 8192, R, C); const int Rb = Epi::PERM ? ((R & ~31) + perm32(R & 31)) : R;
        voffA[i] = (unsigned)(R * LD + C) * 2u; voffB[i] = (unsigned)(Rb * LD + C) * 2u; }
    const size_t kstep = (size_t)(BK * 2);
    const size_t hstep = (size_t)HALF * LD * 2;
    const size_t tstep = 2 * hstep;
    const unsigned ldsw = (unsigned)wid * 1024u;
    const int aoff = lds_byte(wr * 64 + fr, fq * 8), boff = lds_byte(wc * 32 + fr, fq * 8);
#define PG8_SA(b, h) (((b) * 2 + (h)) * HTB)
#define PG8_SB(b, h) ((4 + (b) * 2 + (h)) * HTB)
#define PG8_STAGE(bufoff, gbase, voff) do { _Pragma("unroll") for (int _i = 0; _i < 2; ++_i) \
        __builtin_amdgcn_global_load_lds((const unsigned*)((const char*)(gbase) + (voff)[_i]), (PG8_LAS unsigned*)(lds + (bufoff) + ldsw + _i * 8192), 16, 0, 0); } while (0)
#define PG8_LDA(dst, b, h) do { _Pragma("unroll") for (int m = 0; m < 4; ++m) _Pragma("unroll") for (int k = 0; k < 2; ++k) dst[m][k] = *(const PG8_LAS bf16x8*)(lds + PG8_SA(b, h) + aoff + m * 2048 + k * 1024); } while (0)
#define PG8_LDB(dst, b, h) do { _Pragma("unroll") for (int n = 0; n < 2; ++n) _Pragma("unroll") for (int k = 0; k < 2; ++k) dst[n][k] = *(const PG8_LAS bf16x8*)(lds + PG8_SB(b, h) + boff + n * 2048 + k * 1024); } while (0)
#define PG8_MMA(ai, bj, At, Bt) do { __builtin_amdgcn_s_setprio(1); _Pragma("unroll") for (int m = 0; m < 4; ++m) _Pragma("unroll") for (int n = 0; n < 2; ++n) _Pragma("unroll") for (int k = 0; k < 2; ++k) \
        acc[ai][bj][m][n] = __builtin_amdgcn_mfma_f32_16x16x32_bf16(Bt[n][k], At[m][k], acc[ai][bj][m][n], 0, 0, 0); __builtin_amdgcn_s_setprio(0); } while (0)
#define PG8_WAIT_V(n) asm volatile("s_waitcnt vmcnt(" #n ")" ::: "memory")
#define PG8_WAIT_L(n) asm volatile("s_waitcnt lgkmcnt(" #n ")" ::: "memory")
#define PG8_BAR __builtin_amdgcn_s_barrier()
#define PG8_SCHED __builtin_amdgcn_sched_barrier(0)
    Unit cur, nxt; int ui = 0;
    if (!S.next(0, cur)) return;
    f32x4 acc[2][2][4][2];
#pragma unroll
    for (int a = 0; a < 2; ++a)
#pragma unroll
        for (int b = 0; b < 2; ++b)
#pragma unroll
            for (int m = 0; m < 4; ++m)
#pragma unroll
                for (int n = 0; n < 2; ++n) acc[a][b][m][n] = (f32x4){0.f, 0.f, 0.f, 0.f};
    bf16x8 At[4][2], B0[2][2], B1[2][2];
    const char* cA = (const char*)g.A + (size_t)cur.pm * tstep + (size_t)cur.kofs * 2; const char* cB = (const char*)g.Bt + (size_t)cur.pb * tstep + (size_t)cur.kofs * 2;
    S.a_ready(cur); cur.sb = 0;
    if constexpr (Sched::SIDE) S.prefetch(cur, 0, wid, lane);
    PG8_STAGE(PG8_SB(0, 0), cB, voffB); PG8_STAGE(PG8_SA(0, 0), cA, voffA); PG8_STAGE(PG8_SB(0, 1), cB + hstep, voffB); PG8_STAGE(PG8_SA(0, 1), cA + hstep, voffA);
    if (wr == 1) PG8_BAR;
    PG8_WAIT_V(4); PG8_BAR;
    PG8_STAGE(PG8_SB(1, 0), cB + kstep, voffB); PG8_STAGE(PG8_SA(1, 0), cA + kstep, voffA); PG8_STAGE(PG8_SB(1, 1), cB + hstep + kstep, voffB);
    PG8_WAIT_V(6); PG8_BAR;
    for (;;) {
        const bool has_next = S.next(ui + 1, nxt); nxt.sb = cur.sb == 2 ? 0 : cur.sb + 1;
        if constexpr (Sched::SIDE) { if (has_next) S.prefetch(nxt, nxt.sb, wid, lane); }
        const char* nA = has_next ? (const char*)g.A + (size_t)nxt.pm * tstep + (size_t)nxt.kofs * 2 : cA; const char* nB = has_next ? (const char*)g.Bt + (size_t)nxt.pb * tstep + (size_t)nxt.kofs * 2 : cB;
        for (int t = 0; t < nt; t += 2) {
            const bool last = (t == nt - 2);
            const char* a1 = cA + (size_t)(t + 1) * kstep;
            const char* a2 = last ? nA : cA + (size_t)(t + 2) * kstep; const char* b2 = last ? nB : cB + (size_t)(t + 2) * kstep;
            const char* a3 = a2 + kstep; const char* b3 = b2 + kstep;
            if (last && has_next) S.a_ready(nxt);
            PG8_LDB(B0, 0, 0); PG8_SCHED; PG8_LDA(At, 0, 0); PG8_STAGE(PG8_SA(1, 1), a1 + hstep, voffA);
            PG8_WAIT_L(8); PG8_BAR; PG8_WAIT_L(0); PG8_MMA(0, 0, At, B0); PG8_BAR; PG8_SCHED;
            PG8_LDB(B1, 0, 1); PG8_STAGE(PG8_SB(0, 0), b2, voffB);
            PG8_BAR; PG8_WAIT_L(0); PG8_MMA(0, 1, At, B1); PG8_BAR;
            PG8_LDA(At, 0, 1); PG8_STAGE(PG8_SA(0, 0), a2, voffA);
            PG8_BAR; PG8_WAIT_L(0); PG8_MMA(1, 0, At, B0); PG8_BAR; PG8_SCHED;
            PG8_STAGE(PG8_SB(0, 1), b2 + hstep, voffB);
            PG8_WAIT_V(6); PG8_BAR; PG8_MMA(1, 1, At, B1); PG8_BAR;
            PG8_LDB(B0, 1, 0); PG8_SCHED; PG8_LDA(At, 1, 0); PG8_STAGE(PG8_SA(0, 1), a2 + hstep, voffA);
            PG8_WAIT_L(8); PG8_BAR; PG8_WAIT_L(0); PG8_MMA(0, 0, At, B0); PG8_BAR; PG8_SCHED;
            PG8_LDB(B1, 1, 1); PG8_STAGE(PG8_SB(1, 0), b3, voffB);
            PG8_BAR; PG8_WAIT_L(0); PG8_MMA(0, 1, At, B1); PG8_BAR;
            PG8_LDA(At, 1, 1); PG8_STAGE(PG8_SA(1, 0), a3, voffA);
            PG8_BAR; PG8_WAIT_L(0); PG8_MMA(1, 0, At, B0); PG8_BAR; PG8_SCHED;
            PG8_STAGE(PG8_SB(1, 1), b3 + hstep, voffB);
            PG8_WAIT_V(6); PG8_BAR; PG8_MMA(1, 1, At, B1); PG8_BAR;
        }
        E(acc, cur, wr, wc, fr, fq); S.done(cur);
        if (!has_next) break;
#pragma unroll
        for (int a = 0; a < 2; ++a)
#pragma unroll
            for (int b = 0; b < 2; ++b)
#pragma unroll
                for (int m = 0; m < 4; ++m)
#pragma unroll
                    for (int n = 0; n < 2; ++n) acc[a][b][m][n] = (f32x4){0.f, 0.f, 0.f, 0.f};
        cur = nxt; cA = nA; cB = nB; ++ui;
    }
    PG8_WAIT_V(0);
    if (wr == 0) PG8_BAR;
    PG8_BAR;
#undef PG8_SA
#undef PG8_SB
#undef PG8_STAGE
#undef PG8_LDA
#undef PG8_LDB
#undef PG8_MMA
#undef PG8_WAIT_V
#undef PG8_WAIT_L
#undef PG8_BAR
#undef PG8_SCHED
}
template <class Epi, class Sched>
__device__ __forceinline__ void gemm_phase_gather(PG8_LAS unsigned char* lds, const Gemm g, const Sched& S, const Epi& E) {
    const int tid = threadIdx.x, wid = __builtin_amdgcn_readfirstlane(tid >> 6), lane = tid & 63, wr = wid >> 2, wc = wid & 3, fr = lane & 15, fq = lane >> 4;
    const int K = g.K, nt = K / BK;
    unsigned voffB[2]; int RA[2], CA[2];
#pragma unroll
    for (int i = 0; i < 2; ++i) { int R, C; stage_rc(tid * 16 + i * 8192, R, C); const int Rb = Epi::PERM ? ((R & ~31) + perm32(R & 31)) : R;
        RA[i] = R; CA[i] = C * 2; voffB[i] = (unsigned)(Rb * K + C) * 2u; }
    unsigned va0[2], va1[2], vn0[2], vn1[2];
#define PG8_ROWS(u_, d0, d1) do { const PG8_LAS int* tk_ = S.tok_table((u_).sb); _Pragma("unroll") for (int _i = 0; _i < 2; ++_i) { d0[_i] = (unsigned)tk_[RA[_i]] * (unsigned)(K * 2) + (unsigned)CA[_i]; d1[_i] = (unsigned)tk_[HALF + RA[_i]] * (unsigned)(K * 2) + (unsigned)CA[_i]; } } while (0)
    const size_t kstep = (size_t)(BK * 2);
    const size_t hstep = (size_t)HALF * K * 2;
    const size_t tstep = 2 * hstep;
    const unsigned ldsw = (unsigned)wid * 1024u;
    const int aoff = lds_byte(wr * 64 + fr, fq * 8), boff = lds_byte(wc * 32 + fr, fq * 8);
#define PG8_SA(b, h) (((b) * 2 + (h)) * HTB)
#define PG8_SB(b, h) ((4 + (b) * 2 + (h)) * HTB)
#define PG8_STAGE(bufoff, gbase, voff) do { _Pragma("unroll") for (int _i = 0; _i < 2; ++_i) \
        __builtin_amdgcn_global_load_lds((const unsigned*)((const char*)(gbase) + (voff)[_i]), (PG8_LAS unsigned*)(lds + (bufoff) + ldsw + _i * 8192), 16, 0, 0); } while (0)
#define PG8_LDA(dst, b, h) do { _Pragma("unroll") for (int m = 0; m < 4; ++m) _Pragma("unroll") for (int k = 0; k < 2; ++k) dst[m][k] = *(const PG8_LAS bf16x8*)(lds + PG8_SA(b, h) + aoff + m * 2048 + k * 1024); } while (0)
#define PG8_LDB(dst, b, h) do { _Pragma("unroll") for (int n = 0; n < 2; ++n) _Pragma("unroll") for (int k = 0; k < 2; ++k) dst[n][k] = *(const PG8_LAS bf16x8*)(lds + PG8_SB(b, h) + boff + n * 2048 + k * 1024); } while (0)
#define PG8_MMA(ai, bj, At, Bt) do { __builtin_amdgcn_s_setprio(1); _Pragma("unroll") for (int m = 0; m < 4; ++m) _Pragma("unroll") for (int n = 0; n < 2; ++n) _Pragma("unroll") for (int k = 0; k < 2; ++k) \
        acc[ai][bj][m][n] = __builtin_amdgcn_mfma_f32_16x16x32_bf16(Bt[n][k], At[m][k], acc[ai][bj][m][n], 0, 0, 0); __builtin_amdgcn_s_setprio(0); } while (0)
#define PG8_WAIT_V(n) asm volatile("s_waitcnt vmcnt(" #n ")" ::: "memory")
#define PG8_WAIT_L(n) asm volatile("s_waitcnt lgkmcnt(" #n ")" ::: "memory")
#define PG8_BAR __builtin_amdgcn_s_barrier()
#define PG8_SCHED __builtin_amdgcn_sched_barrier(0)
    Unit cur, nxt; int ui = 0;
    if (!S.next(0, cur)) return;
    f32x4 acc[2][2][4][2];
#pragma unroll
    for (int a = 0; a < 2; ++a)
#pragma unroll
        for (int b = 0; b < 2; ++b)
#pragma unroll
            for (int m = 0; m < 4; ++m)
#pragma unroll
                for (int n = 0; n < 2; ++n) acc[a][b][m][n] = (f32x4){0.f, 0.f, 0.f, 0.f};
    bf16x8 At[4][2], B0[2][2], B1[2][2];
    const char* cA = (const char*)g.A; const char* cB = (const char*)g.Bt + (size_t)cur.pb * tstep;
    S.a_ready(cur); cur.sb = 0;
    S.prefetch(cur, 0, wid, lane); PG8_WAIT_V(0); __syncthreads();
    PG8_ROWS(cur, va0, va1);
    PG8_STAGE(PG8_SB(0, 0), cB, voffB); PG8_STAGE(PG8_SA(0, 0), cA, va0); PG8_STAGE(PG8_SB(0, 1), cB + hstep, voffB); PG8_STAGE(PG8_SA(0, 1), cA, va1);
    if (wr == 1) PG8_BAR;
    PG8_WAIT_V(4); PG8_BAR;
    PG8_STAGE(PG8_SB(1, 0), cB + kstep, voffB); PG8_STAGE(PG8_SA(1, 0), cA + kstep, va0); PG8_STAGE(PG8_SB(1, 1), cB + hstep + kstep, voffB);
    PG8_WAIT_V(6); PG8_BAR;
    for (;;) {
        const bool has_next = S.next(ui + 1, nxt); nxt.sb = cur.sb == 2 ? 0 : cur.sb + 1;
        const char* nB = has_next ? (const char*)g.Bt + (size_t)nxt.pb * tstep : cB;
        if (has_next) S.prefetch(nxt, nxt.sb, wid, lane);
        for (int t = 0; t < nt; t += 2) {
            const bool last = (t == nt - 2);
            const char* a1 = cA + (size_t)(t + 1) * kstep;
            const char* a2 = last ? cA : cA + (size_t)(t + 2) * kstep; const char* b2 = last ? nB : cB + (size_t)(t + 2) * kstep;
            int tkr0[2], tkr1[2];
            { const PG8_LAS int* tk_ = S.tok_table(nxt.sb);
#pragma unroll
              for (int _i = 0; _i < 2; ++_i) { tkr0[_i] = tk_[RA[_i]]; tkr1[_i] = tk_[HALF + RA[_i]]; } }
            PG8_SCHED;
            const char* a3 = a2 + kstep; const char* b3 = b2 + kstep;
            if (last && has_next) S.a_ready(nxt);
            PG8_LDB(B0, 0, 0); PG8_SCHED; PG8_LDA(At, 0, 0); PG8_STAGE(PG8_SA(1, 1), a1, va1);
            PG8_WAIT_L(8); PG8_BAR; PG8_WAIT_L(0); PG8_MMA(0, 0, At, B0); PG8_BAR; PG8_SCHED;
            PG8_LDB(B1, 0, 1); PG8_STAGE(PG8_SB(0, 0), b2, voffB);
            PG8_BAR; PG8_WAIT_L(0); PG8_MMA(0, 1, At, B1); PG8_BAR;
            unsigned x0[2], x1[2];
#pragma unroll
            for (int _i = 0; _i < 2; ++_i) { vn0[_i] = has_next ? (unsigned)tkr0[_i] * (unsigned)(K * 2) + (unsigned)CA[_i] : va0[_i]; vn1[_i] = has_next ? (unsigned)tkr1[_i] * (unsigned)(K * 2) + (unsigned)CA[_i] : va1[_i];
                x0[_i] = last ? vn0[_i] : va0[_i]; x1[_i] = last ? vn1[_i] : va1[_i]; }
            PG8_SCHED;
            PG8_LDA(At, 0, 1); PG8_STAGE(PG8_SA(0, 0), a2, x0);
            PG8_BAR; PG8_WAIT_L(0); PG8_MMA(1, 0, At, B0); PG8_BAR; PG8_SCHED;
            PG8_STAGE(PG8_SB(0, 1), b2 + hstep, voffB);
            PG8_WAIT_V(6); PG8_BAR; PG8_MMA(1, 1, At, B1); PG8_BAR;
            PG8_LDB(B0, 1, 0); PG8_SCHED; PG8_LDA(At, 1, 0); PG8_STAGE(PG8_SA(0, 1), a2, x1);
            PG8_WAIT_L(8); PG8_BAR; PG8_WAIT_L(0); PG8_MMA(0, 0, At, B0); PG8_BAR; PG8_SCHED;
            PG8_LDB(B1, 1, 1); PG8_STAGE(PG8_SB(1, 0), b3, voffB);
            PG8_BAR; PG8_WAIT_L(0); PG8_MMA(0, 1, At, B1); PG8_BAR;
            PG8_LDA(At, 1, 1); PG8_STAGE(PG8_SA(1, 0), a3, x0);
            PG8_BAR; PG8_WAIT_L(0); PG8_MMA(1, 0, At, B0); PG8_BAR; PG8_SCHED;
            PG8_STAGE(PG8_SB(1, 1), b3 + hstep, voffB);
            PG8_WAIT_V(6); PG8_BAR; PG8_MMA(1, 1, At, B1); PG8_BAR;
        }
        E(acc, cur, wr, wc, fr, fq); S.done(cur);
        if (!has_next) break;
#pragma unroll
        for (int a = 0; a < 2; ++a)
#pragma unroll
            for (int b = 0; b < 2; ++b)
#pragma unroll
                for (int m = 0; m < 4; ++m)
#pragma unroll
                    for (int n = 0; n < 2; ++n) acc[a][b][m][n] = (f32x4){0.f, 0.f, 0.f, 0.f};
        cur = nxt; cB = nB; ++ui;
#pragma unroll
        for (int _i = 0; _i < 2; ++_i) { va0[_i] = vn0[_i]; va1[_i] = vn1[_i]; }
    }
    PG8_WAIT_V(0);
    if (wr == 0) PG8_BAR;
    PG8_BAR;
#undef PG8_ROWS
#undef PG8_SA
#undef PG8_SB
#undef PG8_STAGE
#undef PG8_LDA
#undef PG8_LDB
#undef PG8_MMA
#undef PG8_WAIT_V
#undef PG8_WAIT_L
#undef PG8_BAR
#undef PG8_SCHED
}
}
namespace fa {
constexpr float SCALE = 0.08838834764831845f;
constexpr float THR = 8.f;
constexpr int D = 128, NW = 8, QBLK = 32, KVBLK = 64, QB = NW * QBLK;
constexpr int SHM_V = KVBLK * D * 2, SHM_K = KVBLK * D * 2;
constexpr int OFF_WS = 2 * SHM_V + 2 * SHM_K, OFF_BIAS = OFF_WS + NW * 64 * 4, LDS_BYTES = OFF_BIAS + 2 * 256;
typedef short s16x4 __attribute__((ext_vector_type(4)));
typedef float f32x16 __attribute__((ext_vector_type(16)));
typedef unsigned u32x4 __attribute__((ext_vector_type(4)));

#define KSWZ(row, colB) ((row) * 256 + ((colB) ^ (((row) & 7) << 4)))
#define SBAR() __builtin_amdgcn_sched_barrier(0)
__device__ __forceinline__ int v_st(int k, int c) { const int kk = (k & ~0xC) | ((k & 4) << 1) | ((k & 8) >> 1); return ((kk >> 3) * 4 + (c >> 5)) * 512 + ((kk & 7) * 32 + (c & 31)) * 2; }
__device__ __forceinline__ int v_rd_base(int lane) { return ((lane & 3) << 3) | (((lane >> 2) & 3) << 6) | (((lane >> 4) & 1) << 5) | (((lane >> 5) & 1) << 8); }
constexpr int v_rd_off(int d0, int ks, int half) { return d0 * 512 + ks * 4096 + half * 2048; }
__device__ __forceinline__ int crow(int r, int hi) { return (r & 3) + 8 * (r >> 2) + 4 * hi; }
__device__ __forceinline__ unsigned cvtpk(float lo, float hi) { unsigned r; asm volatile("v_cvt_pk_bf16_f32 %0, %1, %2" : "=v"(r) : "v"(lo), "v"(hi)); return r; }
__device__ __forceinline__ bf16x8 load8(const bf16* p) { return *reinterpret_cast<const bf16x8*>(p); }
__device__ __forceinline__ void mask_tile(f32x16& p0, f32x16& p1, int dq, unsigned W) {
    const float NEG = -__builtin_inff();
#pragma unroll
    for (int r = 0; r < 16; ++r) {
        const int c = (r & 3) + 8 * (r >> 2);
        if ((unsigned)(dq - c) >= W) p0[r] = NEG;
        if ((unsigned)(dq - c - 32) >= W) p1[r] = NEG;
    }
}
__device__ __forceinline__ void partialSM(f32x16& p0, f32x16& p1, float& m_reg, float& mn, float& alpha) {
    float pmax = p0[0]; for (int r = 1; r < 16; ++r) pmax = fmaxf(pmax, p0[r]); for (int r = 0; r < 16; ++r) pmax = fmaxf(pmax, p1[r]);
    { auto rr = __builtin_amdgcn_permlane32_swap(__float_as_uint(pmax), __float_as_uint(pmax), false, false);
      pmax = fmaxf(__uint_as_float(rr[0]), __uint_as_float(rr[1])); }
    constexpr float C2 = 1.4426950408889634f * SCALE;
    if (__builtin_expect(__all((pmax - m_reg) * SCALE <= THR), 1)) { mn = m_reg; alpha = 1.f; }
    else { mn = fmaxf(m_reg, pmax); alpha = __builtin_amdgcn_exp2f((m_reg - mn) * C2); m_reg = mn; }
    const float mnL = -mn * C2;
    for (int r = 0; r < 16; ++r) p0[r] = fmaf(p0[r], C2, mnL); for (int r = 0; r < 16; ++r) p1[r] = fmaf(p1[r], C2, mnL);
    for (int r = 0; r < 16; ++r) p0[r] = __builtin_amdgcn_exp2f(p0[r]);
}
__device__ __forceinline__ void finishSM(f32x16& p0, f32x16& p1, float alpha, float& l_reg, bf16x8& pa0, bf16x8& pa1, bf16x8& pa2, bf16x8& pa3) {
    for (int r = 0; r < 16; ++r) p1[r] = __builtin_amdgcn_exp2f(p1[r]);
    float ps = 0; for (int r = 0; r < 16; ++r) ps += p0[r]; for (int r = 0; r < 16; ++r) ps += p1[r];
    { auto rr = __builtin_amdgcn_permlane32_swap(__float_as_uint(ps), __float_as_uint(ps), false, false);
      ps = __uint_as_float(rr[0]) + __uint_as_float(rr[1]); }
    l_reg = l_reg * alpha + ps;
#define PK4(P, B_, OUT) do { unsigned a0 = cvtpk(P[B_+0], P[B_+1]), a1 = cvtpk(P[B_+2], P[B_+3]);                          \
        unsigned b0 = cvtpk(P[B_+4], P[B_+5]), b1 = cvtpk(P[B_+6], P[B_+7]);                                             \
        auto r0 = __builtin_amdgcn_permlane32_swap(a0, b0, false, false); auto r1 = __builtin_amdgcn_permlane32_swap(a1, b1, false, false); \
        u32x4 w = {r0[0], r1[0], r0[1], r1[1]}; OUT = *reinterpret_cast<bf16x8*>(&w); } while (0)
    PK4(p0, 0, pa0); PK4(p0, 8, pa1); PK4(p1, 0, pa2); PK4(p1, 8, pa3);
#undef PK4
}
template <int KB, bool BIAS>
__device__ __forceinline__ void qkt(f32x16& p0, f32x16& p1, const char* K_lds, const char* B_lds, int r32, int hi, const bf16x8* qr) {
    if constexpr (BIAS) {
        const f32x4* bl = reinterpret_cast<const f32x4*>(B_lds + KB * 256 + hi * 16);
        const f32x4 a0 = bl[0], a1 = bl[2], a2 = bl[4], a3 = bl[6];
        p0 = (f32x16){a0.x, a0.y, a0.z, a0.w, a1.x, a1.y, a1.z, a1.w, a2.x, a2.y, a2.z, a2.w, a3.x, a3.y, a3.z, a3.w};
        const f32x4 c0 = bl[8], c1 = bl[10], c2 = bl[12], c3 = bl[14];
        p1 = (f32x16){c0.x, c0.y, c0.z, c0.w, c1.x, c1.y, c1.z, c1.w, c2.x, c2.y, c2.z, c2.w, c3.x, c3.y, c3.z, c3.w};
    } else { p0 = f32x16{}; p1 = f32x16{}; }
    const char* kb[4];
#pragma unroll
    for (int dd = 0; dd < 4; ++dd) kb[dd] = K_lds + KB * SHM_K + KSWZ(r32, (dd * 16 + hi * 8) * 2);
#pragma unroll
    for (int d0 = 0; d0 < 8; ++d0) { const char* a = kb[d0 & 3] + (d0 >> 2) * 128;
        bf16x8 b0 = *reinterpret_cast<const bf16x8*>(a);
        bf16x8 b1 = *reinterpret_cast<const bf16x8*>(a + 32 * 256);
        p0 = __builtin_amdgcn_mfma_f32_32x32x16_bf16(b0, qr[d0], p0, 0, 0, 0);
        p1 = __builtin_amdgcn_mfma_f32_32x32x16_bf16(b1, qr[d0], p1, 0, 0, 0); }
}
template <int KB>
__device__ __forceinline__ void add_bias(f32x16& p0, f32x16& p1, const char* B_lds, int hi) {
    const f32x4* bl = reinterpret_cast<const f32x4*>(B_lds + KB * 256 + hi * 16);
#pragma unroll
    for (int g = 0; g < 4; ++g) { const f32x4 a = bl[2 * g], c = bl[8 + 2 * g];
        p0[4 * g + 0] += a.x; p0[4 * g + 1] += a.y; p0[4 * g + 2] += a.z; p0[4 * g + 3] += a.w;
        p1[4 * g + 0] += c.x; p1[4 * g + 1] += c.y; p1[4 * g + 2] += c.z; p1[4 * g + 3] += c.w; }
}
template <int VB>
__device__ __forceinline__ void pv_tile(f32x16* o, int vb0, bf16x8 pa0, bf16x8 pa1, bf16x8 pa2, bf16x8 pa3) {
#define TRRD(dst, off) asm volatile("ds_read_b64_tr_b16 %0, %1 offset:%2" : "=&v"(dst) : "v"(vb0), "i"(off) : "memory")
#define PV_D0(d0) do { s16x4 l0, l1, l2, l3, h0, h1, h2, h3; constexpr int b_ = VB * SHM_V + v_rd_off(d0, 0, 0);   \
        TRRD(l0, b_); TRRD(h0, b_ + 2048); TRRD(l1, b_ + 4096); TRRD(h1, b_ + 6144); TRRD(l2, b_ + 8192); TRRD(h2, b_ + 10240); TRRD(l3, b_ + 12288); TRRD(h3, b_ + 14336); \
        asm volatile("s_waitcnt lgkmcnt(0)" ::: "memory"); SBAR();   \
        o[d0] = __builtin_amdgcn_mfma_f32_32x32x16_bf16(pa0, (bf16x8){l0[0], l0[1], l0[2], l0[3], h0[0], h0[1], h0[2], h0[3]}, o[d0], 0, 0, 0);   \
        o[d0] = __builtin_amdgcn_mfma_f32_32x32x16_bf16(pa1, (bf16x8){l1[0], l1[1], l1[2], l1[3], h1[0], h1[1], h1[2], h1[3]}, o[d0], 0, 0, 0);   \
        o[d0] = __builtin_amdgcn_mfma_f32_32x32x16_bf16(pa2, (bf16x8){l2[0], l2[1], l2[2], l2[3], h2[0], h2[1], h2[2], h2[3]}, o[d0], 0, 0, 0);   \
        o[d0] = __builtin_amdgcn_mfma_f32_32x32x16_bf16(pa3, (bf16x8){l3[0], l3[1], l3[2], l3[3], h3[0], h3[1], h3[2], h3[3]}, o[d0], 0, 0, 0); } while (0)
    PV_D0(0); PV_D0(1); PV_D0(2); PV_D0(3);
#undef PV_D0
#undef TRRD
}

struct BlockRef { const bf16* Q; const bf16* K; const bf16* V; const float* Bk; bf16* O; int P0; };
struct Seam { bf16x8 qr[8]; bf16x8 st_v0, st_v1, st_k0, st_k1; };
__device__ __forceinline__ int swa_jlo(int P0, int W) { const int lowk = P0 - W + 1; return lowk > 0 ? lowk / KVBLK : 0; }

#define ROWK(p, k0, rr) ((p) + (size_t)((k0) + (rr)) * KS + sc)
#define ROWV(p, k0, rr) ((p) + (size_t)((k0) + (rr)) * VS + sc)
#define VMW() asm volatile("s_waitcnt vmcnt(0)" ::: "memory")
#define VMWN(n) asm volatile("s_waitcnt vmcnt(%0)" :: "i"(n) : "memory")
#define SLOAD_H(R_, k0, bfb) do { S.st_v0 = load8(ROWV((R_).V, k0, sr)); S.st_v1 = load8(ROWV((R_).V, k0, 32 + sr));              \
                         S.st_k0 = load8(ROWK((R_).K, k0, sr)); S.st_k1 = load8(ROWK((R_).K, k0, 32 + sr));                  \
                         if constexpr (BIAS) { if (wid == 0) __builtin_amdgcn_global_load_lds((const unsigned*)((R_).Bk + (k0) + lane), (LAS unsigned*)((LAS char*)B_lds + (bfb) * 256), 4, 0, 0); } } while (0)
#define SWRITE_HK(bf) do { *(bf16x8*)(K_lds + (bf) * SHM_K + kws) = S.st_k0; *(bf16x8*)(K_lds + (bf) * SHM_K + kws + 32 * 256) = S.st_k1; } while (0)
#define SWRITE_HV(bf) do { *(bf16x8*)(V_lds + (bf) * SHM_V + vst0) = S.st_v0; *(bf16x8*)(V_lds + (bf) * SHM_V + vst1) = S.st_v1; } while (0)
#define SWRITE_H(bf) do { SWRITE_HV(bf); SWRITE_HK(bf); } while (0)

template <bool BIAS, int QS, int KS, int VS, int OS>
__device__ __forceinline__ void attn_prime(const BlockRef& cur, int W, char* lds, Seam& S) {
    const int tid = threadIdx.x, wid = __builtin_amdgcn_readfirstlane(tid >> 6), lane = tid & 63, r32 = lane & 31, hi = lane >> 5;
    const int sr = tid >> 4, sc = (tid & 15) * 8, kws = KSWZ(sr, sc * 2); char* K_lds = lds + 2 * SHM_V; char* B_lds = lds + OFF_BIAS;
    const int kb0 = swa_jlo(cur.P0, W) * KVBLK;
    for (int d0 = 0; d0 < 8; ++d0) S.qr[d0] = load8(cur.Q + (size_t)(wid * QBLK + r32) * QS + d0 * 16 + hi * 8);
    SLOAD_H(cur, kb0, 0); VMW(); SWRITE_HK(0);
    __syncthreads();
}
template <bool BIAS, int QS, int KS, int VS, int OS>
__device__ __forceinline__ void attn_block(const BlockRef& cur, const BlockRef& nxt, int skv, int W, char* lds, Seam& S) {
    int tid_ = threadIdx.x; asm volatile("" : "+v"(tid_));
    const int tid = tid_, wid = __builtin_amdgcn_readfirstlane(tid >> 6), lane = tid & 63, r32 = lane & 31, hi = lane >> 5;
    const int j_lo = swa_jlo(cur.P0, W);
    int j_hi = (cur.P0 + QB - 1) / KVBLK + 1; if (j_hi > skv / KVBLK) j_hi = skv / KVBLK;
    const int NT = j_hi - j_lo;
    const int kbn = swa_jlo(nxt.P0, W) * KVBLK;
    const int qlo = cur.P0 + wid * QBLK, qm = qlo + r32 - 4 * hi;
    char* V_lds = lds; char* K_lds = lds + 2 * SHM_V; char* B_lds = lds + OFF_BIAS;
    float* ws = (float*)(lds + OFF_WS) + wid * 64; float* li_l = ws, * al_l = ws + 32;
    float m_reg = -1e30f, l_reg = 0; f32x16 o[4] = {};
    const int sr = tid >> 4, sc = (tid & 15) * 8, vst0 = v_st(sr, sc), vst1 = v_st(32 + sr, sc), kws = KSWZ(sr, sc * 2);
    const int vb0 = (int)(uintptr_t)V_lds + v_rd_base(lane);
#define RESC(a) do { if (__any((a) < 1.f)) { if (hi == 0) al_l[r32] = (a); asm volatile("s_waitcnt lgkmcnt(0)" ::: "memory");              \
                     for (int d_ = 0; d_ < 4; ++d_) for (int r = 0; r < 16; ++r) o[d_][r] *= al_l[crow(r, hi)]; } } while (0)
#define KBASE(t) ((j_lo + (t)) * KVBLK)
#define MASKT(P0_, P1_, t, KB_) do { const int kb_ = KBASE(t); if (kb_ + KVBLK - 1 > qlo || kb_ <= qlo + QBLK - 1 - W) mask_tile(P0_, P1_, qm - kb_, (unsigned)W); } while (0)
    constexpr int NQL = 8;
#define SEAM_K0() do { VMWN(NQL); SWRITE_HK(0); SBAR(); } while (0)
    f32x16 pA0, pA1, pB0, pB1; float mnA, mnB, alA, alB; bf16x8 pa0, pa1, pa2, pa3;
    SWRITE_HV(0); SBAR();
    if (NT > 1) { SLOAD_H(cur, KBASE(1), 1); }
    SBAR(); qkt<0, BIAS>(pA0, pA1, K_lds, B_lds, r32, hi, S.qr);
    MASKT(pA0, pA1, 0, 0); partialSM(pA0, pA1, m_reg, mnA, alA);
    if (NT > 1) { VMW(); SWRITE_H(1); }
    __syncthreads();
#define HALF_STEP(PX0, PX1, mnX, alX, PY0, PY1, alY, t, KB, VB, SB) do {                                                      \
        SBAR(); qkt<KB, BIAS>(PX0, PX1, K_lds, B_lds, r32, hi, S.qr);                                                         \
        finishSM(PY0, PY1, alY, l_reg, pa0, pa1, pa2, pa3); SBAR();                                                           \
        if ((t) + 1 < NT) { SLOAD_H(cur, KBASE((t) + 1), SB); SBAR(); }                                                           \
        pv_tile<VB>(o, vb0, pa0, pa1, pa2, pa3); MASKT(PX0, PX1, (t), KB); partialSM(PX0, PX1, m_reg, mnX, alX);                  \
        __syncthreads();                                                                                                      \
        if ((t) + 1 < NT) { VMW(); SWRITE_H(SB); }                                                                            \
        RESC(alX); __syncthreads(); } while (0)
    for (int t = 1; t + 1 < NT; t += 2) {
        HALF_STEP(pB0, pB1, mnB, alB, pA0, pA1, alA, t, 1, 0, 0);
        HALF_STEP(pA0, pA1, mnA, alA, pB0, pB1, alB, t + 1, 0, 1, 1);
    }
    const bool even = (NT & 1) == 0;
    if (even) { SBAR(); qkt<1, BIAS>(pB0, pB1, K_lds, B_lds, r32, hi, S.qr); SBAR(); }
    SLOAD_H(nxt, kbn, 0); SBAR();
#pragma unroll
    for (int d0 = 0; d0 < 8; ++d0) S.qr[d0] = load8(nxt.Q + (size_t)(wid * QBLK + r32) * QS + d0 * 16 + hi * 8);
    SBAR();
    finishSM(pA0, pA1, alA, l_reg, pa0, pa1, pa2, pa3); SBAR();
    pv_tile<0>(o, vb0, pa0, pa1, pa2, pa3);
    if (even) { MASKT(pB0, pB1, NT - 1, 1); partialSM(pB0, pB1, m_reg, mnB, alB); __syncthreads(); RESC(alB);
        finishSM(pB0, pB1, alB, l_reg, pa0, pa1, pa2, pa3); SBAR(); pv_tile<1>(o, vb0, pa0, pa1, pa2, pa3); }
    SBAR(); SEAM_K0();
    if (hi == 0) li_l[r32] = l_reg; asm volatile("s_waitcnt lgkmcnt(0)" ::: "memory");
    float rli[16];
#pragma unroll
    for (int r = 0; r < 16; ++r) rli[r] = __builtin_amdgcn_rcpf(li_l[crow(r, hi)]);
    int tid_e = threadIdx.x; asm volatile("" : "+v"(tid_e)); const int lane_e = tid_e & 63;
    const int r32e = lane_e & 31, hie = lane_e >> 5;
    bf16* Ow = cur.O + (size_t)(wid * QBLK + 4 * hie) * OS + r32e;
#pragma unroll
    for (int r = 0; r < 16; ++r) { const int orow = (r & 3) + 8 * (r >> 2);
#pragma unroll
        for (int d0 = 0; d0 < 4; ++d0) { const float v = o[d0][r] * rli[r];
            const float vn = __shfl_xor(v, 1);
            if ((r32e & 1) == 0) *(unsigned*)(Ow + (size_t)orow * OS + d0 * 32) = cvtpk(v, vn); } }
    __syncthreads();
#undef RESC
#undef KBASE
#undef MASKT
#undef SEAM_K0
#undef HALF_STEP
}
#undef ROWK
#undef ROWV
#undef VMW
#undef VMWN
#undef SLOAD_H
#undef SWRITE_HK
#undef SWRITE_HV
#undef SWRITE_H
#undef KSWZ
#undef SBAR
}
namespace gla {
typedef float f32x16 __attribute__((ext_vector_type(16)));
typedef short s16x4 __attribute__((ext_vector_type(4)));
constexpr int CH = 64, NCH = SEQ / CH, DK = 256, DV = 512, NH = 4;
constexpr int L_QK = 0, QK_BYTES = 32768, NQK = 3;
constexpr int L_VA = NQK * QK_BYTES, VA_BYTES = 25600;
constexpr int LDS_BYTES = L_VA + 2 * VA_BYTES;

__device__ __forceinline__ unsigned swz(unsigned row) { return ((row & 3u) << 2) | ((row >> 2) & 3u); }
__device__ __forceinline__ unsigned off_b(unsigned row, unsigned ch) { return 256u * row + 16u * (ch ^ swz(row)); }
__device__ __forceinline__ unsigned row_read_addr(unsigned lane, unsigned s) { return off_b(lane & 31u, 2u * s + (lane >> 5)); }
__device__ __forceinline__ unsigned tr_read_addr(unsigned lane, unsigned c, unsigned ks, unsigned t) {
    const unsigned h = lane >> 5, blk = (lane >> 4) & 1u, q = (lane & 15u) >> 2, p = lane & 3u;
    return off_b(16u * ks + 8u * h + 4u * t + q, 4u * c + 2u * blk + (p >> 1)) + 8u * (p & 1u);
}
__device__ __forceinline__ unsigned cvtpk(float lo, float hi) { unsigned r; asm volatile("v_cvt_pk_bf16_f32 %0, %1, %2" : "=v"(r) : "v"(lo), "v"(hi)); return r; }
#define GLA_TRRD(dst, addr) asm volatile("ds_read_b64_tr_b16 %0, %1" : "=&v"(dst) : "v"(addr) : "memory")
#define GLA_LWAIT() do { asm volatile("s_waitcnt lgkmcnt(0)" ::: "memory"); __builtin_amdgcn_sched_barrier(0); } while (0)

__device__ __forceinline__ void apass_job(const bf16* QT, const bf16* KT, bf16* AT, int job, int lane) {
    const int tile = job % 3, cc = job / 3, c = cc & (NCH - 1), bh = cc >> 6;
    const int tm = tile ? 1 : 0, tn = tile == 2 ? 1 : 0, r32 = lane & 31, h = lane >> 5;
    const bf16* qrow = QT + ((size_t)bh * SEQ + c * CH + 32 * tm + r32) * DK + 8 * h;
    const bf16* krow = KT + ((size_t)bh * SEQ + c * CH + 32 * tn + r32) * DK + 8 * h;
    f32x16 acc = {};
#pragma unroll
    for (int kb = 0; kb < 4; ++kb) {
        bf16x8 qa[4], ka[4];
#pragma unroll
        for (int k = 0; k < 4; ++k) { qa[k] = *(const bf16x8*)(qrow + 16 * (4 * kb + k)); ka[k] = *(const bf16x8*)(krow + 16 * (4 * kb + k)); }
#pragma unroll
        for (int k = 0; k < 4; ++k) acc = __builtin_amdgcn_mfma_f32_32x32x16_bf16(ka[k], qa[k], acc, 0, 0, 0);
    }
    const int t = 32 * tm + r32;
    bf16* dst = AT + (((size_t)bh * NCH + c) * CH + t) * CH + 32 * tn + 4 * h;
#pragma unroll
    for (int g = 0; g < 4; ++g) {
        const int s0 = 32 * tn + 8 * g + 4 * h;
        float v[4];
#pragma unroll
        for (int e = 0; e < 4; ++e) v[e] = (s0 + e <= t) ? acc[4 * g + e] : 0.f;
        *(v2u*)(dst + 8 * g) = (v2u){cvtpk(v[0], v[1]), cvtpk(v[2], v[3])};
    }
}

struct ScanRef { const bf16* QT; const bf16* KT; const bf16* VG; const bf16* AT; const float* EBL; float* O; };

__device__ __forceinline__ void dma_qk(const ScanRef& R, LAS unsigned char* lds, int n, int nb, int hw, int lane_) {
    int lane = lane_; asm volatile("" : "+v"(lane));
    const int c = n >> 1, hh = n & 1; LAS unsigned char* buf = lds + L_QK + nb * QK_BYTES;
#pragma unroll
    for (int i = 0; i < 8; ++i) {
        const int j = i * 4 + hw;
        const int img = j >> 3, j8 = j & 7, row = 4 * j8 + (lane >> 4), ch = (lane & 15) ^ (int)swz((unsigned)row);
        const bf16* src = ((img >> 1) ? R.KT : R.QT) + ((size_t)(c * CH + 32 * (img & 1) + row)) * DK + 128 * hh + 8 * ch;
        __builtin_amdgcn_global_load_lds((const unsigned*)src, (LAS unsigned*)(buf + img * 8192 + j8 * 1024), 16, 0, 0);
    }
}
__device__ __forceinline__ void dma_va(const ScanRef& R, LAS unsigned char* lds, int c, int hw, int lane_) {
    int lane = lane_; asm volatile("" : "+v"(lane));
    LAS unsigned char* buf = lds + L_VA + (c & 1) * VA_BYTES;
#pragma unroll
    for (int i = 0; i < 7; ++i) {
        const int j = i * 4 + hw;
        const int j8 = j & 7, row = 4 * j8 + (lane >> 4), ch = (lane & 15) ^ (int)swz((unsigned)row);
        if (j < 16) {
            const bf16* src = R.VG + ((size_t)(c * CH + 32 * (j >> 3) + row)) * DV + 8 * ch;
            __builtin_amdgcn_global_load_lds((const unsigned*)src, (LAS unsigned*)(buf + (j >> 3) * 8192 + j8 * 1024), 16, 0, 0);
        } else if (j < 24) {
            const int t = row + 32 * (ch >> 3), s0 = 8 * (ch & 7);
            const bf16* src = R.AT + ((size_t)c * CH + t) * CH + s0;
            __builtin_amdgcn_global_load_lds((const unsigned*)src, (LAS unsigned*)(buf + 16384 + j8 * 1024), 16, 0, 0);
        } else {
            const float* src = R.EBL + (size_t)c * DK + 4 * lane;
            __builtin_amdgcn_global_load_lds((const unsigned*)src, (LAS unsigned*)(buf + 24576), 16, 0, 0);
        }
    }
}

__device__ __forceinline__ unsigned vxor(unsigned a, const unsigned k) { unsigned r; asm volatile("v_xor_b32 %0, %1, %2" : "=v"(r) : "i"(k), "v"(a)); return r; }
#define GLA_TRRDO(dst, addr, off) asm volatile("ds_read_b64_tr_b16 %0, %1 offset:%2" : "=&v"(dst) : "v"(addr), "i"(off) : "memory")
#define GLA_LWAITN(n) do { asm volatile("s_waitcnt lgkmcnt(" #n ")" ::: "memory"); __builtin_amdgcn_sched_barrier(0); } while (0)
template <int HH>
__device__ __forceinline__ void scan_half(f32x16 (&S)[8], f32x16 (&acc)[2], bf16x8 (&vf)[4], unsigned qk, unsigned va, int w, float* Orow) {
    int t_ = threadIdx.x; asm volatile("" : "+v"(t_));
    const unsigned lane = (unsigned)t_ & 63u, r32 = lane & 31u, h = lane >> 5, blk = (lane >> 4) & 1u, q = (lane & 15u) >> 2, p = lane & 3u;
    const unsigned sw = swz(r32);
    const unsigned qbase = 256u * r32 + (sw << 4) + 8u * h + qk;
    const unsigned abase = (256u * r32 + (sw << 4)) ^ (h << 4);
    const unsigned tr0 = 256u * (8u * h + q) + 8u * (p & 1u) + 16u * ((2u * blk + (p >> 1)) ^ (2u * h)) + 64u * q;
    const unsigned tr1 = 256u * (8u * h + 4u + q) + 8u * (p & 1u) + 16u * ((2u * blk + (p >> 1)) ^ (2u * h + 1u)) + 64u * q;
    const unsigned kb0 = tr0 + qk + 16384u, kb1 = tr1 + qk + 16384u;
    s16x4 loA[4], hiA[4];
#define GLA_LOADK(il, lo, hi) do { const unsigned k0_ = vxor(kb0, (unsigned)((il) << 6)), k1_ = vxor(kb1, (unsigned)((il) << 6)); \
        _Pragma("unroll") for (int kk = 0; kk < 4; ++kk) { GLA_TRRDO(lo[kk], k0_, (kk >> 1) * 8192 + (kk & 1) * 4096); GLA_TRRDO(hi[kk], k1_, (kk >> 1) * 8192 + (kk & 1) * 4096); } } while (0)
#define GLA_MMAK(il, lo, hi) do { f32x16& X = S[4 * HH + (il)]; \
        _Pragma("unroll") for (int kk = 0; kk < 4; ++kk) X = __builtin_amdgcn_mfma_f32_32x32x16_bf16((bf16x8){lo[kk][0], lo[kk][1], lo[kk][2], lo[kk][3], hi[kk][0], hi[kk][1], hi[kk][2], hi[kk][3]}, vf[kk], X, 0, 0, 0); } while (0)
#define GLA_SCALE(il) do { f32x16& X = S[4 * HH + (il)]; \
        const LAS float* eb = (const LAS float*)(uintptr_t)(va + 24576u + 4u * (32u * (4 * HH + (il)) + 4u * h)); \
        _Pragma("unroll") for (int g = 0; g < 4; ++g) { const f32x4 e = *(const LAS f32x4*)(eb + 8 * g); X[4 * g + 0] *= e.x; X[4 * g + 1] *= e.y; X[4 * g + 2] *= e.z; X[4 * g + 3] *= e.w; } } while (0)
    if constexpr (HH == 0) {
        const unsigned v0 = (tr0 ^ ((unsigned)w << 6)) + va, v1 = (tr1 ^ ((unsigned)w << 6)) + va;
        s16x4 lo[4], hi[4];
#pragma unroll
        for (int kk = 0; kk < 4; ++kk) { GLA_TRRDO(lo[kk], v0, (kk >> 1) * 8192 + (kk & 1) * 4096); GLA_TRRDO(hi[kk], v1, (kk >> 1) * 8192 + (kk & 1) * 4096); }
        GLA_LWAITN(0);
#pragma unroll
        for (int kk = 0; kk < 4; ++kk) vf[kk] = (bf16x8){lo[kk][0], lo[kk][1], lo[kk][2], lo[kk][3], hi[kk][0], hi[kk][1], hi[kk][2], hi[kk][3]};
        acc[0] = f32x16{}; acc[1] = f32x16{};
        const unsigned ab = abase + va + 16384u;
#pragma unroll
        for (int m = 0; m < 2; ++m)
#pragma unroll
            for (int kk = 0; kk < 2 + 2 * m; ++kk) { const bf16x8 a = *(const LAS bf16x8*)(uintptr_t)vxor(ab, (unsigned)((4 * m + kk) << 5)); acc[m] = __builtin_amdgcn_mfma_f32_32x32x16_bf16(a, vf[kk], acc[m], 0, 0, 0); }
    }
    GLA_LOADK(0, loA, hiA);
#pragma unroll
    for (int il = 0; il < 4; ++il) {
        const f32x16& X = S[4 * HH + il];
#pragma unroll
        for (int s2 = 0; s2 < 2; ++s2) {
            const v4u bw = {cvtpk(X[8 * s2 + 0], X[8 * s2 + 1]), cvtpk(X[8 * s2 + 2], X[8 * s2 + 3]), cvtpk(X[8 * s2 + 4], X[8 * s2 + 5]), cvtpk(X[8 * s2 + 6], X[8 * s2 + 7])};
            const bf16x8 bfr = __builtin_bit_cast(bf16x8, bw);
            const unsigned a0 = vxor(qbase, (unsigned)((4 * il + 2 * s2) << 4)), a1 = vxor(qbase, (unsigned)((4 * il + 2 * s2 + 1) << 4));
#pragma unroll
            for (int m = 0; m < 2; ++m) {
                const v2u p0 = *(const LAS v2u*)(uintptr_t)(a0 + m * 8192), p1 = *(const LAS v2u*)(uintptr_t)(a1 + m * 8192);
                const v4u aw = {p0.x, p0.y, p1.x, p1.y};
                acc[m] = __builtin_amdgcn_mfma_f32_32x32x16_bf16(__builtin_bit_cast(bf16x8, aw), bfr, acc[m], 0, 0, 0);
            }
        }
    }
    if constexpr (HH == 1) {
        float* ob = Orow + (size_t)(4u * h) * DM + 32 * w + r32;
#pragma unroll
        for (int m = 0; m < 2; ++m)
#pragma unroll
            for (int r = 0; r < 16; ++r) ob[(size_t)(32 * m + (r & 3) + 8 * (r >> 2)) * DM] = acc[m][r];
    }
    GLA_LWAITN(0); GLA_MMAK(0, loA, hiA); __builtin_amdgcn_sched_barrier(0); GLA_LOADK(1, loA, hiA); GLA_SCALE(0);
    GLA_LWAITN(0); GLA_MMAK(1, loA, hiA); __builtin_amdgcn_sched_barrier(0); GLA_LOADK(2, loA, hiA); GLA_SCALE(1);
    GLA_LWAITN(0); GLA_MMAK(2, loA, hiA); __builtin_amdgcn_sched_barrier(0); GLA_LOADK(3, loA, hiA); GLA_SCALE(2);
    GLA_LWAITN(0); GLA_MMAK(3, loA, hiA); GLA_SCALE(3);
#undef GLA_LOADK
#undef GLA_MMAK
#undef GLA_SCALE
}

__device__ __forceinline__ void scan_item(const ScanRef& R, LAS unsigned char* lds) {
    int tid_ = threadIdx.x; asm volatile("" : "+v"(tid_));
    const int tid = tid_, wid = __builtin_amdgcn_readfirstlane(tid >> 6), lane = tid & 63;
    __syncthreads();
#define GLA_BAR() do { asm volatile("s_waitcnt lgkmcnt(0)" ::: "memory"); __builtin_amdgcn_s_barrier(); asm volatile("" ::: "memory"); } while (0)
    if (wid >= 4) {
        const int hw = wid & 3; int nb = 0;
        dma_qk(R, lds, 0, 0, hw, lane); dma_qk(R, lds, 1, 1, hw, lane); dma_va(R, lds, 0, hw, lane); asm volatile("s_waitcnt vmcnt(0)" ::: "memory");
        for (int c = 0; c < NCH; ++c) {
            GLA_BAR();
            { const int nb2 = nb >= 1 ? nb - 1 : 2;
              if (c + 1 < NCH) { dma_qk(R, lds, 2 * c + 2, nb2, hw, lane); dma_va(R, lds, c + 1, hw, lane); asm volatile("s_waitcnt vmcnt(15)" ::: "memory"); }
              else asm volatile("s_waitcnt vmcnt(0)" ::: "memory"); }
            nb = nb == 2 ? 0 : nb + 1;
            GLA_BAR();
            { const int nb2 = nb >= 1 ? nb - 1 : 2;
              if (c + 1 < NCH) { dma_qk(R, lds, 2 * c + 3, nb2, hw, lane); asm volatile("s_waitcnt vmcnt(8)" ::: "memory"); }
              else asm volatile("s_waitcnt vmcnt(0)" ::: "memory"); }
            nb = nb == 2 ? 0 : nb + 1;
        }
        GLA_BAR();
    } else {
        f32x16 S[8]; f32x16 acc[2]; bf16x8 vf[4]; int nb = 0;
#pragma unroll
        for (int i = 0; i < 8; ++i) S[i] = f32x16{};
        acc[0] = f32x16{}; acc[1] = f32x16{};
#pragma unroll
        for (int i = 0; i < 4; ++i) vf[i] = bf16x8{};
        for (int c = 0; c < NCH; ++c) {
            const unsigned va = (unsigned)(L_VA + (c & 1) * VA_BYTES);
            GLA_BAR();
            scan_half<0>(S, acc, vf, (unsigned)(L_QK + nb * QK_BYTES), va, wid, R.O + (size_t)c * CH * DM);
            nb = nb == 2 ? 0 : nb + 1;
            GLA_BAR();
            scan_half<1>(S, acc, vf, (unsigned)(L_QK + nb * QK_BYTES), va, wid, R.O + (size_t)c * CH * DM);
            nb = nb == 2 ? 0 : nb + 1;
        }
        GLA_BAR();
    }
#undef GLA_BAR
}
#undef GLA_TRRD
#undef GLA_TRRDO
#undef GLA_LWAIT
#undef GLA_LWAITN
}
constexpr int NWAVES = 8;
constexpr int LDS_BYTES = 163840;
constexpr int RING_BYTES = 131072;
constexpr int CTLW = 159744;

constexpr size_t MiB = (size_t)1 << 20;
constexpr size_t WS_CTL = 0, CTL_BYTES = 1 * MiB;
constexpr size_t WS_WTIN = CTL_BYTES;
constexpr size_t WS_WTBG = WS_WTIN + (size_t)INCP * DM * 2;
constexpr size_t WS_WTBF = WS_WTBG + (size_t)DM * DM * 2;
constexpr size_t WS_WTOUT = WS_WTBF + (size_t)DM * DM * 2;
constexpr size_t WS_WTMQ = WS_WTOUT + (size_t)DM * DM * 2;
constexpr size_t WS_WTMKV = WS_WTMQ + (size_t)512 * DM * 2;
constexpr size_t WS_WTMO = WS_WTMKV + (size_t)1024 * DM * 2;
constexpr size_t WS_WTUP = WS_WTMO + (size_t)DM * 512 * 2;
constexpr size_t WS_WTDN = WS_WTUP + (size_t)NE * 4096 * DM * 2;
constexpr size_t WS_WRT = WS_WTDN + (size_t)NE * DM * DM * 2;
constexpr size_t WS_QT = WS_WRT + (size_t)256 * DM * 2;
constexpr size_t WS_KT = WS_QT + (size_t)T * 1024 * 2;
constexpr size_t WS_VG = WS_KT + (size_t)T * 1024 * 2;
constexpr size_t WS_SG = WS_VG + (size_t)T * DM * 2;
constexpr size_t WS_FQH = WS_SG + (size_t)T * DM * 2;
constexpr size_t WS_FKH = WS_FQH + (size_t)T * DM * 2;
constexpr size_t WS_FVH = WS_FKH + (size_t)T * DM * 2;
constexpr size_t WS_GG = WS_FVH + (size_t)T * DM * 2;
constexpr size_t WS_GF = WS_GG + (size_t)T * DM * 2;
constexpr size_t WS_YB = WS_QT;
static_assert(WS_GF + (size_t)T * DM * 2 - WS_QT >= (size_t)PMAX * DM * 2, "YB overlay");
constexpr size_t WS_OGLA = WS_GF + (size_t)T * DM * 2;
constexpr size_t WS_Y2 = WS_OGLA + (size_t)T * DM * 4;
constexpr size_t WS_H = WS_Y2 + (size_t)T * DM * 4;
constexpr size_t WS_ACT = WS_OGLA;
static_assert(WS_H + (size_t)T * DM * 2 - WS_OGLA >= (size_t)PMAX * DM * 2, "ACT overlay");
constexpr size_t WS_Y1 = WS_H + (size_t)T * DM * 2;
constexpr size_t WS_X1 = WS_Y1 + (size_t)T * DM * 4;
constexpr size_t WS_X2 = WS_X1 + (size_t)T * DM * 4;
constexpr size_t WS_ATT = WS_X2 + (size_t)T * DM * 4;
constexpr size_t WS_ON = WS_ATT + (size_t)T * DM * 2;
constexpr size_t WS_MRG = WS_ON + (size_t)T * DM * 2;
constexpr size_t WS_H2 = WS_MRG + (size_t)T * DM * 2;
constexpr size_t WS_XS = WS_H2 + (size_t)T * DM * 2;
constexpr size_t WS_OM = WS_XS + (size_t)T * DM * 2;
constexpr size_t WS_MN = WS_OM + (size_t)T * 512 * 2;
constexpr size_t WS_QM = WS_MN + (size_t)1024 * DM * 2;
constexpr size_t WS_KV = WS_QM + (size_t)T * 1024 * 4;
constexpr size_t WS_ASG = WS_KV + (size_t)1024 * 4096 * 4;
constexpr size_t WS_TOKL = WS_ASG + (size_t)NASG * 8;
constexpr size_t WS_WL = WS_TOKL + (size_t)NE * T * 4;
constexpr size_t WS_RSL = WS_WL + (size_t)NE * T * 4;
constexpr size_t WS_RSS1 = WS_RSL + (size_t)NE * T * 4;
constexpr size_t WS_RSS2 = WS_RSS1 + (size_t)T * 32 * 4;
constexpr size_t WS_LOG = WS_RSS2 + (size_t)T * 32 * 4;
constexpr size_t WS_EBL = WS_LOG + (size_t)T * 128 * 4;
constexpr size_t WS_AT = WS_EBL + (size_t)16 * 64 * 256 * 4;
constexpr size_t WS_GAFF = WS_AT + (size_t)16 * 64 * 64 * 64 * 2;
constexpr size_t WS_CB = WS_GAFF + (size_t)T * 128 * 4;
constexpr size_t WS_QMB = WS_CB + (size_t)NB * 16 * SEQ * 4;
constexpr size_t WS_KNB = WS_QMB + (size_t)T * 512 * 2;
constexpr size_t WS_VB = WS_KNB + (size_t)NB * 4 * MEML * 128 * 2;
constexpr size_t WS_END = WS_VB + (size_t)NB * 4 * MEML * 128 * 2;
constexpr int CW_CNT = 0, CW_NT = 64, CW_FOXQ = 128  , CW_GLA = 1024  , CW_BAR = 4096;

struct Args { const float* in[27]; float* out; unsigned char* ws; int ph_lo, ph_hi; };
struct Frame { LAS unsigned char* lds; int tid, lane, wave, G, bid, gw, ngw; };

__device__ __forceinline__ void p0_transpose_item(const float* W, int K, int N, bf16* WT, LAS float* scr, int item, int lane) {
    const int nblk = N / 32, kb = item / nblk, nb = item % nblk, k0 = 64 * kb, n0 = 32 * nb;
#pragma unroll 8
    for (int i = 0; i < 32; ++i) { const int kk = 2 * i + (lane >> 5); scr[kk * 33 + (lane & 31)] = W[(size_t)(k0 + kk) * N + n0 + (lane & 31)]; }
    LDS_WAIT(); asm volatile("" ::: "memory");
    const int c = lane & 7;
#pragma unroll
    for (int j = 0; j < 4; ++j) { const int n = (lane >> 3) + 8 * j; const LAS float* s = scr + (8 * c) * 33 + n;
        v4u o; o.x = pk2(s[0 * 33], s[1 * 33]); o.y = pk2(s[2 * 33], s[3 * 33]); o.z = pk2(s[4 * 33], s[5 * 33]); o.w = pk2(s[6 * 33], s[7 * 33]);
        *(v4u*)(WT + (size_t)(n0 + n) * K + k0 + 8 * c) = o; }
    LDS_WAIT(); asm volatile("" ::: "memory");
}
__device__ __forceinline__ void transpose_job(Frame& F, const float* W, int K, int N, int batch, bf16* WT) {
    LAS float* scr = (LAS float*)(F.lds + F.wave * 16384);
    const int per = (K / 64) * (N / 32); const long total = (long)per * batch;
    for (long it = F.gw; it < total; it += F.ngw) { const int e = (int)(it / per), r = (int)(it % per);
        p0_transpose_item(W + (size_t)e * K * N, K, N, WT + (size_t)e * N * K, scr, r, F.lane); }
}
__device__ __forceinline__ void rms_row_bf16(const float* xrow, const float* g, bf16* orow, int lane) {
    const f32x4* xr = (const f32x4*)xrow + lane; const f32x4* gr = (const f32x4*)g + lane;
    f32x4 v[8]; float s = 0.f;
#pragma unroll
    for (int j = 0; j < 8; ++j) { v[j] = xr[64 * j]; s += (v[j].x * v[j].x + v[j].y * v[j].y) + (v[j].z * v[j].z + v[j].w * v[j].w); }
    const float r = 1.0f / sqrtf(wave_sum(s) * (1.f / DM) + EPS);
    v2u* o8 = (v2u*)orow + lane;
#pragma unroll
    for (int j = 0; j < 8; ++j) { const f32x4 gg = gr[64 * j]; v2u w; w.x = pk2(v[j].x * r * gg.x, v[j].y * r * gg.y); w.y = pk2(v[j].z * r * gg.z, v[j].w * r * gg.w); o8[64 * j] = w; }
}

__device__ __forceinline__ void rms_rows2_bf16(const float* xa, const float* xb, const float* g, bf16* oa, bf16* ob, int lane) {
    const f32x4* pa = (const f32x4*)xa + lane; const f32x4* pb = (const f32x4*)xb + lane; const f32x4* gr = (const f32x4*)g + lane;
    f32x4 va[8], vb[8]; float sa = 0.f, sb = 0.f;
#pragma unroll
    for (int j = 0; j < 8; ++j) va[j] = __builtin_nontemporal_load(pa + 64 * j);
#pragma unroll
    for (int j = 0; j < 8; ++j) vb[j] = __builtin_nontemporal_load(pb + 64 * j);
#pragma unroll
    for (int j = 0; j < 8; ++j) { sa += (va[j].x * va[j].x + va[j].y * va[j].y) + (va[j].z * va[j].z + va[j].w * va[j].w); sb += (vb[j].x * vb[j].x + vb[j].y * vb[j].y) + (vb[j].z * vb[j].z + vb[j].w * vb[j].w); }
    const float ra = __builtin_amdgcn_rsqf(wave_sum(sa) * (1.f / DM) + EPS), rb = __builtin_amdgcn_rsqf(wave_sum(sb) * (1.f / DM) + EPS);
    v2u* o8a = (v2u*)oa + lane; v2u* o8b = (v2u*)ob + lane;
#pragma unroll
    for (int j = 0; j < 8; ++j) { const f32x4 gg = gr[64 * j];
        __builtin_nontemporal_store((v2u){pk2(va[j].x * ra * gg.x, va[j].y * ra * gg.y), pk2(va[j].z * ra * gg.z, va[j].w * ra * gg.w)}, o8a + 64 * j);
        __builtin_nontemporal_store((v2u){pk2(vb[j].x * rb * gg.x, vb[j].y * rb * gg.y), pk2(vb[j].z * rb * gg.z, vb[j].w * rb * gg.w)}, o8b + 64 * j); }
}

__device__ __forceinline__ void naive_attn_row(const float* qrow, const float* Kb, size_t kstride, const float* Vb, size_t vstride, const float* cb, float ct, int nk, float scale,
                                               int lane, float& o0, float& o1) {
    const f32x2 q = *(const f32x2*)(qrow + 2 * lane);
    float m = -1e30f, l = 0.f, a0 = 0.f, a1 = 0.f;
#pragma unroll 4
    for (int s = 0; s < nk; ++s) {
        const f32x2 kk = *(const f32x2*)(Kb + (size_t)s * kstride + 2 * lane);
        const f32x2 vv = *(const f32x2*)(Vb + (size_t)s * vstride + 2 * lane);
        float d = wave_sum(q.x * kk.x + q.y * kk.y) * scale;
        if (cb) d += ct - cb[s];
        const float mn = fmaxf(m, d), alpha = __expf(m - mn), p = __expf(d - mn);
        l = l * alpha + p; a0 = a0 * alpha + p * vv.x; a1 = a1 * alpha + p * vv.y; m = mn;
    }
    o0 = a0 / l; o1 = a1 / l;
}

__device__ __forceinline__ int win_row(int n) { return n < 6144 ? n : n < 6160 ? 16384 + (n - 6144) : n < 12304 ? n - 16 : n < 12320 ? 16400 + (n - 12304) : n - 32; }
__device__ __forceinline__ void transpose_win(Frame& F, const float* W, bf16* WT) {
    LAS float* scr = (LAS float*)(F.lds + F.wave * 16384);
    constexpr int K = DM, N = INC, total = (K / 64) * 2;
    for (int it = F.gw; it < total; it += F.ngw) {
        const int kb = it >> 1, k0 = 64 * kb, n0 = (it & 1) ? 12304 : 6144, lane = F.lane;
#pragma unroll 8
        for (int i = 0; i < 16; ++i) { const int kk = 4 * i + (lane >> 4); scr[kk * 17 + (lane & 15)] = W[(size_t)(k0 + kk) * N + n0 + (lane & 15)]; }
        LDS_WAIT(); asm volatile("" ::: "memory");
        const int c = lane & 7, r0 = win_row(n0);
#pragma unroll
        for (int j = 0; j < 2; ++j) { const int n = (lane >> 3) + 8 * j; const LAS float* sp = scr + (8 * c) * 17 + n;
            v4u o; o.x = pk2(sp[0 * 17], sp[1 * 17]); o.y = pk2(sp[2 * 17], sp[3 * 17]); o.z = pk2(sp[4 * 17], sp[5 * 17]); o.w = pk2(sp[6 * 17], sp[7 * 17]);
            *(v4u*)(WT + (size_t)(r0 + n) * K + k0 + 8 * c) = o; }
        LDS_WAIT(); asm volatile("" ::: "memory");
    }
}
__device__ __forceinline__ void transpose_win64(LAS unsigned char* lds, const float* W, bf16* WT, int gw, int ngw) {
    int t_ = threadIdx.x; asm volatile("" : "+v"(t_));
    const int wid = __builtin_amdgcn_readfirstlane(t_ >> 6), lane = t_ & 63;
    LAS unsigned char* tile = lds + wid * 19456;
    const unsigned tbase = (unsigned)(size_t)tile;
    const int lr = lane >> 4, lc = lane & 15, g = lane >> 4, q = (lane & 15) >> 2, p = lane & 3;
    const unsigned wr_off = (unsigned)(lr * 160 + lc * 8), tr_off = (unsigned)(q * 160 + (g * 16 + 4 * p) * 2);
    const unsigned ldo = (unsigned)(lr * INC * 4 + lc * 16), sto = (unsigned)((lane >> 3) * (DM * 2) + (lane & 7) * 16);
    constexpr int total = (DM / 64) * 256; constexpr unsigned rs = 4u * INC * 4u;
#define TW_SRC(it_, sp_, dp_) do { const int kb_ = (it_) >> 8, d0_ = 64 * ((it_) & 255), n0_ = d0_ + (d0_ < 6144 ? 0 : d0_ < 12288 ? 16 : 32); \
        sp_ = (const char*)W + ((size_t)(64 * kb_) * INC + n0_) * 4; dp_ = (char*)WT + ((size_t)d0_ * DM + 64 * kb_) * 2; } while (0)
#define TW_LOAD(R_, sp_) do { _Pragma("unroll") for (int i = 0; i < 16; ++i) R_[i] = __builtin_nontemporal_load((const f32x4*)(sp_ + (ldo + (unsigned)i * rs))); } while (0)
#define TW_PROC(R_, dp_) do { \
        _Pragma("unroll") for (int i = 0; i < 16; ++i) { const v2u w = {pk2(R_[i].x, R_[i].y), pk2(R_[i].z, R_[i].w)}; *(LAS v2u*)(tile + wr_off + i * 640) = w; } \
        asm volatile("s_waitcnt lgkmcnt(0)" ::: "memory"); \
        _Pragma("unroll") for (int hb_ = 0; hb_ < 2; ++hb_) { v2u ta_[4], tb_[4]; \
            _Pragma("unroll") for (int jj = 0; jj < 4; ++jj) { \
                asm volatile("ds_read_b64_tr_b16 %0, %1 offset:%2" : "=&v"(ta_[jj]) : "v"(tbase + tr_off), "i"((4 * hb_ + jj) * 1280) : "memory"); \
                asm volatile("ds_read_b64_tr_b16 %0, %1 offset:%2" : "=&v"(tb_[jj]) : "v"(tbase + tr_off), "i"((4 * hb_ + jj) * 1280 + 640) : "memory"); } \
            asm volatile("s_waitcnt lgkmcnt(0)" : "+v"(ta_[0]), "+v"(ta_[1]), "+v"(ta_[2]), "+v"(ta_[3]), "+v"(tb_[0]), "+v"(tb_[1]), "+v"(tb_[2]), "+v"(tb_[3]) :: "memory"); \
            _Pragma("unroll") for (int jj = 0; jj < 4; ++jj) *(LAS v4u*)(tile + 10240 + lane * 144 + (4 * hb_ + jj) * 16) = (v4u){ta_[jj].x, ta_[jj].y, tb_[jj].x, tb_[jj].y}; } \
        asm volatile("s_waitcnt lgkmcnt(0)" ::: "memory"); \
        _Pragma("unroll") for (int hf_ = 0; hf_ < 2; ++hf_) { v4u ow_[4]; \
            _Pragma("unroll") for (int s_ = 0; s_ < 4; ++s_) ow_[s_] = *(const LAS v4u*)(tile + 10240 + (8 * (4 * hf_ + s_) + (lane >> 3)) * 144 + (lane & 7) * 16); \
            _Pragma("unroll") for (int s_ = 0; s_ < 4; ++s_) __builtin_nontemporal_store(ow_[s_], (v4u*)(dp_ + (sto + (unsigned)(8 * (4 * hf_ + s_)) * (unsigned)(DM * 2)))); \
            asm volatile("" ::: "memory"); } \
        asm volatile("s_waitcnt lgkmcnt(0)" ::: "memory"); } while (0)
    f32x4 RA[16], RB[16]; const char* sA; const char* sB; char* dA; char* dB;
    int it = gw;
    if (it < total) { TW_SRC(it, sA, dA); TW_LOAD(RA, sA); }
    while (it < total) {
        const int i1 = it + ngw, i2 = it + 2 * ngw;
        if (i1 < total) { TW_SRC(i1, sB, dB); TW_LOAD(RB, sB); }
        TW_PROC(RA, dA);
        if (i1 >= total) break;
        if (i2 < total) { TW_SRC(i2, sA, dA); TW_LOAD(RA, sA); }
        TW_PROC(RB, dB);
        it = i2;
    }
#undef TW_SRC
#undef TW_LOAD
#undef TW_PROC
}
__device__ __forceinline__ void transpose64(LAS unsigned char* lds, const float* W, int K, int N, bf16* WT, int gw, int ngw) {
    int t_ = threadIdx.x; asm volatile("" : "+v"(t_));
    const int wid = __builtin_amdgcn_readfirstlane(t_ >> 6), lane = t_ & 63;
    LAS unsigned char* tile = lds + wid * 19456;
    const unsigned tbase = (unsigned)(size_t)tile;
    const int lr = lane >> 4, lc = lane & 15, g = lane >> 4, q = (lane & 15) >> 2, p = lane & 3;
    const unsigned wr_off = (unsigned)(lr * 160 + lc * 8), tr_off = (unsigned)(q * 160 + (g * 16 + 4 * p) * 2);
    const unsigned ldo = (unsigned)(lr * N * 4 + lc * 16), sto = (unsigned)((lane >> 3) * (K * 2) + (lane & 7) * 16), rs = 16u * (unsigned)N, ds8 = 8u * (unsigned)(K * 2);
    const int nbk = N >> 6, total = (K >> 6) * nbk;
#define TG_SRC(it_, sp_, dp_) do { const int kb_ = (it_) / nbk, nb_ = (it_) - kb_ * nbk; \
        sp_ = (const char*)W + ((size_t)(64 * kb_) * N + 64 * nb_) * 4; dp_ = (char*)WT + ((size_t)(64 * nb_) * K + 64 * kb_) * 2; } while (0)
#define TG_LOAD(R_, sp_) do { _Pragma("unroll") for (int i = 0; i < 16; ++i) R_[i] = __builtin_nontemporal_load((const f32x4*)(sp_ + (ldo + (unsigned)i * rs))); } while (0)
#define TG_PROC(R_, dp_) do { \
        _Pragma("unroll") for (int i = 0; i < 16; ++i) { const v2u w = {pk2(R_[i].x, R_[i].y), pk2(R_[i].z, R_[i].w)}; *(LAS v2u*)(tile + wr_off + i * 640) = w; } \
        asm volatile("s_waitcnt lgkmcnt(0)" ::: "memory"); \
        _Pragma("unroll") for (int hb_ = 0; hb_ < 2; ++hb_) { v2u ta_[4], tb_[4]; \
            _Pragma("unroll") for (int jj = 0; jj < 4; ++jj) { \
                asm volatile("ds_read_b64_tr_b16 %0, %1 offset:%2" : "=&v"(ta_[jj]) : "v"(tbase + tr_off), "i"((4 * hb_ + jj) * 1280) : "memory"); \
                asm volatile("ds_read_b64_tr_b16 %0, %1 offset:%2" : "=&v"(tb_[jj]) : "v"(tbase + tr_off), "i"((4 * hb_ + jj) * 1280 + 640) : "memory"); } \
            asm volatile("s_waitcnt lgkmcnt(0)" : "+v"(ta_[0]), "+v"(ta_[1]), "+v"(ta_[2]), "+v"(ta_[3]), "+v"(tb_[0]), "+v"(tb_[1]), "+v"(tb_[2]), "+v"(tb_[3]) :: "memory"); \
            _Pragma("unroll") for (int jj = 0; jj < 4; ++jj) *(LAS v4u*)(tile + 10240 + lane * 144 + (4 * hb_ + jj) * 16) = (v4u){ta_[jj].x, ta_[jj].y, tb_[jj].x, tb_[jj].y}; } \
        asm volatile("s_waitcnt lgkmcnt(0)" ::: "memory"); \
        _Pragma("unroll") for (int hf_ = 0; hf_ < 2; ++hf_) { v4u ow_[4]; \
            _Pragma("unroll") for (int s_ = 0; s_ < 4; ++s_) ow_[s_] = *(const LAS v4u*)(tile + 10240 + (8 * (4 * hf_ + s_) + (lane >> 3)) * 144 + (lane & 7) * 16); \
            _Pragma("unroll") for (int s_ = 0; s_ < 4; ++s_) *(v4u*)(dp_ + (sto + (unsigned)(4 * hf_ + s_) * ds8)) = ow_[s_]; \
            asm volatile("" ::: "memory"); } \
        asm volatile("s_waitcnt lgkmcnt(0)" ::: "memory"); } while (0)
    f32x4 RA[16], RB[16]; const char* sA; const char* sB; char* dA; char* dB;
    int it = gw;
    if (it < total) { TG_SRC(it, sA, dA); TG_LOAD(RA, sA); }
    while (it < total) {
        const int i1 = it + ngw, i2 = it + 2 * ngw;
        if (i1 < total) { TG_SRC(i1, sB, dB); TG_LOAD(RB, sB); }
        TG_PROC(RA, dA);
        if (i1 >= total) break;
        if (i2 < total) { TG_SRC(i2, sA, dA); TG_LOAD(RA, sA); }
        TG_PROC(RB, dB);
        it = i2;
    }
#undef TG_SRC
#undef TG_LOAD
#undef TG_PROC
}
struct EpiInProj {
    static constexpr bool PERM = true;
    bf16 *QT, *VG, *SG, *FQ, *GG; float* GAFF;
    __device__ __forceinline__ void operator()(const f32x4 (&acc)[2][2][4][2], const pg8::Unit& u, int wr, int wc, int fr, int fq) const {
        const int pn = u.pn, row0 = u.pm * 256 + wr * 64 + fr, b = row0 >> 12, s0 = row0 & (SEQ - 1), cl = wc * 32 + 8 * fq;
        if (pn == 64) {
            if (wc == 0) {
#pragma unroll
                for (int ai = 0; ai < 2; ++ai)
#pragma unroll
                    for (int m = 0; m < 4; ++m) { float* d = GAFF + (size_t)(row0 + ai * 128 + m * 16) * 32 + 8 * fq; *(f32x4*)d = acc[ai][0][m][0]; *(f32x4*)(d + 4) = acc[ai][0][m][1]; }
            }
            return;
        }
        bf16* base0; bf16* base1; int rs, act = 0;
        if (pn < 8)       { base0 = QT + (size_t)(pn >> 2) * ((size_t)T * 1024) + (size_t)(b * 4 + (pn & 3)) * SEQ * 256 + cl; base1 = base0 + 128; rs = 256; }
        else if (pn < 16) { const int t = pn - 8; base0 = VG + (size_t)(b * 4 + (t >> 1)) * SEQ * 512 + 256 * (t & 1) + cl; base1 = base0 + 128; rs = 512; }
        else if (pn < 24) { base0 = SG + (size_t)b * SEQ * DM + 256 * (pn - 16) + cl; base1 = base0 + 128; rs = DM; act = 1; }
        else if (pn < 48) { const int t = (pn - 24) & 7; base0 = FQ + (size_t)((pn - 24) >> 3) * ((size_t)T * DM) + (size_t)(b * 16 + 2 * t) * SEQ * 128 + cl; base1 = base0 + (size_t)SEQ * 128; rs = 128; }
        else              { base0 = GG + (size_t)((pn - 48) >> 3) * ((size_t)T * DM) + (size_t)b * SEQ * DM + 256 * ((pn - 48) & 7) + cl; base1 = base0 + 128; rs = DM; act = 2; }
#pragma unroll
        for (int ai = 0; ai < 2; ++ai)
#pragma unroll
            for (int m = 0; m < 4; ++m) { const size_t ro = (size_t)(s0 + ai * 128 + m * 16) * rs;
#pragma unroll
                for (int bj = 0; bj < 2; ++bj) { f32x4 v0 = acc[ai][bj][m][0], v1 = acc[ai][bj][m][1];
                    if (act == 1) {
#pragma unroll
                        for (int j = 0; j < 4; ++j) { v0[j] = v0[j] * sigmoid_f(v0[j]); v1[j] = v1[j] * sigmoid_f(v1[j]); } }
                    else if (act == 2) {
#pragma unroll
                        for (int j = 0; j < 4; ++j) { v0[j] = sigmoid_f(v0[j]); v1[j] = sigmoid_f(v1[j]); } }
                    v4u w; w.x = pg8::cvt_pk_bf16(v0[0], v0[1]); w.y = pg8::cvt_pk_bf16(v0[2], v0[3]); w.z = pg8::cvt_pk_bf16(v1[0], v1[1]); w.w = pg8::cvt_pk_bf16(v1[2], v1[3]);
                    *(v4u*)((bj ? base1 : base0) + ro) = w; } }
    }
};


template <int STAGE> struct EpiGate {
    static constexpr bool PERM = true;
    bf16* Y; const bf16* G; bf16* M;
    __device__ __forceinline__ void operator()(const f32x4 (&acc)[2][2][4][2], const pg8::Unit& u, int wr, int wc, int fr, int fq) const {
        const size_t o00 = (size_t)(u.pm * 256 + wr * 64 + fr) * DM + u.pn * 256 + wc * 32 + 8 * fq;
#pragma unroll
        for (int ai = 0; ai < 2; ++ai) {
            v4u gw[4][2], yw[4][2];
#pragma unroll
            for (int m = 0; m < 4; ++m)
#pragma unroll
                for (int bj = 0; bj < 2; ++bj) { const size_t o = o00 + (size_t)(ai * 128 + m * 16) * DM + 128 * bj; gw[m][bj] = *(const v4u*)(G + o); if (STAGE == 1) yw[m][bj] = *(const v4u*)(Y + o); }
#pragma unroll
            for (int m = 0; m < 4; ++m)
#pragma unroll
                for (int bj = 0; bj < 2; ++bj) { const size_t o = o00 + (size_t)(ai * 128 + m * 16) * DM + 128 * bj; const v4u g = gw[m][bj];
                    const f32x4 g0 = {bf2f(g.x & 0xffffu), bf2f(g.x >> 16), bf2f(g.y & 0xffffu), bf2f(g.y >> 16)}, g1 = {bf2f(g.z & 0xffffu), bf2f(g.z >> 16), bf2f(g.w & 0xffffu), bf2f(g.w >> 16)};
                    f32x4 v0 = acc[ai][bj][m][0] * g0, v1 = acc[ai][bj][m][1] * g1;
                    if (STAGE == 1) { const v4u y = yw[m][bj]; v0 += (f32x4){bf2f(y.x & 0xffffu), bf2f(y.x >> 16), bf2f(y.y & 0xffffu), bf2f(y.y >> 16)}; v1 += (f32x4){bf2f(y.z & 0xffffu), bf2f(y.z >> 16), bf2f(y.w & 0xffffu), bf2f(y.w >> 16)}; }
                    *(v4u*)((STAGE == 0 ? Y : M) + o) = (v4u){pg8::cvt_pk_bf16(v0[0], v0[1]), pg8::cvt_pk_bf16(v0[2], v0[3]), pg8::cvt_pk_bf16(v1[0], v1[1]), pg8::cvt_pk_bf16(v1[2], v1[3])}; }
        }
    }
};
template <bool XBF16, bool BBF16> struct EpiRes {
    static constexpr bool PERM = true;
    const float* base; float* X; const float* gain; bf16* H; float* RSS;
    __device__ __forceinline__ void operator()(const f32x4 (&acc)[2][2][4][2], const pg8::Unit& u, int wr, int wc, int fr, int fq) const {
        const int row0 = u.pm * 256 + wr * 64 + fr, col0 = u.pn * 256 + wc * 32 + 8 * fq;
        f32x4 gv[2][2];
#pragma unroll
        for (int bj = 0; bj < 2; ++bj) { gv[bj][0] = *(const f32x4*)(gain + col0 + 128 * bj); gv[bj][1] = *(const f32x4*)(gain + col0 + 128 * bj + 4); }
#pragma unroll
        for (int ai = 0; ai < 2; ++ai) {
            f32x4 b0[4][2], b1[4][2];
#pragma unroll
            for (int m = 0; m < 4; ++m)
#pragma unroll
                for (int bj = 0; bj < 2; ++bj) { const size_t o = (size_t)(row0 + ai * 128 + m * 16) * DM + col0 + 128 * bj;
                    if (BBF16) { const v4u w = *(const v4u*)((const bf16*)base + o); b0[m][bj] = (f32x4){bf2f(w.x & 0xffffu), bf2f(w.x >> 16), bf2f(w.y & 0xffffu), bf2f(w.y >> 16)}; b1[m][bj] = (f32x4){bf2f(w.z & 0xffffu), bf2f(w.z >> 16), bf2f(w.w & 0xffffu), bf2f(w.w >> 16)}; }
                    else { b0[m][bj] = *(const f32x4*)(base + o); b1[m][bj] = *(const f32x4*)(base + o + 4); } }
#pragma unroll
            for (int m = 0; m < 4; ++m) { const int row = row0 + ai * 128 + m * 16; float ss = 0.f;
#pragma unroll
                for (int bj = 0; bj < 2; ++bj) { const size_t o = (size_t)row * DM + col0 + 128 * bj;
                    const f32x4 v0 = acc[ai][bj][m][0] + b0[m][bj], v1 = acc[ai][bj][m][1] + b1[m][bj];
                    if (XBF16) *(v4u*)((bf16*)X + o) = (v4u){pg8::cvt_pk_bf16(v0[0], v0[1]), pg8::cvt_pk_bf16(v0[2], v0[3]), pg8::cvt_pk_bf16(v1[0], v1[1]), pg8::cvt_pk_bf16(v1[2], v1[3])};
                    else { *(f32x4*)(X + o) = v0; *(f32x4*)(X + o + 4) = v1; }
                    ss += (v0[0] * v0[0] + v0[1] * v0[1] + v0[2] * v0[2] + v0[3] * v0[3]) + (v1[0] * v1[0] + v1[1] * v1[1] + v1[2] * v1[2] + v1[3] * v1[3]);
                    const f32x4 h0 = v0 * gv[bj][0], h1 = v1 * gv[bj][1];
                    *(v4u*)(H + o) = (v4u){pg8::cvt_pk_bf16(h0[0], h0[1]), pg8::cvt_pk_bf16(h0[2], h0[3]), pg8::cvt_pk_bf16(h1[0], h1[1]), pg8::cvt_pk_bf16(h1[2], h1[3])}; }
                ss += __shfl_xor(ss, 16); ss += __shfl_xor(ss, 32);
                if (fq == 0) RSS[(size_t)row * 32 + u.pn * 4 + wc] = ss; }
        }
    }
};

constexpr int MT_BASE = CTLW + 1024, MT_NRT = MT_BASE, MT_CNT = MT_BASE + 16, MT_PBASE = MT_CNT + 32 * 4, MT_TE = MT_PBASE + 36 * 4, MT_TP = MT_TE + MAXRT * 4, MT_END = MT_TP + MAXRT * 4;
static_assert(MT_END <= LDS_BYTES && gla::LDS_BYTES <= CTLW && fa::LDS_BYTES <= CTLW, "LDS map");
__device__ __forceinline__ void moe_tables(LAS unsigned char* lds, unsigned* ctl) {
    LAS int* nrt = (LAS int*)(lds + MT_NRT); LAS int* cnt = (LAS int*)(lds + MT_CNT); LAS int* pbase = (LAS int*)(lds + MT_PBASE); LAS int* te = (LAS int*)(lds + MT_TE); LAS int* tp = (LAS int*)(lds + MT_TP);
    __syncthreads();
    if (threadIdx.x < 64) {
        const int lane = threadIdx.x;
        const int c = lane < NE ? (int)xb_ld(ctl + CW_CNT + lane) : 0;
        const int nt = (c + 255) >> 8;
        int pre = nt;
#pragma unroll
        for (int o = 1; o < 32; o <<= 1) { const int y = __shfl_up(pre, o); if (lane >= o) pre += y; }
        const int first = pre - nt;
        if (lane < NE) { cnt[lane] = c; pbase[lane] = first * 256; for (int k = 0; k < nt; ++k) { te[first + k] = lane; tp[first + k] = k * 256; } }
        if (lane == NE - 1) { pbase[NE] = pre * 256; nrt[0] = pre; } }
    __syncthreads();
}
constexpr int SIDE_OFF = RING_BYTES, SIDE_STRIDE = 3072;
static_assert(SIDE_OFF + 3 * SIDE_STRIDE <= CTLW, "side tables");
template <bool UP> struct MoeOrder {
    static constexpr bool SIDE = true;
    LAS unsigned char* lds; const int* tokl; const float* rowscale; const float* bias; int nN, G, c;
    __device__ __forceinline__ bool next(int i, pg8::Unit& u) const {
        const int nrt = *(const LAS int*)(lds + MT_NRT); int rt, pn;
        if (G == 256) { const int x = c & 7, j = c >> 3, s = i * 8 + x, parts = nN >> 2, rg = s / parts, ph = s - rg * parts;
            rt = 8 * rg + (j >> 2); pn = 4 * ph + (j & 3); if (rt >= nrt) return false; }
        else { const long L = (long)i * G + c; if (L >= (long)nrt * nN) return false; rt = (int)(L / nN); pn = (int)(L % nN); }
        u.pm = rt; u.pn = pn; u.pb = ((const LAS int*)(lds + MT_TE))[rt] * nN + pn; u.kofs = 0; return true;
    }
    __device__ __forceinline__ void prefetch(const pg8::Unit& u, int sb, int wid, int lane) const {
        if (wid != 0) return;
        const int e = ((const LAS int*)(lds + MT_TE))[u.pm], p0 = ((const LAS int*)(lds + MT_TP))[u.pm];
        LAS unsigned char* dst = lds + SIDE_OFF + sb * SIDE_STRIDE;
        if (UP) __builtin_amdgcn_global_load_lds((const unsigned*)(tokl + (size_t)e * T + p0 + 4 * lane), (LAS unsigned*)dst, 16, 0, 0);
        __builtin_amdgcn_global_load_lds((const unsigned*)(rowscale + (size_t)e * T + p0 + 4 * lane), (LAS unsigned*)(dst + 1024), 16, 0, 0);
        const float* bsrc = UP ? bias + (size_t)e * 4096 + 128 * u.pn + (lane < 32 ? 4 * lane : 2048 + 4 * (lane - 32)) : bias + (size_t)e * DM + 256 * u.pn + 4 * lane;
        __builtin_amdgcn_global_load_lds((const unsigned*)bsrc, (LAS unsigned*)(dst + 2048), 16, 0, 0);
    }
    __device__ __forceinline__ const LAS int* tok_table(int sb) const { return (const LAS int*)(lds + SIDE_OFF + sb * SIDE_STRIDE); }
    __device__ __forceinline__ void a_ready(const pg8::Unit&) const {}
    __device__ __forceinline__ void done(const pg8::Unit&) const {}
};
struct EpiSwiglu {
    static constexpr bool PERM = true;
    bf16* act; LAS unsigned char* lds;
    __device__ __forceinline__ void operator()(const f32x4 (&acc)[2][2][4][2], const pg8::Unit& u, int wr, int wc, int fr, int fq) const {
        const int col = 128 * u.pn + wc * 32 + 8 * fq;
        const LAS unsigned char* side = lds + SIDE_OFF + u.sb * SIDE_STRIDE;
        const LAS float* rrow = (const LAS float*)(side + 1024) + wr * 64 + fr;
        const LAS float* bg = (const LAS float*)(side + 2048) + wc * 32 + 8 * fq;
        const f32x4 bg0 = *(const LAS f32x4*)bg, bg1 = *(const LAS f32x4*)(bg + 4), bl0 = *(const LAS f32x4*)(bg + 128), bl1 = *(const LAS f32x4*)(bg + 132);
        bf16* dst = act + (size_t)(u.pm * 256 + wr * 64 + fr) * DM + col;
#pragma unroll
        for (int ai = 0; ai < 2; ++ai)
#pragma unroll
            for (int m = 0; m < 4; ++m) {
                const float rs = rrow[ai * 128 + m * 16];
                const f32x4 g0 = acc[ai][0][m][0] * rs + bg0, g1 = acc[ai][0][m][1] * rs + bg1, l0 = acc[ai][1][m][0] * rs + bl0, l1 = acc[ai][1][m][1] * rs + bl1;
                float o[8];
#pragma unroll
                for (int j = 0; j < 4; ++j) { const float ga = fminf(g0[j], 7.f), gb = fminf(g1[j], 7.f), la_ = fminf(fmaxf(l0[j], -7.f), 7.f), lb = fminf(fmaxf(l1[j], -7.f), 7.f);
                    o[j] = ga * sigmoid_f(1.702f * ga) * (la_ + 1.f); o[4 + j] = gb * sigmoid_f(1.702f * gb) * (lb + 1.f); }
                *(v4u*)(dst + (size_t)(ai * 128 + m * 16) * DM) = (v4u){pg8::cvt_pk_bf16(o[0], o[1]), pg8::cvt_pk_bf16(o[2], o[3]), pg8::cvt_pk_bf16(o[4], o[5]), pg8::cvt_pk_bf16(o[6], o[7])};
            }
    }
};
struct EpiDown {
    static constexpr bool PERM = true;
    bf16* yb; LAS unsigned char* lds;
    __device__ __forceinline__ void operator()(const f32x4 (&acc)[2][2][4][2], const pg8::Unit& u, int wr, int wc, int fr, int fq) const {
        const int col = 256 * u.pn + wc * 32 + 8 * fq;
        const LAS unsigned char* side = lds + SIDE_OFF + u.sb * SIDE_STRIDE;
        const LAS float* wrow = (const LAS float*)(side + 1024) + wr * 64 + fr;
        const LAS float* bb = (const LAS float*)(side + 2048) + wc * 32 + 8 * fq; f32x4 bv[2][2];
#pragma unroll
        for (int bj = 0; bj < 2; ++bj) { bv[bj][0] = *(const LAS f32x4*)(bb + 128 * bj); bv[bj][1] = *(const LAS f32x4*)(bb + 128 * bj + 4); }
        bf16* dst = yb + (size_t)(u.pm * 256 + wr * 64 + fr) * DM + col;
#pragma unroll
        for (int ai = 0; ai < 2; ++ai)
#pragma unroll
            for (int m = 0; m < 4; ++m) { const float gt = wrow[ai * 128 + m * 16];
#pragma unroll
                for (int bj = 0; bj < 2; ++bj) { const f32x4 v0 = (acc[ai][bj][m][0] + bv[bj][0]) * gt, v1 = (acc[ai][bj][m][1] + bv[bj][1]) * gt;
                    *(v4u*)(dst + (size_t)(ai * 128 + m * 16) * DM + 128 * bj) = (v4u){pg8::cvt_pk_bf16(v0[0], v0[1]), pg8::cvt_pk_bf16(v0[2], v0[3]), pg8::cvt_pk_bf16(v1[0], v1[1]), pg8::cvt_pk_bf16(v1[2], v1[3])}; } }
    }
};
__device__ __forceinline__ void transpose_job_up(Frame& F, const float* W, bf16* WT) {
    LAS float* scr = (LAS float*)(F.lds + F.wave * 16384);
    constexpr int K = DM, N = 4096, per = (K / 64) * (N / 32); const long total = (long)per * NE;
    for (long it = F.gw; it < total; it += F.ngw) { const int e = (int)(it / per), item = (int)(it % per), lane = F.lane;
        const float* Wp = W + (size_t)e * K * N; bf16* WTp = WT + (size_t)e * N * K;
        const int nblk = N / 32, kb = item / nblk, nb = item % nblk, k0 = 64 * kb, n0 = 32 * nb;
        const int m0 = n0 & 2047, r0 = 256 * (m0 >> 7) + (n0 >= 2048 ? 128 : 0) + (m0 & 127);
#pragma unroll 8
        for (int i = 0; i < 32; ++i) { const int kk = 2 * i + (lane >> 5); scr[kk * 33 + (lane & 31)] = Wp[(size_t)(k0 + kk) * N + n0 + (lane & 31)]; }
        LDS_WAIT(); asm volatile("" ::: "memory");
        const int c = lane & 7;
#pragma unroll
        for (int j = 0; j < 4; ++j) { const int n = (lane >> 3) + 8 * j; const LAS float* sp = scr + (8 * c) * 33 + n;
            v4u o; o.x = pk2(sp[0 * 33], sp[1 * 33]); o.y = pk2(sp[2 * 33], sp[3 * 33]); o.z = pk2(sp[4 * 33], sp[5 * 33]); o.w = pk2(sp[6 * 33], sp[7 * 33]);
            *(v4u*)(WTp + (size_t)(r0 + n) * K + k0 + 8 * c) = o; }
        LDS_WAIT(); asm volatile("" ::: "memory");
    }
}


__device__ __forceinline__ void convert_expert_share(LAS unsigned char* lds, const float* Wup, const float* Wdn, bf16* WtUp, bf16* WtDn, int sh) {
    int t_ = threadIdx.x; asm volatile("" : "+v"(t_));
    const int wid = __builtin_amdgcn_readfirstlane(t_ >> 6), lane = t_ & 63;
    const int e = sh >> 3, part = sh & 7;
    LAS unsigned char* tile = lds + wid * 19456;
    const unsigned tbase = (unsigned)(size_t)tile;
    const int lr = lane >> 4, lc = lane & 15;
    const int g = lane >> 4, q = (lane & 15) >> 2, p = lane & 3;
    const unsigned wr_off = (unsigned)(lr * 160 + lc * 8), tr_off = (unsigned)(q * 160 + (g * 16 + 4 * p) * 2);
#define CES_SRC(it_, src_, N_, n0_, k0_, dst_, up_) do { const int it__ = (it_); \
        if (it__ < 32) { const int id = it__ * 8 + wid, kb = id >> 3, nb = id & 7; N_ = 4096; n0_ = part * 512 + nb * 64; k0_ = kb * 64; src_ = Wup + (size_t)e * DM * 4096; dst_ = WtUp + (size_t)e * 4096 * DM; up_ = true; } \
        else { const int id = (it__ - 32) * 8 + wid, kb = id >> 2, nb = id & 3; N_ = DM; n0_ = part * 256 + nb * 64; k0_ = kb * 64; src_ = Wdn + (size_t)e * DM * DM; dst_ = WtDn + (size_t)e * DM * DM; up_ = false; } } while (0)
#define CES_LOAD(R_, src_, N_, n0_, k0_) do { _Pragma("unroll") for (int i = 0; i < 16; ++i) R_[i] = __builtin_nontemporal_load((const f32x4*)(src_ + (size_t)(k0_ + 4 * i + lr) * N_ + n0_ + 4 * lc)); } while (0)
#define CES_PROC(R_, dst_, UP_, n0_, k0_) do { \
        _Pragma("unroll") for (int i = 0; i < 16; ++i) { const v2u w = {pk2(R_[i].x, R_[i].y), pk2(R_[i].z, R_[i].w)}; *(LAS v2u*)(tile + wr_off + i * 640) = w; } \
        asm volatile("s_waitcnt lgkmcnt(0)" ::: "memory"); \
          \
        _Pragma("unroll") for (int hb_ = 0; hb_ < 2; ++hb_) { v2u ta_[4], tb_[4]; \
            _Pragma("unroll") for (int jj = 0; jj < 4; ++jj) { \
                asm volatile("ds_read_b64_tr_b16 %0, %1 offset:%2" : "=&v"(ta_[jj]) : "v"(tbase + tr_off), "i"((4 * hb_ + jj) * 1280) : "memory"); \
                asm volatile("ds_read_b64_tr_b16 %0, %1 offset:%2" : "=&v"(tb_[jj]) : "v"(tbase + tr_off), "i"((4 * hb_ + jj) * 1280 + 640) : "memory"); } \
            asm volatile("s_waitcnt lgkmcnt(0)" : "+v"(ta_[0]), "+v"(ta_[1]), "+v"(ta_[2]), "+v"(ta_[3]), "+v"(tb_[0]), "+v"(tb_[1]), "+v"(tb_[2]), "+v"(tb_[3]) :: "memory"); \
            _Pragma("unroll") for (int jj = 0; jj < 4; ++jj) *(LAS v4u*)(tile + 10240 + lane * 144 + (4 * hb_ + jj) * 16) = (v4u){ta_[jj].x, ta_[jj].y, tb_[jj].x, tb_[jj].y}; } \
        asm volatile("s_waitcnt lgkmcnt(0)" ::: "memory"); \
          \
        _Pragma("unroll") for (int hf_ = 0; hf_ < 2; ++hf_) { v4u ow_[4]; \
            _Pragma("unroll") for (int s_ = 0; s_ < 4; ++s_) ow_[s_] = *(const LAS v4u*)(tile + 10240 + (8 * (4 * hf_ + s_) + (lane >> 3)) * 144 + (lane & 7) * 16); \
            _Pragma("unroll") for (int s_ = 0; s_ < 4; ++s_) { const int n = n0_ + 8 * (4 * hf_ + s_) + (lane >> 3); \
                const int m0 = n & 2047, drow = UP_ ? 256 * (m0 >> 7) + (n >= 2048 ? 128 : 0) + (m0 & 127) : n; \
                __builtin_nontemporal_store(ow_[s_], (v4u*)(dst_ + (size_t)drow * DM + k0_ + 8 * (lane & 7))); } \
            asm volatile("" ::: "memory"); } \
        asm volatile("s_waitcnt lgkmcnt(0)" ::: "memory"); } while (0)
    f32x4 RA[16], RB[16], RC[16];
    const float* sA; const float* sB; const float* sC; bf16* dA; bf16* dB; bf16* dC; int NA, NB_, NC, n0A, n0B, n0C, k0A, k0B, k0C; bool uA, uB, uC;
    CES_SRC(0, sA, NA, n0A, k0A, dA, uA); CES_LOAD(RA, sA, NA, n0A, k0A);
    CES_SRC(1, sB, NB_, n0B, k0B, dB, uB); CES_LOAD(RB, sB, NB_, n0B, k0B);
    for (int it = 0; it < 48; it += 3) {
        CES_SRC(it + 2, sC, NC, n0C, k0C, dC, uC); CES_LOAD(RC, sC, NC, n0C, k0C);
        CES_PROC(RA, dA, uA, n0A, k0A);
        if (it + 3 < 48) { CES_SRC(it + 3, sA, NA, n0A, k0A, dA, uA); CES_LOAD(RA, sA, NA, n0A, k0A); }
        CES_PROC(RB, dB, uB, n0B, k0B);
        if (it + 4 < 48) { CES_SRC(it + 4, sB, NB_, n0B, k0B, dB, uB); CES_LOAD(RB, sB, NB_, n0B, k0B); }
        CES_PROC(RC, dC, uC, n0C, k0C);
    }
#undef CES_SRC
#undef CES_LOAD
#undef CES_PROC
}

__global__ void __launch_bounds__(NWAVES * 64, 2) mk_fwd(Args args) {
    extern __shared__ __attribute__((aligned(16))) unsigned char lds_raw[];
    Frame F;
    F.lds = (LAS unsigned char*)lds_raw;
    F.tid = threadIdx.x; F.lane = F.tid & 63; F.wave = __builtin_amdgcn_readfirstlane(F.tid >> 6);
    F.G = gridDim.x; F.bid = blockIdx.x; F.gw = F.bid * NWAVES + F.wave; F.ngw = F.G * NWAVES;
    unsigned char* ws = args.ws;
    unsigned* ctl = (unsigned*)(ws + WS_CTL);
    for (int u = F.tid; u < (LDS_BYTES - CTLW) / 4; u += NWAVES * 64) ((LAS unsigned*)(F.lds + CTLW))[u] = 0u;
    __syncthreads();
    XcdBarrier bar = xcd_barrier_post(ctl + CW_BAR, (volatile LAS unsigned*)(F.lds + CTLW + 64));
#define GRID_BAR(k) do { if (IN(k) && IN((k) + 1)) xcd_barrier(bar); } while (0)
    const float* x = args.in[0]; const float* mem = args.in[1];
    bf16* WtIn = (bf16*)(ws + WS_WTIN); bf16* WtBg = (bf16*)(ws + WS_WTBG); bf16* WtBf = (bf16*)(ws + WS_WTBF); bf16* WtOut = (bf16*)(ws + WS_WTOUT);
    bf16* WtMq = (bf16*)(ws + WS_WTMQ); bf16* WtMkv = (bf16*)(ws + WS_WTMKV); bf16* WtMo = (bf16*)(ws + WS_WTMO); bf16* WtUp = (bf16*)(ws + WS_WTUP); bf16* WtDn = (bf16*)(ws + WS_WTDN);
    bf16* WrT = (bf16*)(ws + WS_WRT); bf16* yb = (bf16*)(ws + WS_YB); int* tokl = (int*)(ws + WS_TOKL); float* wl = (float*)(ws + WS_WL); float* rsl = (float*)(ws + WS_RSL); float* RSS1 = (float*)(ws + WS_RSS1); float* RSS2 = (float*)(ws + WS_RSS2); float* logits = (float*)(ws + WS_LOG);
    bf16* QT = (bf16*)(ws + WS_QT); bf16* KT = (bf16*)(ws + WS_KT); bf16* VG = (bf16*)(ws + WS_VG); float* EBL = (float*)(ws + WS_EBL); bf16* AT = (bf16*)(ws + WS_AT);
    bf16* SG = (bf16*)(ws + WS_SG); bf16* GG = (bf16*)(ws + WS_GG); bf16* GF = (bf16*)(ws + WS_GF); float* GAFF = (float*)(ws + WS_GAFF);
    float* ogla = (float*)(ws + WS_OGLA); float* Y1 = (float*)(ws + WS_Y1); float* Y2 = (float*)(ws + WS_Y2); float* X1 = (float*)(ws + WS_X1); float* X2 = (float*)(ws + WS_X2);
    bf16* hb = (bf16*)(ws + WS_H); bf16* attb = (bf16*)(ws + WS_ATT); bf16* onb = (bf16*)(ws + WS_ON); bf16* mrg = (bf16*)(ws + WS_MRG); bf16* h2 = (bf16*)(ws + WS_H2); bf16* xs = (bf16*)(ws + WS_XS);
    bf16* om = (bf16*)(ws + WS_OM); bf16* mn = (bf16*)(ws + WS_MN); float* qm = (float*)(ws + WS_QM); float* kv = (float*)(ws + WS_KV);
    bf16* act = (bf16*)(ws + WS_ACT);
    int* asg_e = (int*)(ws + WS_ASG); int* asg_pos = asg_e + NASG;
    bf16* fqh = (bf16*)(ws + WS_FQH); bf16* fkh = (bf16*)(ws + WS_FKH); bf16* fvh = (bf16*)(ws + WS_FVH); float* cbias = (float*)(ws + WS_CB);
    bf16* qmb = (bf16*)(ws + WS_QMB); bf16* knb = (bf16*)(ws + WS_KNB); bf16* vb = (bf16*)(ws + WS_VB);
    const int lo = args.ph_lo, hi = args.ph_hi;
#define IN(k) (lo <= (k) && (k) < hi)
#define REFRESH() do { int t_ = threadIdx.x; asm volatile("" : "+v"(t_)); F.tid = t_; F.lane = t_ & 63; F.wave = __builtin_amdgcn_readfirstlane(t_ >> 6); F.gw = F.bid * NWAVES + F.wave; } while (0)

    if (IN(0)) { REFRESH();
        transpose_win64(F.lds, args.in[3], WtIn, F.gw, F.ngw);
        __syncthreads();
        transpose_win(F, args.in[3], WtIn);
        { v4u* z = (v4u*)(WtIn + (size_t)(64 * 256 + 32) * DM); const int nz = (INCP - INC) * DM / 8; for (int i = F.bid * 512 + F.tid; i < nz; i += F.G * 512) z[i] = (v4u){0u, 0u, 0u, 0u}; }
        for (int m = F.gw; m < T; m += 2 * F.ngw) {
            const int m2 = m + F.ngw;
            if (m2 < T) rms_rows2_bf16(x + (size_t)m * DM, x + (size_t)m2 * DM, args.in[2], hb + (size_t)m * DM, hb + (size_t)m2 * DM, F.lane);
            else rms_row_bf16(x + (size_t)m * DM, args.in[2], hb + (size_t)m * DM, F.lane); }
    }
    GRID_BAR(0);
    if (IN(1)) { REFRESH();
        pg8::Gemm g{hb, WtIn, T, 16384, DM}; pg8::StaticOrder S; S.init(T, 16384, F.G, F.bid);
        EpiInProj E{QT, VG, SG, fqh, GG, GAFF};
        { const int r0 = F.bid & 15; pg8::StaticOrder Sa = S; Sa.iend = r0;
          pg8::gemm_phase<EpiInProj, pg8::StaticOrder>(F.lds, g, Sa, E);
          __syncthreads();
          for (int sh = F.bid; sh < 256; sh += F.G) convert_expert_share(F.lds, args.in[23], args.in[25], WtUp, WtDn, sh);
          __syncthreads();
          transpose64(F.lds, args.in[10], DM, DM, WtBg, F.gw, F.ngw);
          transpose64(F.lds, args.in[11], DM, DM, WtBf, F.gw, F.ngw);
          transpose64(F.lds, args.in[12], DM, DM, WtOut, F.gw, F.ngw);
          transpose64(F.lds, args.in[15], DM, 512, WtMq, F.gw, F.ngw);
          transpose64(F.lds, args.in[16], DM, 1024, WtMkv, F.gw, F.ngw);
          transpose64(F.lds, args.in[19], 512, DM, WtMo, F.gw, F.ngw);
          __syncthreads();
          transpose_job(F, args.in[21], DM, NE, 1, WrT);
          { v4u* z = (v4u*)tokl; const int nz = NE * T / 4; for (int i = F.bid * 512 + F.tid; i < nz; i += F.G * 512) z[i] = (v4u){0u, 0u, 0u, 0u}; }
          { v4u* z = (v4u*)(WrT + (size_t)NE * DM); const int nz = (256 - NE) * DM / 8; for (int i = F.bid * 512 + F.tid; i < nz; i += F.G * 512) z[i] = (v4u){0u, 0u, 0u, 0u}; }
          for (int m = F.gw; m < NB * MEML; m += F.ngw) rms_row_bf16(mem + (size_t)m * DM, args.in[14], mn + (size_t)m * DM, F.lane);
          __syncthreads();
          S.i0 = r0; }
        static_assert(WS_KT == WS_QT + (size_t)T * 1024 * 2 && WS_FKH == WS_FQH + (size_t)T * DM * 2 && WS_FVH == WS_FKH + (size_t)T * DM * 2 && WS_GF == WS_GG + (size_t)T * DM * 2, "epilogue pointer arithmetic");
        pg8::gemm_phase<EpiInProj, pg8::StaticOrder>(F.lds, g, S, E);
        { pg8::Gemm g2{hb, WtIn + (size_t)16384 * DM, T, 256, 512, DM}; pg8::SplitOrder S2{64, 1, 4, 512, F.G, F.bid}; pg8::EpiN32 E2{GAFF, 128};
          pg8::gemm_phase<pg8::EpiN32, pg8::SplitOrder>(F.lds, g2, S2, E2); }
    }
    GRID_BAR(1);
    if (IN(2)) { REFRESH();
        const float* aup = args.in[4]; const float* abias = args.in[5];
        LAS float* gaL = (LAS float*)F.lds;
        LAS float* bL = (LAS float*)(F.lds + 4096);
        for (int job = F.bid; job < 16 * 64; job += F.G) {
            const int bh = job >> 6, c = job & 63, b = bh >> 2, h = bh & 3; const size_t tok0 = (size_t)b * SEQ + c * 64;
            __syncthreads();
            if (F.tid < 256) { const float* gp_ = GAFF + (tok0 + (F.tid >> 2)) * 128 + 4 * (F.tid & 3); *(LAS f32x4*)(gaL + (F.tid >> 2) * 16 + 4 * (F.tid & 3)) = (*(const f32x4*)gp_ + *(const f32x4*)(gp_ + 32)) + (*(const f32x4*)(gp_ + 64) + *(const f32x4*)(gp_ + 96)); }
            __syncthreads();
            const int k = F.tid & 255, half = F.tid >> 8;
            { float au[16];
#pragma unroll
              for (int r = 0; r < 16; ++r) au[r] = aup[r * 1024 + h * 256 + k];
              const float ab = abias[h * 256 + k]; float run = 0.f;
#pragma unroll 4
              for (int tt = 0; tt < 32; ++tt) { const int t = 32 * half + tt; float a = ab;
#pragma unroll
                for (int r4 = 0; r4 < 4; ++r4) { const f32x4 g4 = *(const LAS f32x4*)(gaL + t * 16 + 4 * r4); a += g4.x * au[4 * r4] + g4.y * au[4 * r4 + 1] + g4.z * au[4 * r4 + 2] + g4.w * au[4 * r4 + 3]; }
                run += log_sigmoid_f(a) * (1.0f / 16.0f); bL[t * 256 + k] = run; } }
            __syncthreads();
            { const float add = half ? bL[31 * 256 + k] : 0.f;
              __syncthreads();
              if (half) {
#pragma unroll 8
                for (int tt = 0; tt < 32; ++tt) bL[(32 + tt) * 256 + k] += add; } }
            __syncthreads();
            if (F.tid < 256) EBL[((size_t)bh * 64 + c) * 256 + F.tid] = __expf(bL[63 * 256 + F.tid]);
            { bf16* qb = QT + ((size_t)bh * SEQ + c * 64) * 256; bf16* kb = KT + ((size_t)bh * SEQ + c * 64) * 256;
              v4u qv[4], kv_[4];
#pragma unroll
              for (int i = 0; i < 4; ++i) { const int it = F.tid + 512 * i, t = it >> 5, cg = it & 31; qv[i] = *(const v4u*)(qb + t * 256 + 8 * cg); kv_[i] = *(const v4u*)(kb + t * 256 + 8 * cg); }
#pragma unroll
              for (int i = 0; i < 4; ++i) { const int it = F.tid + 512 * i, t = it >> 5, cg = it & 31;
                const f32x4 b0 = *(const LAS f32x4*)(bL + t * 256 + 8 * cg), b1 = *(const LAS f32x4*)(bL + t * 256 + 8 * cg + 4);
                const float eb[8] = {__expf(b0.x), __expf(b0.y), __expf(b0.z), __expf(b0.w), __expf(b1.x), __expf(b1.y), __expf(b1.z), __expf(b1.w)};
                const unsigned qw[4] = {qv[i].x, qv[i].y, qv[i].z, qv[i].w}, kw[4] = {kv_[i].x, kv_[i].y, kv_[i].z, kv_[i].w}; unsigned qo[4], ko[4];
#pragma unroll
                for (int j = 0; j < 4; ++j) { const float e0 = eb[2 * j], e1 = eb[2 * j + 1];
                    qo[j] = pk2(bf2f(qw[j] & 0xffffu) * e0 * (1.0f / 16.0f), bf2f(qw[j] >> 16) * e1 * (1.0f / 16.0f));
                    ko[j] = pk2(bf2f(kw[j] & 0xffffu) * __builtin_amdgcn_rcpf(e0), bf2f(kw[j] >> 16) * __builtin_amdgcn_rcpf(e1)); }
                *(v4u*)(qb + t * 256 + 8 * cg) = (v4u){qo[0], qo[1], qo[2], qo[3]}; *(v4u*)(kb + t * 256 + 8 * cg) = (v4u){ko[0], ko[1], ko[2], ko[3]}; } }
        }
        VM_WAIT(); __syncthreads();
        { int nj = 0; for (int job = F.bid; job < 16 * 64; job += F.G) ++nj;
          for (int a = F.wave; a < 3 * nj; a += NWAVES) { const int job = F.bid + (a / 3) * F.G; gla::apass_job(QT, KT, AT, job * 3 + (a % 3), F.lane); } }
        for (int job = F.bid - (F.G - 64); job >= 0 && job < NB * 16; job += F.G) {
            const int b = job >> 4, h = job & 15; const float fb = args.in[7][h];
            LAS double* wsum = (LAS double*)(F.lds + 4096 + 65536);
            float xv[8];
#pragma unroll
            for (int j = 0; j < 8; ++j) { const float* gp_ = GAFF + (size_t)(b * SEQ + 8 * F.tid + j) * 128 + 16 + h; xv[j] = log_sigmoid_f((gp_[0] + gp_[32]) + (gp_[64] + gp_[96]) + fb); }
            double loc = 0.0;
#pragma unroll
            for (int j = 0; j < 8; ++j) loc += (double)xv[j];
            double pre = loc;
#pragma unroll
            for (int o = 1; o < 64; o <<= 1) { const double y = __shfl_up(pre, o); if (F.lane >= o) pre += y; }
            __syncthreads();
            if (F.lane == 63) wsum[F.wave] = pre;
            __syncthreads();
            double run = pre - loc;
            for (int w = 0; w < F.wave; ++w) run += wsum[w];
#pragma unroll
            for (int j = 0; j < 8; ++j) { run += (double)xv[j]; cbias[(size_t)(b * 16 + h) * SEQ + 8 * F.tid + j] = (float)(-run * (double)(1.0f / fa::SCALE)); }
        }
        { int tl_ = threadIdx.x; asm volatile("" : "+v"(tl_));
          const int l16 = tl_ & 15, rsub = (tl_ & 63) >> 4;
          const f32x4 gq0 = *(const f32x4*)(args.in[8] + 8 * l16), gq1 = *(const f32x4*)(args.in[8] + 8 * l16 + 4), gk0 = *(const f32x4*)(args.in[9] + 8 * l16), gk1 = *(const f32x4*)(args.in[9] + 8 * l16 + 4);
#define QKN_LOAD(W_, r0_) do { _Pragma("unroll") for (int i = 0; i < 4; ++i) W_[i] = *(const v4u*)(fqh + (size_t)((r0_) + 4 * i + rsub) * 128 + 8 * l16); } while (0)
#define QKN_PROC(W_, r0_) do { const bool isk_ = (r0_) >= T * 16; const f32x4 g0 = isk_ ? gk0 : gq0, g1 = isk_ ? gk1 : gq1; \
            _Pragma("unroll") for (int i = 0; i < 4; ++i) { \
                float v[8] = {bf2f(W_[i].x & 0xffffu), bf2f(W_[i].x >> 16), bf2f(W_[i].y & 0xffffu), bf2f(W_[i].y >> 16), bf2f(W_[i].z & 0xffffu), bf2f(W_[i].z >> 16), bf2f(W_[i].w & 0xffffu), bf2f(W_[i].w >> 16)}; \
                float ss = 0.f; \
                _Pragma("unroll") for (int j = 0; j < 8; ++j) ss += v[j] * v[j]; \
                ss += __shfl_xor(ss, 1); ss += __shfl_xor(ss, 2); ss += __shfl_xor(ss, 4); ss += __shfl_xor(ss, 8); \
                const float r = 1.0f / sqrtf(ss * (1.f / 128.f) + EPS); \
                *(v4u*)(fqh + (size_t)((r0_) + 4 * i + rsub) * 128 + 8 * l16) = (v4u){pk2(v[0] * r * g0.x, v[1] * r * g0.y), pk2(v[2] * r * g0.z, v[3] * r * g0.w), pk2(v[4] * r * g1.x, v[5] * r * g1.y), pk2(v[6] * r * g1.z, v[7] * r * g1.w)}; } } while (0)
          const int step = F.ngw * 16, end = T * 32;
          v4u wa[4], wb[4];
          int r0 = F.gw * 16;
          if (r0 < end) { QKN_LOAD(wa, r0);
            for (;;) {
              const int r1 = r0 + step, r2 = r1 + step;
              if (r1 < end) QKN_LOAD(wb, r1);
              QKN_PROC(wa, r0);
              if (r1 >= end) break;
              if (r2 < end) QKN_LOAD(wa, r2);
              QKN_PROC(wb, r1);
              if (r2 >= end) break;
              r0 = r2;
            } }
#undef QKN_LOAD
#undef QKN_PROC
        }
    }
    GRID_BAR(2);
    if (IN(3)) { REFRESH();
        for (int item = F.bid; item < 64; item += F.G) {
            const int bh = item >> 2, grp = item & 3, b = bh >> 2, h = bh & 3;
            gla::ScanRef R{QT + (size_t)bh * SEQ * 256, KT + (size_t)bh * SEQ * 256, VG + (size_t)bh * SEQ * 512 + 128 * grp, AT + (size_t)bh * 64 * 64 * 64, EBL + (size_t)bh * 64 * 256,
                           ogla + (size_t)b * SEQ * DM + h * 512 + 128 * grp};
            gla::scan_item(R, F.lds);
            VM_WAIT(); __syncthreads();
            if (F.tid == 0) {
                unsigned* cw = ctl + CW_GLA + 64 * bh;
                __builtin_amdgcn_fence(__ATOMIC_RELEASE, "agent"); VM_WAIT();
                (void)xb_add(cw, 1u);
                unsigned sp = 0; while (xb_ld(cw) < 4u) { __builtin_amdgcn_s_sleep(2); if (++sp > (1u << 20)) { atomicAdd(ctl + CW_BAR + XB_TMO, 1u); break; } }
                __builtin_amdgcn_fence(__ATOMIC_ACQUIRE, "agent"); VM_WAIT();
            }
            __syncthreads();
            { const float* gp = args.in[6] + F.lane * 8; const f32x4 gq0 = *(const f32x4*)gp, gq1 = *(const f32x4*)(gp + 4);
              for (int tt = F.wave * 4; tt < 1024; tt += NWAVES * 4) {
                f32x4 v0[4], v1[4]; v4u sgw[4];
#pragma unroll
                for (int i = 0; i < 4; ++i) { const size_t o = ((size_t)b * SEQ + grp * 1024 + tt + i) * DM + h * 512 + F.lane * 8; v0[i] = *(const f32x4*)(ogla + o); v1[i] = *(const f32x4*)(ogla + o + 4); sgw[i] = *(const v4u*)(SG + o); }
#pragma unroll
                for (int i = 0; i < 4; ++i) { const size_t o = ((size_t)b * SEQ + grp * 1024 + tt + i) * DM + h * 512 + F.lane * 8;
                    const float ss = (v0[i].x * v0[i].x + v0[i].y * v0[i].y + v0[i].z * v0[i].z + v0[i].w * v0[i].w) + (v1[i].x * v1[i].x + v1[i].y * v1[i].y + v1[i].z * v1[i].z + v1[i].w * v1[i].w);
                    const float r = 1.0f / sqrtf(wave_sum(ss) * (1.f / 512.f) + EPS);
                    const float sg[8] = {bf2f(sgw[i].x & 0xffffu), bf2f(sgw[i].x >> 16), bf2f(sgw[i].y & 0xffffu), bf2f(sgw[i].y >> 16), bf2f(sgw[i].z & 0xffffu), bf2f(sgw[i].z >> 16), bf2f(sgw[i].w & 0xffffu), bf2f(sgw[i].w >> 16)};
                    *(v4u*)(onb + o) = (v4u){pk2(v0[i].x * r * gq0.x * sg[0], v0[i].y * r * gq0.y * sg[1]), pk2(v0[i].z * r * gq0.z * sg[2], v0[i].w * r * gq0.w * sg[3]),
                                             pk2(v1[i].x * r * gq1.x * sg[4], v1[i].y * r * gq1.y * sg[5]), pk2(v1[i].z * r * gq1.z * sg[6], v1[i].w * r * gq1.w * sg[7])}; } } }
        }
        __syncthreads();
        {
            constexpr int total = NB * 16 * 16, per_q = total / 8;
            volatile LAS int* qs = (volatile LAS int*)(F.lds + CTLW + 256);
            const unsigned myq = xb_xcc_id() & 7u;
#define FOX_FETCH(dst_) do { int got_ = total; for (unsigned k_ = 0; k_ < 8u; ++k_) { const unsigned q_ = (myq + k_) & 7u; \
                if (xb_ld(ctl + CW_FOXQ + 64 * q_) < (unsigned)per_q) { const unsigned v_ = atomicAdd(ctl + CW_FOXQ + 64 * q_, 1u); if (v_ < (unsigned)per_q) { got_ = (int)(q_ * per_q + v_); break; } } } (dst_) = got_; } while (0)
            if (F.tid == 0) { int a_, b_; FOX_FETCH(a_); FOX_FETCH(b_); qs[2] = a_; qs[3] = b_; }
            __syncthreads();
            int L = __builtin_amdgcn_readfirstlane(qs[2]), Ln = __builtin_amdgcn_readfirstlane(qs[3]), it = 0;
            if (L < total) {
#define FOX_REF(R_, L_) do { const int q_ = (L_) / per_q, i_ = (L_) - q_ * per_q, qb_ = 15 - (i_ >> 3), bh_ = (i_ & 7) * 8 + q_, b_ = bh_ >> 4, h_ = bh_ & 15; \
                (R_).Q = fqh + ((size_t)bh_ * SEQ + qb_ * 256) * 128; (R_).K = fkh + (size_t)bh_ * SEQ * 128; (R_).V = fvh + (size_t)bh_ * SEQ * 128; (R_).Bk = cbias + (size_t)bh_ * SEQ; \
                (R_).O = attb + ((size_t)(b_ * SEQ + qb_ * 256)) * DM + h_ * 128; (R_).P0 = qb_ * 256; } while (0)
                fa::BlockRef cur, nxt; fa::Seam S;
                FOX_REF(cur, L);
                fa::attn_prime<true, 128, 128, 128, DM>(cur, SEQ, (char*)lds_raw, S);
                for (;;) {
                    const bool last = Ln >= total;
                    if (last) nxt = cur; else FOX_REF(nxt, Ln);
                    if (F.tid == 0 && !last) { int a_; FOX_FETCH(a_); qs[it & 1] = a_; }
                    fa::attn_block<true, 128, 128, 128, DM>(cur, nxt, SEQ, SEQ, (char*)lds_raw, S);
                    if (last) break;
                    cur = nxt; L = Ln; Ln = __builtin_amdgcn_readfirstlane(qs[it & 1]); ++it;
                }
#undef FOX_REF
#undef FOX_FETCH
            }
        }
    }
    GRID_BAR(3);
    if (IN(5)) { REFRESH();
        { pg8::Gemm g{onb, WtBg, T, DM, DM}; pg8::StaticOrder S; S.init(T, DM, F.G, F.bid); EpiGate<0> E{(bf16*)Y1, GG, nullptr}; pg8::gemm_phase<EpiGate<0>, pg8::StaticOrder>(F.lds, g, S, E); }
        { pg8::Gemm g{attb, WtBf, T, DM, DM}; pg8::StaticOrder S; S.init(T, DM, F.G, F.bid); EpiGate<1> E{(bf16*)Y1, GF, mrg}; pg8::gemm_phase<EpiGate<1>, pg8::StaticOrder>(F.lds, g, S, E); }
    }
    GRID_BAR(5);
    if (IN(7)) { REFRESH(); pg8::Gemm g{mrg, WtOut, T, DM, DM}; pg8::StaticOrder S; S.init(T, DM, F.G, F.bid); EpiRes<true, false> E{x, X1, args.in[13], h2, RSS1}; pg8::gemm_phase<EpiRes<true, false>, pg8::StaticOrder>(F.lds, g, S, E); }
    GRID_BAR(7);
    if (IN(9)) { REFRESH();
        { pg8::Gemm g{h2, WtMq, T, 512, 1024, DM}; pg8::SplitOrder S{64, 2, 2, 1024, F.G, F.bid}; pg8::EpiF32 E{qm, 1024, nullptr}; pg8::gemm_phase<pg8::EpiF32, pg8::SplitOrder>(F.lds, g, S, E); }
        { pg8::Gemm g{mn, WtMkv, 1024, 1024, 512, DM}; pg8::SplitOrder S{4, 4, 4, 512, F.G, F.bid}; pg8::EpiF32 E{kv, 4096, nullptr}; pg8::gemm_phase<pg8::EpiF32, pg8::SplitOrder>(F.lds, g, S, E); }
    }
    GRID_BAR(9);
    if (IN(10)) { REFRESH();
        const int l16 = F.lane & 15, rsub = F.lane >> 4;
        for (int r0 = F.gw * 16; r0 < T * 4 + 1024 * 4; r0 += F.ngw * 16) {
            const bool isq = r0 < T * 4; const float* gp = args.in[isq ? 17 : 18] + 8 * l16; const f32x4 g0 = *(const f32x4*)gp, g1 = *(const f32x4*)(gp + 4);
            f32x4 a0[4], a1[4], c0[4], c1[4];
#pragma unroll
            for (int i = 0; i < 4; ++i) { const int r = (isq ? r0 : r0 - T * 4) + 4 * i + rsub, h = r & 3, row = r >> 2;
                if (isq) { const float* src = qm + (size_t)row * 1024 + h * 128 + 8 * l16; a0[i] = *(const f32x4*)src + *(const f32x4*)(src + 512); a1[i] = *(const f32x4*)(src + 4) + *(const f32x4*)(src + 516); }
                else { const float* src = kv + (size_t)row * 4096 + h * 128 + 8 * l16;
                    a0[i] = (*(const f32x4*)src + *(const f32x4*)(src + 1024)) + (*(const f32x4*)(src + 2048) + *(const f32x4*)(src + 3072));
                    a1[i] = (*(const f32x4*)(src + 4) + *(const f32x4*)(src + 1028)) + (*(const f32x4*)(src + 2052) + *(const f32x4*)(src + 3076));
                    c0[i] = (*(const f32x4*)(src + 512) + *(const f32x4*)(src + 1536)) + (*(const f32x4*)(src + 2560) + *(const f32x4*)(src + 3584));
                    c1[i] = (*(const f32x4*)(src + 516) + *(const f32x4*)(src + 1540)) + (*(const f32x4*)(src + 2564) + *(const f32x4*)(src + 3588)); } }
#pragma unroll
            for (int i = 0; i < 4; ++i) { const int r = (isq ? r0 : r0 - T * 4) + 4 * i + rsub, h = r & 3, row = r >> 2;
                float ss = (a0[i].x * a0[i].x + a0[i].y * a0[i].y + a0[i].z * a0[i].z + a0[i].w * a0[i].w) + (a1[i].x * a1[i].x + a1[i].y * a1[i].y + a1[i].z * a1[i].z + a1[i].w * a1[i].w);
                ss += __shfl_xor(ss, 1); ss += __shfl_xor(ss, 2); ss += __shfl_xor(ss, 4); ss += __shfl_xor(ss, 8);
                float epsq = EPS;
                if (isq) { const f32x2 p2 = *(const f32x2*)(RSS1 + (size_t)row * 32 + 2 * l16); float ms = p2.x + p2.y; ms += __shfl_xor(ms, 1); ms += __shfl_xor(ms, 2); ms += __shfl_xor(ms, 4); ms += __shfl_xor(ms, 8); epsq = EPS * (ms * (1.f / DM) + EPS); }
                const float rr = 1.0f / sqrtf(ss * (1.f / 128.f) + epsq);
                const v4u w = {pk2(a0[i].x * rr * g0.x, a0[i].y * rr * g0.y), pk2(a0[i].z * rr * g0.z, a0[i].w * rr * g0.w), pk2(a1[i].x * rr * g1.x, a1[i].y * rr * g1.y), pk2(a1[i].z * rr * g1.z, a1[i].w * rr * g1.w)};
                if (isq) *(v4u*)(qmb + (size_t)row * 512 + h * 128 + 8 * l16) = w;
                else { const size_t o = ((size_t)((row >> 8) * 4 + h) * MEML + (row & 255)) * 128 + 8 * l16; *(v4u*)(knb + o) = w;
                       *(v4u*)(vb + o) = (v4u){pk2(c0[i].x, c0[i].y), pk2(c0[i].z, c0[i].w), pk2(c1[i].x, c1[i].y), pk2(c1[i].z, c1[i].w)}; } }
        }
    }
    GRID_BAR(10);
    if (IN(11)) { REFRESH();
        {
            constexpr int total = NB * 4 * 16; const int stride = F.G; int L = F.bid;
            if (L < total) {
#define MEM_REF(R_, L_) do { const int bh_ = (L_) >> 4, qb_ = (L_) & 15, b_ = bh_ >> 2, h_ = bh_ & 3; \
                (R_).Q = qmb + ((size_t)(b_ * SEQ + qb_ * 256)) * 512 + h_ * 128; (R_).K = knb + (size_t)bh_ * MEML * 128; (R_).V = vb + (size_t)bh_ * MEML * 128; (R_).Bk = nullptr; \
                (R_).O = om + ((size_t)(b_ * SEQ + qb_ * 256)) * 512 + h_ * 128; (R_).P0 = MEML; } while (0)
                fa::BlockRef cur, nxt; fa::Seam S;
                MEM_REF(cur, L);
                fa::attn_prime<false, 512, 128, 128, 512>(cur, 1 << 30, (char*)lds_raw, S);
                for (;;) {
                    const bool more_item = L + stride < total; const int Ln = more_item ? L + stride : L;
                    if (!more_item) nxt = cur; else MEM_REF(nxt, Ln);
                    fa::attn_block<false, 512, 128, 128, 512>(cur, nxt, MEML, 1 << 30, (char*)lds_raw, S);
                    if (!more_item) break;
                    cur = nxt; L = Ln;
                }
#undef MEM_REF
            }
        }
    }
    GRID_BAR(11);
    if (IN(12)) { REFRESH(); pg8::Gemm g{om, WtMo, T, DM, 512}; pg8::StaticOrder S; S.init(T, DM, F.G, F.bid); EpiRes<true, true> E{X1, X2, args.in[20], xs, RSS2}; pg8::gemm_phase<EpiRes<true, true>, pg8::StaticOrder>(F.lds, g, S, E); }
    GRID_BAR(12);
    if (IN(15)) { REFRESH();
        const float* br = args.in[22];
        LAS int* hist = (LAS int*)F.lds; LAS int* gbase = hist + NE;
        LAS float* part = (LAS float*)(F.lds + 1024);
        for (int m0 = F.bid * 64; m0 < T; m0 += F.G * 64) {
            __syncthreads();
            if (F.tid < NE) hist[F.tid] = 0;
            { const int fr = F.lane & 15, fq = F.lane >> 4;
              f32x4 acc[4][2];
#pragma unroll
              for (int tb = 0; tb < 4; ++tb)
#pragma unroll
                  for (int eb = 0; eb < 2; ++eb) acc[tb][eb] = (f32x4){0.f, 0.f, 0.f, 0.f};
              const bf16* ap = xs + (size_t)(m0 + fr) * DM + 256 * F.wave + 8 * fq;
              const bf16* bp = WrT + (size_t)fr * DM + 256 * F.wave + 8 * fq;
              bf16x8 a[8][4], bw[8][2];
#pragma unroll
              for (int ks = 0; ks < 8; ++ks) {
#pragma unroll
                  for (int tb = 0; tb < 4; ++tb) a[ks][tb] = *(const bf16x8*)(ap + (size_t)tb * 16 * DM + ks * 32);
#pragma unroll
                  for (int eb = 0; eb < 2; ++eb) bw[ks][eb] = *(const bf16x8*)(bp + (size_t)eb * 16 * DM + ks * 32); }
#pragma unroll
              for (int ks = 0; ks < 8; ++ks)
#pragma unroll
                  for (int tb = 0; tb < 4; ++tb)
#pragma unroll
                      for (int eb = 0; eb < 2; ++eb) acc[tb][eb] = __builtin_amdgcn_mfma_f32_16x16x32_bf16(a[ks][tb], bw[ks][eb], acc[tb][eb], 0, 0, 0);
#pragma unroll
              for (int tb = 0; tb < 4; ++tb)
#pragma unroll
                  for (int eb = 0; eb < 2; ++eb)
#pragma unroll
                      for (int i = 0; i < 4; ++i) part[(F.wave * 64 + tb * 16 + 4 * fq + i) * 32 + eb * 16 + fr] = acc[tb][eb][i]; }
            __syncthreads();
            int ti[TOPK], rk[TOPK]; float gt[TOPK], rstd = 0.f; const int m = m0 + F.tid;
            if (F.tid < 64) {
                float ms = 0.f;
#pragma unroll
                for (int q = 0; q < 8; ++q) { const f32x4 p4 = *(const f32x4*)(RSS2 + (size_t)m * 32 + 4 * q); ms += (p4.x + p4.y) + (p4.z + p4.w); }
                rstd = 1.0f / sqrtf(ms * (1.f / DM) + EPS);
                float lg[NE];
#pragma unroll
                for (int q = 0; q < 8; ++q) { const LAS float* lp_ = part + F.tid * 32 + 4 * q;
                    const f32x4 l4 = ((*(const LAS f32x4*)lp_ + *(const LAS f32x4*)(lp_ + 2048)) + (*(const LAS f32x4*)(lp_ + 4096) + *(const LAS f32x4*)(lp_ + 6144)))
                                   + ((*(const LAS f32x4*)(lp_ + 8192) + *(const LAS f32x4*)(lp_ + 10240)) + (*(const LAS f32x4*)(lp_ + 12288) + *(const LAS f32x4*)(lp_ + 14336))), b4 = *(const f32x4*)(br + 4 * q);
                    lg[4 * q] = l4.x * rstd + b4.x; lg[4 * q + 1] = l4.y * rstd + b4.y; lg[4 * q + 2] = l4.z * rstd + b4.z; lg[4 * q + 3] = l4.w * rstd + b4.w; }
                unsigned taken = 0u; float tv[TOPK];
#pragma unroll
                for (int k = 0; k < TOPK; ++k) { float best = -3.0e38f; int bi = 0;
#pragma unroll
                    for (int e = 0; e < NE; ++e) { const bool ok = !((taken >> e) & 1u) && lg[e] > best; best = ok ? lg[e] : best; bi = ok ? e : bi; }
                    taken |= 1u << bi; tv[k] = best; ti[k] = bi; }
                float ps = 0.f;
#pragma unroll
                for (int k = 0; k < TOPK; ++k) { gt[k] = __expf(tv[k] - tv[0]); ps += gt[k]; }
#pragma unroll
                for (int k = 0; k < TOPK; ++k) { gt[k] /= ps; rk[k] = __hip_atomic_fetch_add(&hist[ti[k]], 1, __ATOMIC_RELAXED, __HIP_MEMORY_SCOPE_WORKGROUP); }
            }
            __syncthreads();
            if (F.tid < NE) gbase[F.tid] = (int)atomicAdd(ctl + CW_CNT + F.tid, (unsigned)hist[F.tid]);
            __syncthreads();
            if (F.tid < 64) {
#pragma unroll
                for (int k = 0; k < TOPK; ++k) { const int pos = gbase[ti[k]] + rk[k]; asg_e[m * TOPK + k] = ti[k]; asg_pos[m * TOPK + k] = pos;
                    const size_t li = (size_t)ti[k] * T + pos; tokl[li] = m; wl[li] = gt[k]; rsl[li] = rstd; }
            }
        }
    }
    GRID_BAR(15);
    if (IN(16)) { REFRESH();
        moe_tables(F.lds, ctl);
        pg8::Gemm g{xs, WtUp, PMAX, 4096, DM}; MoeOrder<true> S{F.lds, tokl, rsl, args.in[24], 16, F.G, F.bid}; EpiSwiglu E{act, F.lds};
        pg8::gemm_phase_gather<EpiSwiglu, MoeOrder<true>>(F.lds, g, S, E);
    }
    GRID_BAR(16);
    if (IN(17)) { REFRESH();
        moe_tables(F.lds, ctl);
        pg8::Gemm g{act, WtDn, PMAX, DM, DM}; MoeOrder<false> S{F.lds, tokl, wl, args.in[26], 8, F.G, F.bid}; EpiDown E{yb, F.lds};
        pg8::gemm_phase<EpiDown, MoeOrder<false>>(F.lds, g, S, E);
    }
    GRID_BAR(17);
    if (IN(18)) { REFRESH();
        moe_tables(F.lds, ctl);
        const LAS int* pbase = (const LAS int*)(F.lds + MT_PBASE);
        for (int t = F.gw; t < T; t += F.ngw) {
            int slot[TOPK];
#pragma unroll
            for (int k = 0; k < TOPK; ++k) slot[k] = pbase[asg_e[t * TOPK + k]] + asg_pos[t * TOPK + k];
            f32x4 o0[4], o1[4]; v4u w[4][TOPK];
#pragma unroll
            for (int p = 0; p < 4; ++p) { const int j = 512 * p + 8 * F.lane; { const v4u xw = *(const v4u*)((const bf16*)X2 + (size_t)t * DM + j); o0[p] = (f32x4){bf2f(xw.x & 0xffffu), bf2f(xw.x >> 16), bf2f(xw.y & 0xffffu), bf2f(xw.y >> 16)}; o1[p] = (f32x4){bf2f(xw.z & 0xffffu), bf2f(xw.z >> 16), bf2f(xw.w & 0xffffu), bf2f(xw.w >> 16)}; }
#pragma unroll
                for (int k = 0; k < TOPK; ++k) w[p][k] = *(const v4u*)(yb + (size_t)slot[k] * DM + j); }
#pragma unroll
            for (int p = 0; p < 4; ++p) { const int j = 512 * p + 8 * F.lane;
#pragma unroll
                for (int k = 0; k < TOPK; ++k) { const v4u q = w[p][k];
                    o0[p].x += bf2f(q.x & 0xffffu); o0[p].y += bf2f(q.x >> 16); o0[p].z += bf2f(q.y & 0xffffu); o0[p].w += bf2f(q.y >> 16);
                    o1[p].x += bf2f(q.z & 0xffffu); o1[p].y += bf2f(q.z >> 16); o1[p].z += bf2f(q.w & 0xffffu); o1[p].w += bf2f(q.w >> 16); }
                *(f32x4*)(args.out + (size_t)t * DM + j) = o0[p]; *(f32x4*)(args.out + (size_t)t * DM + j + 4) = o1[p]; }
        }
    }
#undef IN
}

constexpr int NPHASE = 19;
extern "C" void kernel_launch(void* const* d_in, const int* in_sizes, int n_in, void* d_out, int out_size, void* d_ws, size_t ws_size, hipStream_t stream) {
    static int grid = 0;
    static_assert(WS_END <= (size_t)4290 * 1000 * 1000, "d_ws map too large");
    if (grid == 0) {
        if (n_in != 27 || out_size != T * DM || ws_size < WS_END) { fprintf(stderr, "kernel_launch: unexpected shapes (n_in %d, out %d, ws %zu, need %zu)\n", n_in, out_size, ws_size, (size_t)WS_END); grid = -1; return; }
        int dev = 0, cus = 0, per_cu = 0;
        if (hipGetDevice(&dev) != hipSuccess || hipDeviceGetAttribute(&cus, hipDeviceAttributeMultiprocessorCount, dev) != hipSuccess) { grid = -1; return; }
        if (hipFuncSetAttribute((const void*)mk_fwd, hipFuncAttributeMaxDynamicSharedMemorySize, LDS_BYTES) != hipSuccess) { fprintf(stderr, "kernel_launch: hipFuncSetAttribute failed\n"); grid = -1; return; }
        if (hipOccupancyMaxActiveBlocksPerMultiprocessor(&per_cu, (const void*)mk_fwd, NWAVES * 64, LDS_BYTES) != hipSuccess || per_cu < 1) fprintf(stderr, "kernel_launch: occupancy query says %d\n", per_cu);
        (void)hipGetLastError();
        grid = cus;
    }
    if (grid < 0) return;
    (void)hipMemsetAsync((char*)d_ws + WS_CTL, 0, CTL_BYTES, stream);
    Args a{};
    for (int i = 0; i < 27; ++i) a.in[i] = (const float*)d_in[i];
    a.out = (float*)d_out; a.ws = (unsigned char*)d_ws;
    #ifndef MK_PER_PHASE
    a.ph_lo = 0; a.ph_hi = NPHASE; hipLaunchKernelGGL(mk_fwd, dim3(grid), dim3(NWAVES * 64), LDS_BYTES, stream, a);
#ifdef PROBE_LO
    (void)hipMemsetAsync((char*)d_ws + WS_CTL, 0, CTL_BYTES, stream);
    a.ph_lo = PROBE_LO; a.ph_hi = PROBE_HI; hipLaunchKernelGGL(mk_fwd, dim3(grid), dim3(NWAVES * 64), LDS_BYTES, stream, a);
#endif
#else
    for (int p = 0; p < NPHASE; ++p) { a.ph_lo = p; a.ph_hi = p + 1; hipLaunchKernelGGL(mk_fwd, dim3(grid), dim3(NWAVES * 64), LDS_BYTES, stream, a); }
#endif
}
```

```cpp
#include <hip/hip_runtime.h>
#include <cstdio>
#include <cstdint>

#define GAS __attribute__((address_space(1)))
#define LAS __attribute__((address_space(3)))
typedef unsigned short bf16;
typedef unsigned v4u __attribute__((ext_vector_type(4)));
typedef unsigned v2u __attribute__((ext_vector_type(2)));
typedef float f32x4 __attribute__((ext_vector_type(4)));
typedef float f32x2 __attribute__((ext_vector_type(2)));
typedef short bf16x8 __attribute__((ext_vector_type(8)));

constexpr int T = 16384, DM = 2048, NB = 4, SEQ = 4096, MEML = 256;
constexpr float EPS = 1e-6f;
constexpr int INC = 16416, INCP = 16640;
constexpr int C_GQ = 0, C_GK = 1024, C_GV = 2048, C_GR = 4096, C_GA = 6144, C_FQ = 6160, C_FK = 8208, C_FV = 10256, C_FF = 12304, C_GG = 12320, C_GF = 14368;
constexpr int NE = 32, TOPK = 4, NASG = T * TOPK, PMAX = NASG + NE * 256;
constexpr int MAXRT = PMAX / 256;

__device__ __forceinline__ unsigned f2bf(float f) { unsigned u = __builtin_bit_cast(unsigned, f); return (u + 0x7fffu + ((u >> 16) & 1u)) >> 16; }
__device__ __forceinline__ unsigned pk2(float lo, float hi) { unsigned r; asm("v_cvt_pk_bf16_f32 %0, %1, %2" : "=v"(r) : "v"(lo), "v"(hi)); return r; }
__device__ __forceinline__ float bf2f(unsigned b) { return __builtin_bit_cast(float, b << 16); }
__device__ __forceinline__ float wave_sum(float v) {
#pragma unroll
    for (int o = 1; o < 64; o <<= 1) v += __shfl_xor(v, o);
    return v;
}
__device__ __forceinline__ float sigmoid_f(float x) { return __builtin_amdgcn_rcpf(1.0f + __expf(-x)); }
__device__ __forceinline__ float log_sigmoid_f(float x) { return fminf(x, 0.f) - __logf(1.0f + __expf(-fabsf(x))); }
#define LDS_WAIT() asm volatile("s_waitcnt lgkmcnt(0)" ::: "memory")
#define VM_WAIT() asm volatile("s_waitcnt vmcnt(0)" ::: "memory")
#define XB_TMO      128
#define XB_XCNT(j)  (256  + 64 * (j))
#define XB_XSUB(j)  (1280 + 64 * (j))
#define XB_XGEN(j)  (2304 + 64 * (j))
#define XB_TOP      3328
#define XB_TOPGEN   3392
#define XCD_BAR_WORDS 3456
#define XB_SPIN_CAP (1u << 18)

__device__ __forceinline__ unsigned xb_ld(unsigned* p)              { return __hip_atomic_load(p, __ATOMIC_RELAXED, __HIP_MEMORY_SCOPE_AGENT); }
__device__ __forceinline__ unsigned xb_add(unsigned* p, unsigned v) { return __hip_atomic_fetch_add(p, v, __ATOMIC_RELAXED, __HIP_MEMORY_SCOPE_AGENT); }
__device__ __forceinline__ unsigned xb_xcc_id() { return (unsigned)__builtin_amdgcn_s_getreg((3 << 11) | 20) & 0xFu; }
#define XB_SPIN(cond, bar) do { unsigned _sp = 0; while (cond) { __builtin_amdgcn_s_sleep(1); \
    if ((++_sp & 255u) == 0u) { if (xb_ld(&(bar)[XB_TMO])) break; if (_sp > XB_SPIN_CAP) { atomicAdd(&(bar)[XB_TMO], 1u); break; } } } } while (0)

struct XcdBarrier {
    unsigned* bar; unsigned x;
    volatile LAS unsigned* st;
};
__device__ __forceinline__ XcdBarrier xcd_barrier_post(unsigned* bar, volatile LAS unsigned* st) {
    XcdBarrier b; b.bar = bar; b.x = xb_xcc_id(); b.st = st;
    if (threadIdx.x == 0) (void)xb_add(&bar[XB_XCNT(b.x)], 1u);
    return b;
}
__device__ __forceinline__ void xcd_barrier_complete(unsigned* bar, unsigned x, unsigned& nloc, unsigned& nx) {
    const unsigned G = gridDim.x * gridDim.y * gridDim.z;
    unsigned sum, cnt, mine, sp = 0u;
    for (;;) {
        sum = 0u; cnt = 0u; mine = 0u;
#pragma unroll
        for (unsigned j = 0; j < 16; ++j) { const unsigned c = xb_ld(&bar[XB_XCNT(j)]); sum += c; cnt += (c > 0u) ? 1u : 0u; mine = (j == x) ? c : mine; }
        if (sum == G) break;
        __builtin_amdgcn_s_sleep(1);
        if ((++sp & 255u) == 0u) { if (xb_ld(&bar[XB_TMO])) break; if (sp > XB_SPIN_CAP) { atomicAdd(&bar[XB_TMO], 1u); break; } }
    }
    nloc = mine > 0u ? mine : 1u; nx = cnt > 0u ? cnt : 1u;
}
__device__ __forceinline__ void xcd_barrier(const XcdBarrier& b) {
    asm volatile("s_waitcnt vmcnt(0)" ::: "memory");
    __syncthreads();
    if (threadIdx.x == 0) {
        unsigned* bar = b.bar;
        __builtin_amdgcn_s_waitcnt(0);
        unsigned nloc = b.st[0], nx = b.st[1];
        if (nloc == 0u) { xcd_barrier_complete(bar, b.x, nloc, nx); b.st[0] = nloc; b.st[1] = nx; }
        const unsigned old = xb_add(&bar[XB_XSUB(b.x)], 1u);
        const unsigned gen = old / nloc;
        if (old + 1u == (gen + 1u) * nloc) {
            __builtin_amdgcn_fence(__ATOMIC_RELEASE, "agent");
            asm volatile("s_waitcnt vmcnt(0)" ::: "memory");
            const unsigned og = xb_add(&bar[XB_TOP], 1u);
            const unsigned tg = og / nx;
            if (og + 1u == (tg + 1u) * nx) xb_add(&bar[XB_TOPGEN], 1u);
            else XB_SPIN(xb_ld(&bar[XB_TOPGEN]) == tg, bar);
            __builtin_amdgcn_fence(__ATOMIC_ACQUIRE, "agent");
            xb_add(&bar[XB_XGEN(b.x)], 1u);
            asm volatile("s_waitcnt vmcnt(0)" ::: "memory");
        } else {
            XB_SPIN(xb_ld(&bar[XB_XGEN(b.x)]) == gen, bar);
            __builtin_amdgcn_fence(__ATOMIC_ACQUIRE, "agent");
            asm volatile("s_waitcnt vmcnt(0)" ::: "memory");
        }
    }
    __syncthreads();
}
namespace pg8 {
#define PG8_LAS __attribute__((address_space(3)))
typedef unsigned short bf16_t;
typedef short bf16x8 __attribute__((ext_vector_type(8)));
typedef float f32x4 __attribute__((ext_vector_type(4)));
typedef unsigned u32x4 __attribute__((ext_vector_type(4)));
constexpr int BM = 256, BK = 64, HALF = 128, HTB = HALF * BK * 2  , STAGE_BYTES = 8 * HTB, NXCD = 8, WGM = 8;

__host__ __device__ __forceinline__ int lds_byte(int r, int c) { const int st = (r >> 4) * 2 + (c >> 5), rr = r & 15, cc = c & 31, ob = rr * 64 + cc * 2; return st * 1024 + (ob ^ (((ob >> 9) & 1) << 5)); }
__host__ __device__ __forceinline__ void stage_rc(int b, int& R, int& C) { const int st = b / 1024, sb = b % 1024, swz = sb ^ (((sb >> 9) & 1) << 5); R = (st >> 1) * 16 + swz / 64; C = (st & 1) * 32 + (swz % 64) / 2; }
__host__ __device__ __forceinline__ int perm32(int rho) { const int n = rho >> 4, i = rho & 15; return 8 * (i >> 2) + 4 * n + (i & 3); }

struct Unit { int pm, pn, pb, kofs, sb; };
struct Gemm { const bf16_t* A; const bf16_t* Bt; int M, N, K, ld; };

struct StaticOrder {
    int nM, nN, nwg, G, c, i0 = 0, iend = 1 << 30;
    __host__ __device__ void init(int M, int N, int G_, int c_) { nM = M / BM; nN = N / BM; nwg = nM * nN; G = G_; c = c_; }
    __host__ __device__ bool next(int i, Unit& u) const {
        if (i + i0 >= iend) return false;
        const long L = (long)(i + i0) * G + c; if (L >= nwg) return false;
        int wgid = (int)L; { const int q = nwg / NXCD, r = nwg % NXCD, xcd = wgid % NXCD, off = wgid / NXCD; wgid = (xcd < r ? xcd * (q + 1) : r * (q + 1) + (xcd - r) * q) + off; }
        const int nig = WGM * nN, gid = wgid / nig, fm = gid * WGM, gsz = (nM - fm) < WGM ? (nM - fm) : WGM;
        u.pm = fm + ((wgid % nig) % gsz); u.pn = (wgid % nig) / gsz; u.pb = u.pn; u.kofs = 0; return true;
    }
    static constexpr bool SIDE = false;
    __device__ __forceinline__ void prefetch(const Unit&, int, int, int) const {}
    __device__ __forceinline__ void a_ready(const Unit&) const {}
    __device__ __forceinline__ void done(const Unit&) const {}
};

struct SplitOrder {
    int nM, nN, nS, Ks, G, c;
    __host__ __device__ bool next(int i, Unit& u) const {
        const long L = (long)i * G + c; if (L >= (long)nM * nN * nS) return false;
        const int s = (int)(L % nS), r = (int)(L / nS); u.pm = r / nN; const int pn = r % nN; u.pn = s * nN + pn; u.pb = pn; u.kofs = s * Ks; return true;
    }
    static constexpr bool SIDE = false;
    __device__ __forceinline__ void prefetch(const Unit&, int, int, int) const {}
    __device__ __forceinline__ void a_ready(const Unit&) const {}
    __device__ __forceinline__ void done(const Unit&) const {}
};

__device__ __forceinline__ unsigned cvt_pk_bf16(float lo, float hi) { unsigned r; asm volatile("v_cvt_pk_bf16_f32 %0, %1, %2" : "=v"(r) : "v"(lo), "v"(hi)); return r; }

struct EpiF32 {
    static constexpr bool PERM = false;
    float* C; int ldc; const float* bias;
    __device__ __forceinline__ void operator()(const f32x4 (&acc)[2][2][4][2], const Unit& u, int wr, int wc, int fr, int fq) const {
        const int row0 = u.pm * BM + wr * 64 + fr, col0 = u.pn * BM + wc * 32 + 4 * fq;
        f32x4 bv[2][2];
#pragma unroll
        for (int bj = 0; bj < 2; ++bj)
#pragma unroll
            for (int n = 0; n < 2; ++n) bv[bj][n] = bias ? *(const f32x4*)(bias + col0 + bj * HALF + n * 16) : (f32x4){0.f, 0.f, 0.f, 0.f};
#pragma unroll
        for (int ai = 0; ai < 2; ++ai)
#pragma unroll
            for (int m = 0; m < 4; ++m) { float* rowp = C + (size_t)(row0 + ai * HALF + m * 16) * ldc + col0;
#pragma unroll
                for (int bj = 0; bj < 2; ++bj)
#pragma unroll
                    for (int n = 0; n < 2; ++n) *(f32x4*)(rowp + bj * HALF + n * 16) = acc[ai][bj][m][n] + bv[bj][n]; }
    }
};

struct EpiN32 {
    static constexpr bool PERM = false;
    float* C; int ldc;
    __device__ __forceinline__ void operator()(const f32x4 (&acc)[2][2][4][2], const Unit& u, int wr, int wc, int fr, int fq) const {
        if (wc != 0) return;
        const int row0 = u.pm * BM + wr * 64 + fr;
#pragma unroll
        for (int ai = 0; ai < 2; ++ai)
#pragma unroll
            for (int m = 0; m < 4; ++m) { float* rowp = C + (size_t)(row0 + ai * HALF + m * 16) * ldc + 32 * u.pn + 4 * fq;
                *(f32x4*)rowp = acc[ai][0][m][0]; *(f32x4*)(rowp + 16) = acc[ai][0][m][1]; }
    }
};

template <class Epi, class Sched>
__device__ __forceinline__ void gemm_phase(PG8_LAS unsigned char* lds, const Gemm g, const Sched& S, const Epi& E) {
    const int tid = threadIdx.x, wid = __builtin_amdgcn_readfirstlane(tid >> 6), lane = tid & 63, wr = wid >> 2, wc = wid & 3, fr = lane & 15, fq = lane >> 4;
    const int K = g.K, nt = K / BK, LD = g.ld ? g.ld : g.K;
    unsigned voffA[2], voffB[2];
#pragma unroll
    for (int i = 0; i < 2; ++i) { int R, C; stage_rc(tid * 16 + i * 8192, R, C); const int Rb = Epi::PERM ? ((R & ~31) + perm32(R & 31)) : R;
        voffA[i] = (unsigned)(R * LD + C) * 2u; voffB[i] = (unsigned)(Rb * LD + C) * 2u; }
    const size_t kstep = (size_t)(BK * 2);
    const size_t hstep = (size_t)HALF * LD * 2;
    const size_t tstep = 2 * hstep;
    const unsigned ldsw = (unsigned)wid * 1024u;
    const int aoff = lds_byte(wr * 64 + fr, fq * 8), boff = lds_byte(wc * 32 + fr, fq * 8);
#define PG8_SA(b, h) (((b) * 2 + (h)) * HTB)
#define PG8_SB(b, h) ((4 + (b) * 2 + (h)) * HTB)
#define PG8_STAGE(bufoff, gbase, voff) do { _Pragma("unroll") for (int _i = 0; _i < 2; ++_i) \
        __builtin_amdgcn_global_load_lds((const unsigned*)((const char*)(gbase) + (voff)[_i]), (PG8_LAS unsigned*)(lds + (bufoff) + ldsw + _i * 8192), 16, 0, 0); } while (0)
#define PG8_LDA(dst, b, h) do { _Pragma("unroll") for (int m = 0; m < 4; ++m) _Pragma("unroll") for (int k = 0; k < 2; ++k) dst[m][k] = *(const PG8_LAS bf16x8*)(lds + PG8_SA(b, h) + aoff + m * 2048 + k * 1024); } while (0)
#define PG8_LDB(dst, b, h) do { _Pragma("unroll") for (int n = 0; n < 2; ++n) _Pragma("unroll") for (int k = 0; k < 2; ++k) dst[n][k] = *(const PG8_LAS bf16x8*)(lds + PG8_SB(b, h) + boff + n * 2048 + k * 1024); } while (0)
#define PG8_MMA(ai, bj, At, Bt) do { __builtin_amdgcn_s_setprio(1); _Pragma("unroll") for (int m = 0; m < 4; ++m) _Pragma("unroll") for (int n = 0; n < 2; ++n) _Pragma("unroll") for (int k = 0; k < 2; ++k) \
        acc[ai][bj][m][n] = __builtin_amdgcn_mfma_f32_16x16x32_bf16(Bt[n][k], At[m][k], acc[ai][bj][m][n], 0, 0, 0); __builtin_amdgcn_s_setprio(0); } while (0)
#define PG8_WAIT_V(n) asm volatile("s_waitcnt vmcnt(" #n ")" ::: "memory")
#define PG8_WAIT_L(n) asm volatile("s_waitcnt lgkmcnt(" #n ")" ::: "memory")
#define PG8_BAR __builtin_amdgcn_s_barrier()
#define PG8_SCHED __builtin_amdgcn_sched_barrier(0)
    Unit cur, nxt; int ui = 0;
    if (!S.next(0, cur)) return;
    f32x4 acc[2][2][4][2];
#pragma unroll
    for (int a = 0; a < 2; ++a)
#pragma unroll
        for (int b = 0; b < 2; ++b)
#pragma unroll
            for (int m = 0; m < 4; ++m)
#pragma unroll
                for (int n = 0; n < 2; ++n) acc[a][b][m][n] = (f32x4){0.f, 0.f, 0.f, 0.f};
    bf16x8 At[4][2], B0[2][2], B1[2][2];
    const char* cA = (const char*)g.A + (size_t)cur.pm * tstep + (size_t)cur.kofs * 2; const char* cB = (const char*)g.Bt + (size_t)cur.pb * tstep + (size_t)cur.kofs * 2;
    S.a_ready(cur); cur.sb = 0;
    if constexpr (Sched::SIDE) S.prefetch(cur, 0, wid, lane);
    PG8_STAGE(PG8_SB(0, 0), cB, voffB); PG8_STAGE(PG8_SA(0, 0), cA, voffA); PG8_STAGE(PG8_SB(0, 1), cB + hstep, voffB); PG8_STAGE(PG8_SA(0, 1), cA + hstep, voffA);
    if (wr == 1) PG8_BAR;
    PG8_WAIT_V(4); PG8_BAR;
    PG8_STAGE(PG8_SB(1, 0), cB + kstep, voffB); PG8_STAGE(PG8_SA(1, 0), cA + kstep, voffA); PG8_STAGE(PG8_SB(1, 1), cB + hstep + kstep, voffB);
    PG8_WAIT_V(6); PG8_BAR;
    for (;;) {
        const bool has_next = S.next(ui + 1, nxt); nxt.sb = cur.sb == 2 ? 0 : cur.sb + 1;
        if constexpr (Sched::SIDE) { if (has_next) S.prefetch(nxt, nxt.sb, wid, lane); }
        const char* nA = has_next ? (const char*)g.A + (size_t)nxt.pm * tstep + (size_t)nxt.kofs * 2 : cA; const char* nB = has_next ? (const char*)g.Bt + (size_t)nxt.pb * tstep + (size_t)nxt.kofs * 2 : cB;
        for (int t = 0; t < nt; t += 2) {
            const bool last = (t == nt - 2);
            const char* a1 = cA + (size_t)(t + 1) * kstep;
            const char* a2 = last ? nA : cA + (size_t)(t + 2) * kstep; const char* b2 = last ? nB : cB + (size_t)(t + 2) * kstep;
            const char* a3 = a2 + kstep; const char* b3 = b2 + kstep;
            if (last && has_next) S.a_ready(nxt);
            PG8_LDB(B0, 0, 0); PG8_SCHED; PG8_LDA(At, 0, 0); PG8_STAGE(PG8_SA(1, 1), a1 + hstep, voffA);
            PG8_WAIT_L(8); PG8_BAR; PG8_WAIT_L(0); PG8_MMA(0, 0, At, B0); PG8_BAR; PG8_SCHED;
            PG8_LDB(B1, 0, 1); PG8_STAGE(PG8_SB(0, 0), b2, voffB);
            PG8_BAR; PG8_WAIT_L(0); PG8_MMA(0, 1, At, B1); PG8_BAR;
            PG8_LDA(At, 0, 1); PG8_STAGE(PG8_SA(0, 0), a2, voffA);
            PG8_BAR; PG8_WAIT_L(0); PG8_MMA(1, 0, At, B0); PG8_BAR; PG8_SCHED;
            PG8_STAGE(PG8_SB(0, 1), b2 + hstep, voffB);
            PG8_WAIT_V(6); PG8_BAR; PG8_MMA(1, 1, At, B1); PG8_BAR;
            PG8_LDB(B0, 1, 0); PG8_SCHED; PG8_LDA(At, 1, 0); PG8_STAGE(PG8_SA(0, 1), a2 + hstep, voffA);
            PG8_WAIT_L(8); PG8_BAR; PG8_WAIT_L(0); PG8_MMA(0, 0, At, B0); PG8_BAR; PG8_SCHED;
            PG8_LDB(B1, 1, 1); PG8_STAGE(PG8_SB(1, 0), b3, voffB);
            PG8_BAR; PG8_WAIT_L(0); PG8_MMA(0, 1, At, B1); PG8_BAR;
            PG8_LDA(At, 1, 1); PG8_STAGE(PG8_SA(1, 0), a3, voffA);
            PG8_BAR; PG8_WAIT_L(0); PG8_MMA(1, 0, At, B0); PG8_BAR; PG8_SCHED;
            PG8_STAGE(PG8_SB(1, 1), b3 + hstep, voffB);
            PG8_WAIT_V(6); PG8_BAR; PG8_MMA(1, 1, At, B1); PG8_BAR;
        }
        E(acc, cur, wr, wc, fr, fq); S.done(cur);
        if (!has_next) break;
#pragma unroll
        for (int a = 0; a < 2; ++a)
#pragma unroll
            for (int b = 0; b < 2; ++b)
#pragma unroll
                for (int m = 0; m < 4; ++m)
#pragma unroll
                    for (int n = 0; n < 2; ++n) acc[a][b][m][n] = (f32x4){0.f, 0.f, 0.f, 0.f};
        cur = nxt; cA = nA; cB = nB; ++ui;
    }
    PG8_WAIT_V(0);
    if (wr == 0) PG8_BAR;
    PG8_BAR;
#undef PG8_SA
#undef PG8_SB
#undef PG8_STAGE
#undef PG8_LDA
#undef PG8_LDB
#undef PG8_MMA
#undef PG8_WAIT_V
#undef PG8_WAIT_L
#undef PG8_BAR
#undef PG8_SCHED
}
template <class Epi, class Sched>
__device__ __forceinline__ void gemm_phase_gather(PG8_LAS unsigned char* lds, const Gemm g, const Sched& S, const Epi& E) {
    const int tid = threadIdx.x, wid = __builtin_amdgcn_readfirstlane(tid >> 6), lane = tid & 63, wr = wid >> 2, wc = wid & 3, fr = lane & 15, fq = lane >> 4;
    const int K = g.K, nt = K / BK;
    unsigned voffB[2]; int RA[2], CA[2];
#pragma unroll
    for (int i = 0; i < 2; ++i) { int R, C; stage_rc(tid * 16 + i * 8192, R, C); const int Rb = Epi::PERM ? ((R & ~31) + perm32(R & 31)) : R;
        RA[i] = R; CA[i] = C * 2; voffB[i] = (unsigned)(Rb * K + C) * 2u; }
    unsigned va0[2], va1[2], vn0[2], vn1[2];
#define PG8_ROWS(u_, d0, d1) do { const PG8_LAS int* tk_ = S.tok_table((u_).sb); _Pragma("unroll") for (int _i = 0; _i < 2; ++_i) { d0[_i] = (unsigned)tk_[RA[_i]] * (unsigned)(K * 2) + (unsigned)CA[_i]; d1[_i] = (unsigned)tk_[HALF + RA[_i]] * (unsigned)(K * 2) + (unsigned)CA[_i]; } } while (0)
    const size_t kstep = (size_t)(BK * 2);
    const size_t hstep = (size_t)HALF * K * 2;
    const size_t tstep = 2 * hstep;
    const unsigned ldsw = (unsigned)wid * 1024u;
    const int aoff = lds_byte(wr * 64 + fr, fq * 8), boff = lds_byte(wc * 32 + fr, fq * 8);
#define PG8_SA(b, h) (((b) * 2 + (h)) * HTB)
#define PG8_SB(b, h) ((4 + (b) * 2 + (h)) * HTB)
#define PG8_STAGE(bufoff, gbase, voff) do { _Pragma("unroll") for (int _i = 0; _i < 2; ++_i) \
        __builtin_amdgcn_global_load_lds((const unsigned*)((const char*)(gbase) + (voff)[_i]), (PG8_LAS unsigned*)(lds + (bufoff) + ldsw + _i * 8192), 16, 0, 0); } while (0)
#define PG8_LDA(dst, b, h) do { _Pragma("unroll") for (int m = 0; m < 4; ++m) _Pragma("unroll") for (int k = 0; k < 2; ++k) dst[m][k] = *(const PG8_LAS bf16x8*)(lds + PG8_SA(b, h) + aoff + m * 2048 + k * 1024); } while (0)
#define PG8_LDB(dst, b, h) do { _Pragma("unroll") for (int n = 0; n < 2; ++n) _Pragma("unroll") for (int k = 0; k < 2; ++k) dst[n][k] = *(const PG8_LAS bf16x8*)(lds + PG8_SB(b, h) + boff + n * 2048 + k * 1024); } while (0)
#define PG8_MMA(ai, bj, At, Bt) do { __builtin_amdgcn_s_setprio(1); _Pragma("unroll") for (int m = 0; m < 4; ++m) _Pragma("unroll") for (int n = 0; n < 2; ++n) _Pragma("unroll") for (int k = 0; k < 2; ++k) \
        acc[ai][bj][m][n] = __builtin_amdgcn_mfma_f32_16x16x32_bf16(Bt[n][k], At[m][k], acc[ai][bj][m][n], 0, 0, 0); __builtin_amdgcn_s_setprio(0); } while (0)
#define PG8_WAIT_V(n) asm volatile("s_waitcnt vmcnt(" #n ")" ::: "memory")
#define PG8_WAIT_L(n) asm volatile("s_waitcnt lgkmcnt(" #n ")" ::: "memory")
#define PG8_BAR __builtin_amdgcn_s_barrier()
#define PG8_SCHED __builtin_amdgcn_sched_barrier(0)
    Unit cur, nxt; int ui = 0;
    if (!S.next(0, cur)) return;
    f32x4 acc[2][2][4][2];
#pragma unroll
    for (int a = 0; a < 2; ++a)
#pragma unroll
        for (int b = 0; b < 2; ++b)
#pragma unroll
            for (int m = 0; m < 4; ++m)
#pragma unroll
                for (int n = 0; n < 2; ++n) acc[a][b][m][n] = (f32x4){0.f, 0.f, 0.f, 0.f};
    bf16x8 At[4][2], B0[2][2], B1[2][2];
    const char* cA = (const char*)g.A; const char* cB = (const char*)g.Bt + (size_t)cur.pb * tstep;
    S.a_ready(cur); cur.sb = 0;
    S.prefetch(cur, 0, wid, lane); PG8_WAIT_V(0); __syncthreads();
    PG8_ROWS(cur, va0, va1);
    PG8_STAGE(PG8_SB(0, 0), cB, voffB); PG8_STAGE(PG8_SA(0, 0), cA, va0); PG8_STAGE(PG8_SB(0, 1), cB + hstep, voffB); PG8_STAGE(PG8_SA(0, 1), cA, va1);
    if (wr == 1) PG8_BAR;
    PG8_WAIT_V(4); PG8_BAR;
    PG8_STAGE(PG8_SB(1, 0), cB + kstep, voffB); PG8_STAGE(PG8_SA(1, 0), cA + kstep, va0); PG8_STAGE(PG8_SB(1, 1), cB + hstep + kstep, voffB);
    PG8_WAIT_V(6); PG8_BAR;
    for (;;) {
        const bool has_next = S.next(ui + 1, nxt); nxt.sb = cur.sb == 2 ? 0 : cur.sb + 1;
        const char* nB = has_next ? (const char*)g.Bt + (size_t)nxt.pb * tstep : cB;
        if (has_next) S.prefetch(nxt, nxt.sb, wid, lane);
        for (int t = 0; t < nt; t += 2) {
            const bool last = (t == nt - 2);
            const char* a1 = cA + (size_t)(t + 1) * kstep;
            const char* a2 = last ? cA : cA + (size_t)(t + 2) * kstep; const char* b2 = last ? nB : cB + (size_t)(t + 2) * kstep;
            int tkr0[2], tkr1[2];
            { const PG8_LAS int* tk_ = S.tok_table(nxt.sb);
#pragma unroll
              for (int _i = 0; _i < 2; ++_i) { tkr0[_i] = tk_[RA[_i]]; tkr1[_i] = tk_[HALF + RA[_i]]; } }
            PG8_SCHED;
            const char* a3 = a2 + kstep; const char* b3 = b2 + kstep;
            if (last && has_next) S.a_ready(nxt);
            PG8_LDB(B0, 0, 0); PG8_SCHED; PG8_LDA(At, 0, 0); PG8_STAGE(PG8_SA(1, 1), a1, va1);
            PG8_WAIT_L(8); PG8_BAR; PG8_WAIT_L(0); PG8_MMA(0, 0, At, B0); PG8_BAR; PG8_SCHED;
            PG8_LDB(B1, 0, 1); PG8_STAGE(PG8_SB(0, 0), b2, voffB);
            PG8_BAR; PG8_WAIT_L(0); PG8_MMA(0, 1, At, B1); PG8_BAR;
            unsigned x0[2], x1[2];
#pragma unroll
            for (int _i = 0; _i < 2; ++_i) { vn0[_i] = has_next ? (unsigned)tkr0[_i] * (unsigned)(K * 2) + (unsigned)CA[_i] : va0[_i]; vn1[_i] = has_next ? (unsigned)tkr1[_i] * (unsigned)(K * 2) + (unsigned)CA[_i] : va1[_i];
                x0[_i] = last ? vn0[_i] : va0[_i]; x1[_i] = last ? vn1[_i] : va1[_i]; }
            PG8_SCHED;
            PG8_LDA(At, 0, 1); PG8_STAGE(PG8_SA(0, 0), a2, x0);
            PG8_BAR; PG8_WAIT_L(0); PG8_MMA(1, 0, At, B0); PG8_BAR; PG8_SCHED;
            PG8_STAGE(PG8_SB(0, 1), b2 + hstep, voffB);
            PG8_WAIT_V(6); PG8_BAR; PG8_MMA(1, 1, At, B1); PG8_BAR;
            PG8_LDB(B0, 1, 0); PG8_SCHED; PG8_LDA(At, 1, 0); PG8_STAGE(PG8_SA(0, 1), a2, x1);
            PG8_WAIT_L(8); PG8_BAR; PG8_WAIT_L(0); PG8_MMA(0, 0, At, B0); PG8_BAR; PG8_SCHED;
            PG8_LDB(B1, 1, 1); PG8_STAGE(PG8_SB(1, 0), b3, voffB);
            PG8_BAR; PG8_WAIT_L(0); PG8_MMA(0, 1, At, B1); PG8_BAR;
            PG8_LDA(At, 1, 1); PG8_STAGE(PG8_SA(1, 0), a3, x0);
            PG8_BAR; PG8_WAIT_L(0); PG8_MMA(1, 0, At, B0); PG8_BAR; PG8_SCHED;
            PG8_STAGE(PG8_SB(1, 1), b3 + hstep, voffB);
            PG8_WAIT_V(6); PG8_BAR; PG8_MMA(1, 1, At, B1); PG8_BAR;
        }
        E(acc, cur, wr, wc, fr, fq); S.done(cur);
        if (!has_next) break;
#pragma unroll
        for (int a = 0; a < 2; ++a)
#pragma unroll
            for (int b = 0; b < 2; ++b)
#pragma unroll
                for (int m = 0; m < 4; ++m)
#pragma unroll
                    for (int n = 0; n < 2; ++n) acc[a][b][m][n] = (f32x4){0.f, 0.f, 0.f, 0.f};
        cur = nxt; cB = nB; ++ui;
#pragma unroll
        for (int _i = 0; _i < 2; ++_i) { va0[_i] = vn0[_i]; va1[_i] = vn1[_i]; }
    }
    PG8_WAIT_V(0);
    if (wr == 0) PG8_BAR;
    PG8_BAR;
#undef PG8_ROWS
#undef PG8_SA
#undef PG8_SB
#undef PG8_STAGE
#undef PG8_LDA
#undef PG8_LDB
#undef PG8_MMA
#undef PG8_WAIT_V
#undef PG8_WAIT_L
#undef PG8_BAR
#undef PG8_SCHED
}
}
namespace fa {
constexpr float SCALE = 0.08838834764831845f;
constexpr float THR = 8.f;
constexpr int D = 128, NW = 8, QBLK = 32, KVBLK = 64, QB = NW * QBLK;
constexpr int SHM_V = KVBLK * D * 2, SHM_K = KVBLK * D * 2;
constexpr int OFF_WS = 2 * SHM_V + 2 * SHM_K, OFF_BIAS = OFF_WS + NW * 64 * 4, LDS_BYTES = OFF_BIAS + 2 * 256;
typedef short s16x4 __attribute__((ext_vector_type(4)));
typedef float f32x16 __attribute__((ext_vector_type(16)));
typedef unsigned u32x4 __attribute__((ext_vector_type(4)));

#define KSWZ(row, colB) ((row) * 256 + ((colB) ^ (((row) & 7) << 4)))
#define SBAR() __builtin_amdgcn_sched_barrier(0)
__device__ __forceinline__ int v_st(int k, int c) { const int kk = (k & ~0xC) | ((k & 4) << 1) | ((k & 8) >> 1); return ((kk >> 3) * 4 + (c >> 5)) * 512 + ((kk & 7) * 32 + (c & 31)) * 2; }
__device__ __forceinline__ int v_rd_base(int lane) { return ((lane & 3) << 3) | (((lane >> 2) & 3) << 6) | (((lane >> 4) & 1) << 5) | (((lane >> 5) & 1) << 8); }
constexpr int v_rd_off(int d0, int ks, int half) { return d0 * 512 + ks * 4096 + half * 2048; }
__device__ __forceinline__ int crow(int r, int hi) { return (r & 3) + 8 * (r >> 2) + 4 * hi; }
__device__ __forceinline__ unsigned cvtpk(float lo, float hi) { unsigned r; asm volatile("v_cvt_pk_bf16_f32 %0, %1, %2" : "=v"(r) : "v"(lo), "v"(hi)); return r; }
__device__ __forceinline__ bf16x8 load8(const bf16* p) { return *reinterpret_cast<const bf16x8*>(p); }
__device__ __forceinline__ void mask_tile(f32x16& p0, f32x16& p1, int dq, unsigned W) {
    const float NEG = -__builtin_inff();
#pragma unroll
    for (int r = 0; r < 16; ++r) {
        const int c = (r & 3) + 8 * (r >> 2);
        if ((unsigned)(dq - c) >= W) p0[r] = NEG;
        if ((unsigned)(dq - c - 32) >= W) p1[r] = NEG;
    }
}
__device__ __forceinline__ void partialSM(f32x16& p0, f32x16& p1, float& m_reg, float& mn, float& alpha) {
    float pmax = p0[0]; for (int r = 1; r < 16; ++r) pmax = fmaxf(pmax, p0[r]); for (int r = 0; r < 16; ++r) pmax = fmaxf(pmax, p1[r]);
    { auto rr = __builtin_amdgcn_permlane32_swap(__float_as_uint(pmax), __float_as_uint(pmax), false, false);
      pmax = fmaxf(__uint_as_float(rr[0]), __uint_as_float(rr[1])); }
    constexpr float C2 = 1.4426950408889634f * SCALE;
    if (__builtin_expect(__all((pmax - m_reg) * SCALE <= THR), 1)) { mn = m_reg; alpha = 1.f; }
    else { mn = fmaxf(m_reg, pmax); alpha = __builtin_amdgcn_exp2f((m_reg - mn) * C2); m_reg = mn; }
    const float mnL = -mn * C2;
    for (int r = 0; r < 16; ++r) p0[r] = fmaf(p0[r], C2, mnL); for (int r = 0; r < 16; ++r) p1[r] = fmaf(p1[r], C2, mnL);
    for (int r = 0; r < 16; ++r) p0[r] = __builtin_amdgcn_exp2f(p0[r]);
}
__device__ __forceinline__ void finishSM(f32x16& p0, f32x16& p1, float alpha, float& l_reg, bf16x8& pa0, bf16x8& pa1, bf16x8& pa2, bf16x8& pa3) {
    for (int r = 0; r < 16; ++r) p1[r] = __builtin_amdgcn_exp2f(p1[r]);
    float ps = 0; for (int r = 0; r < 16; ++r) ps += p0[r]; for (int r = 0; r < 16; ++r) ps += p1[r];
    { auto rr = __builtin_amdgcn_permlane32_swap(__float_as_uint(ps), __float_as_uint(ps), false, false);
      ps = __uint_as_float(rr[0]) + __uint_as_float(rr[1]); }
    l_reg = l_reg * alpha + ps;
#define PK4(P, B_, OUT) do { unsigned a0 = cvtpk(P[B_+0], P[B_+1]), a1 = cvtpk(P[B_+2], P[B_+3]);                          \
        unsigned b0 = cvtpk(P[B_+4], P[B_+5]), b1 = cvtpk(P[B_+6], P[B_+7]);                                             \
        auto r0 = __builtin_amdgcn_permlane32_swap(a0, b0, false, false); auto r1 = __builtin_amdgcn_permlane32_swap(a1, b1, false, false); \
        u32x4 w = {r0[0], r1[0], r0[1], r1[1]}; OUT = *reinterpret_cast<bf16x8*>(&w); } while (0)
    PK4(p0, 0, pa0); PK4(p0, 8, pa1); PK4(p1, 0, pa2); PK4(p1, 8, pa3);
#undef PK4
}
template <int KB, bool BIAS>
__device__ __forceinline__ void qkt(f32x16& p0, f32x16& p1, const char* K_lds, const char* B_lds, int r32, int hi, const bf16x8* qr) {
    if constexpr (BIAS) {
        const f32x4* bl = reinterpret_cast<const f32x4*>(B_lds + KB * 256 + hi * 16);
        const f32x4 a0 = bl[0], a1 = bl[2], a2 = bl[4], a3 = bl[6];
        p0 = (f32x16){a0.x, a0.y, a0.z, a0.w, a1.x, a1.y, a1.z, a1.w, a2.x, a2.y, a2.z, a2.w, a3.x, a3.y, a3.z, a3.w};
        const f32x4 c0 = bl[8], c1 = bl[10], c2 = bl[12], c3 = bl[14];
        p1 = (f32x16){c0.x, c0.y, c0.z, c0.w, c1.x, c1.y, c1.z, c1.w, c2.x, c2.y, c2.z, c2.w, c3.x, c3.y, c3.z, c3.w};
    } else { p0 = f32x16{}; p1 = f32x16{}; }
    const char* kb[4];
#pragma unroll
    for (int dd = 0; dd < 4; ++dd) kb[dd] = K_lds + KB * SHM_K + KSWZ(r32, (dd * 16 + hi * 8) * 2);
#pragma unroll
    for (int d0 = 0; d0 < 8; ++d0) { const char* a = kb[d0 & 3] + (d0 >> 2) * 128;
        bf16x8 b0 = *reinterpret_cast<const bf16x8*>(a);
        bf16x8 b1 = *reinterpret_cast<const bf16x8*>(a + 32 * 256);
        p0 = __builtin_amdgcn_mfma_f32_32x32x16_bf16(b0, qr[d0], p0, 0, 0, 0);
        p1 = __builtin_amdgcn_mfma_f32_32x32x16_bf16(b1, qr[d0], p1, 0, 0, 0); }
}
template <int KB>
__device__ __forceinline__ void add_bias(f32x16& p0, f32x16& p1, const char* B_lds, int hi) {
    const f32x4* bl = reinterpret_cast<const f32x4*>(B_lds + KB * 256 + hi * 16);
#pragma unroll
    for (int g = 0; g < 4; ++g) { const f32x4 a = bl[2 * g], c = bl[8 + 2 * g];
        p0[4 * g + 0] += a.x; p0[4 * g + 1] += a.y; p0[4 * g + 2] += a.z; p0[4 * g + 3] += a.w;
        p1[4 * g + 0] += c.x; p1[4 * g + 1] += c.y; p1[4 * g + 2] += c.z; p1[4 * g + 3] += c.w; }
}
template <int VB>
__device__ __forceinline__ void pv_tile(f32x16* o, int vb0, bf16x8 pa0, bf16x8 pa1, bf16x8 pa2, bf16x8 pa3) {
#define TRRD(dst, off) asm volatile("ds_read_b64_tr_b16 %0, %1 offset:%2" : "=&v"(dst) : "v"(vb0), "i"(off) : "memory")
#define PV_D0(d0) do { s16x4 l0, l1, l2, l3, h0, h1, h2, h3; constexpr int b_ = VB * SHM_V + v_rd_off(d0, 0, 0);   \
        TRRD(l0, b_); TRRD(h0, b_ + 2048); TRRD(l1, b_ + 4096); TRRD(h1, b_ + 6144); TRRD(l2, b_ + 8192); TRRD(h2, b_ + 10240); TRRD(l3, b_ + 12288); TRRD(h3, b_ + 14336); \
        asm volatile("s_waitcnt lgkmcnt(0)" ::: "memory"); SBAR();   \
        o[d0] = __builtin_amdgcn_mfma_f32_32x32x16_bf16(pa0, (bf16x8){l0[0], l0[1], l0[2], l0[3], h0[0], h0[1], h0[2], h0[3]}, o[d0], 0, 0, 0);   \
        o[d0] = __builtin_amdgcn_mfma_f32_32x32x16_bf16(pa1, (bf16x8){l1[0], l1[1], l1[2], l1[3], h1[0], h1[1], h1[2], h1[3]}, o[d0], 0, 0, 0);   \
        o[d0] = __builtin_amdgcn_mfma_f32_32x32x16_bf16(pa2, (bf16x8){l2[0], l2[1], l2[2], l2[3], h2[0], h2[1], h2[2], h2[3]}, o[d0], 0, 0, 0);   \
        o[d0] = __builtin_amdgcn_mfma_f32_32x32x16_bf16(pa3, (bf16x8){l3[0], l3[1], l3[2], l3[3], h3[0], h3[1], h3[2], h3[3]}, o[d0], 0, 0, 0); } while (0)
    PV_D0(0); PV_D0(1); PV_D0(2); PV_D0(3);
#undef PV_D0
#undef TRRD
}

struct BlockRef { const bf16* Q; const bf16* K; const bf16* V; const float* Bk; bf16* O; int P0; };
struct Seam { bf16x8 qr[8]; bf16x8 st_v0, st_v1, st_k0, st_k1; };
__device__ __forceinline__ int swa_jlo(int P0, int W) { const int lowk = P0 - W + 1; return lowk > 0 ? lowk / KVBLK : 0; }

#define ROWK(p, k0, rr) ((p) + (size_t)((k0) + (rr)) * KS + sc)
#define ROWV(p, k0, rr) ((p) + (size_t)((k0) + (rr)) * VS + sc)
#define VMW() asm volatile("s_waitcnt vmcnt(0)" ::: "memory")
#define VMWN(n) asm volatile("s_waitcnt vmcnt(%0)" :: "i"(n) : "memory")
#define SLOAD_H(R_, k0, bfb) do { S.st_v0 = load8(ROWV((R_).V, k0, sr)); S.st_v1 = load8(ROWV((R_).V, k0, 32 + sr));              \
                         S.st_k0 = load8(ROWK((R_).K, k0, sr)); S.st_k1 = load8(ROWK((R_).K, k0, 32 + sr));                  \
                         if constexpr (BIAS) { if (wid == 0) __builtin_amdgcn_global_load_lds((const unsigned*)((R_).Bk + (k0) + lane), (LAS unsigned*)((LAS char*)B_lds + (bfb) * 256), 4, 0, 0); } } while (0)
#define SWRITE_HK(bf) do { *(bf16x8*)(K_lds + (bf) * SHM_K + kws) = S.st_k0; *(bf16x8*)(K_lds + (bf) * SHM_K + kws + 32 * 256) = S.st_k1; } while (0)
#define SWRITE_HV(bf) do { *(bf16x8*)(V_lds + (bf) * SHM_V + vst0) = S.st_v0; *(bf16x8*)(V_lds + (bf) * SHM_V + vst1) = S.st_v1; } while (0)
#define SWRITE_H(bf) do { SWRITE_HV(bf); SWRITE_HK(bf); } while (0)

template <bool BIAS, int QS, int KS, int VS, int OS>
__device__ __forceinline__ void attn_prime(const BlockRef& cur, int W, char* lds, Seam& S) {
    const int tid = threadIdx.x, wid = __builtin_amdgcn_readfirstlane(tid >> 6), lane = tid & 63, r32 = lane & 31, hi = lane >> 5;
    const int sr = tid >> 4, sc = (tid & 15) * 8, kws = KSWZ(sr, sc * 2); char* K_lds = lds + 2 * SHM_V; char* B_lds = lds + OFF_BIAS;
    const int kb0 = swa_jlo(cur.P0, W) * KVBLK;
    for (int d0 = 0; d0 < 8; ++d0) S.qr[d0] = load8(cur.Q + (size_t)(wid * QBLK + r32) * QS + d0 * 16 + hi * 8);
    SLOAD_H(cur, kb0, 0); VMW(); SWRITE_HK(0);
    __syncthreads();
}
template <bool BIAS, int QS, int KS, int VS, int OS>
__device__ __forceinline__ void attn_block(const BlockRef& cur, const BlockRef& nxt, int skv, int W, char* lds, Seam& S) {
    int tid_ = threadIdx.x; asm volatile("" : "+v"(tid_));
    const int tid = tid_, wid = __builtin_amdgcn_readfirstlane(tid >> 6), lane = tid & 63, r32 = lane & 31, hi = lane >> 5;
    const int j_lo = swa_jlo(cur.P0, W);
    int j_hi = (cur.P0 + QB - 1) / KVBLK + 1; if (j_hi > skv / KVBLK) j_hi = skv / KVBLK;
    const int NT = j_hi - j_lo;
    const int kbn = swa_jlo(nxt.P0, W) * KVBLK;
    const int qlo = cur.P0 + wid * QBLK, qm = qlo + r32 - 4 * hi;
    char* V_lds = lds; char* K_lds = lds + 2 * SHM_V; char* B_lds = lds + OFF_BIAS;
    float* ws = (float*)(lds + OFF_WS) + wid * 64; float* li_l = ws, * al_l = ws + 32;
    float m_reg = -1e30f, l_reg = 0; f32x16 o[4] = {};
    const int sr = tid >> 4, sc = (tid & 15) * 8, vst0 = v_st(sr, sc), vst1 = v_st(32 + sr, sc), kws = KSWZ(sr, sc * 2);
    const int vb0 = (int)(uintptr_t)V_lds + v_rd_base(lane);
#define RESC(a) do { if (__any((a) < 1.f)) { if (hi == 0) al_l[r32] = (a); asm volatile("s_waitcnt lgkmcnt(0)" ::: "memory");              \
                     for (int d_ = 0; d_ < 4; ++d_) for (int r = 0; r < 16; ++r) o[d_][r] *= al_l[crow(r, hi)]; } } while (0)
#define KBASE(t) ((j_lo + (t)) * KVBLK)
#define MASKT(P0_, P1_, t, KB_) do { const int kb_ = KBASE(t); if (kb_ + KVBLK - 1 > qlo || kb_ <= qlo + QBLK - 1 - W) mask_tile(P0_, P1_, qm - kb_, (unsigned)W); } while (0)
    constexpr int NQL = 8;
#define SEAM_K0() do { VMWN(NQL); SWRITE_HK(0); SBAR(); } while (0)
    f32x16 pA0, pA1, pB0, pB1; float mnA, mnB, alA, alB; bf16x8 pa0, pa1, pa2, pa3;
    SWRITE_HV(0); SBAR();
    if (NT > 1) { SLOAD_H(cur, KBASE(1), 1); }
    SBAR(); qkt<0, BIAS>(pA0, pA1, K_lds, B_lds, r32, hi, S.qr);
    MASKT(pA0, pA1, 0, 0); partialSM(pA0, pA1, m_reg, mnA, alA);
    if (NT > 1) { VMW(); SWRITE_H(1); }
    __syncthreads();
#define HALF_STEP(PX0, PX1, mnX, alX, PY0, PY1, alY, t, KB, VB, SB) do {                                                      \
        SBAR(); qkt<KB, BIAS>(PX0, PX1, K_lds, B_lds, r32, hi, S.qr);                                                         \
        finishSM(PY0, PY1, alY, l_reg, pa0, pa1, pa2, pa3); SBAR();                                                           \
        if ((t) + 1 < NT) { SLOAD_H(cur, KBASE((t) + 1), SB); SBAR(); }                                                           \
        pv_tile<VB>(o, vb0, pa0, pa1, pa2, pa3); MASKT(PX0, PX1, (t), KB); partialSM(PX0, PX1, m_reg, mnX, alX);                  \
        __syncthreads();                                                                                                      \
        if ((t) + 1 < NT) { VMW(); SWRITE_H(SB); }                                                                            \
        RESC(alX); __syncthreads(); } while (0)
    for (int t = 1; t + 1 < NT; t += 2) {
        HALF_STEP(pB0, pB1, mnB, alB, pA0, pA1, alA, t, 1, 0, 0);
        HALF_STEP(pA0, pA1, mnA, alA, pB0, pB1, alB, t + 1, 0, 1, 1);
    }
    const bool even = (NT & 1) == 0;
    if (even) { SBAR(); qkt<1, BIAS>(pB0, pB1, K_lds, B_lds, r32, hi, S.qr); SBAR(); }
    SLOAD_H(nxt, kbn, 0); SBAR();
#pragma unroll
    for (int d0 = 0; d0 < 8; ++d0) S.qr[d0] = load8(nxt.Q + (size_t)(wid * QBLK + r32) * QS + d0 * 16 + hi * 8);
    SBAR();
    finishSM(pA0, pA1, alA, l_reg, pa0, pa1, pa2, pa3); SBAR();
    pv_tile<0>(o, vb0, pa0, pa1, pa2, pa3);
    if (even) { MASKT(pB0, pB1, NT - 1, 1); partialSM(pB0, pB1, m_reg, mnB, alB); __syncthreads(); RESC(alB);
        finishSM(pB0, pB1, alB, l_reg, pa0, pa1, pa2, pa3); SBAR(); pv_tile<1>(o, vb0, pa0, pa1, pa2, pa3); }
    SBAR(); SEAM_K0();
    if (hi == 0) li_l[r32] = l_reg; asm volatile("s_waitcnt lgkmcnt(0)" ::: "memory");
    float rli[16];
#pragma unroll
    for (int r = 0; r < 16; ++r) rli[r] = __builtin_amdgcn_rcpf(li_l[crow(r, hi)]);
    int tid_e = threadIdx.x; asm volatile("" : "+v"(tid_e)); const int lane_e = tid_e & 63;
    const int r32e = lane_e & 31, hie = lane_e >> 5;
    bf16* Ow = cur.O + (size_t)(wid * QBLK + 4 * hie) * OS + r32e;
#pragma unroll
    for (int r = 0; r < 16; ++r) { const int orow = (r & 3) + 8 * (r >> 2);
#pragma unroll
        for (int d0 = 0; d0 < 4; ++d0) { const float v = o[d0][r] * rli[r];
            const float vn = __shfl_xor(v, 1);
            if ((r32e & 1) == 0) *(unsigned*)(Ow + (size_t)orow * OS + d0 * 32) = cvtpk(v, vn); } }
    __syncthreads();
#undef RESC
#undef KBASE
#undef MASKT
#undef SEAM_K0
#undef HALF_STEP
}
#undef ROWK
#undef ROWV
#undef VMW
#undef VMWN
#undef SLOAD_H
#undef SWRITE_HK
#undef SWRITE_HV
#undef SWRITE_H
#undef KSWZ
#undef SBAR
}
namespace gla {
typedef float f32x16 __attribute__((ext_vector_type(16)));
typedef short s16x4 __attribute__((ext_vector_type(4)));
constexpr int CH = 64, NCH = SEQ / CH, DK = 256, DV = 512, NH = 4;
constexpr int L_QK = 0, QK_BYTES = 32768, NQK = 3;
constexpr int L_VA = NQK * QK_BYTES, VA_BYTES = 25600;
constexpr int LDS_BYTES = L_VA + 2 * VA_BYTES;

__device__ __forceinline__ unsigned swz(unsigned row) { return ((row & 3u) << 2) | ((row >> 2) & 3u); }
__device__ __forceinline__ unsigned off_b(unsigned row, unsigned ch) { return 256u * row + 16u * (ch ^ swz(row)); }
__device__ __forceinline__ unsigned row_read_addr(unsigned lane, unsigned s) { return off_b(lane & 31u, 2u * s + (lane >> 5)); }
__device__ __forceinline__ unsigned tr_read_addr(unsigned lane, unsigned c, unsigned ks, unsigned t) {
    const unsigned h = lane >> 5, blk = (lane >> 4) & 1u, q = (lane & 15u) >> 2, p = lane & 3u;
    return off_b(16u * ks + 8u * h + 4u * t + q, 4u * c + 2u * blk + (p >> 1)) + 8u * (p & 1u);
}
__device__ __forceinline__ unsigned cvtpk(float lo, float hi) { unsigned r; asm volatile("v_cvt_pk_bf16_f32 %0, %1, %2" : "=v"(r) : "v"(lo), "v"(hi)); return r; }
#define GLA_TRRD(dst, addr) asm volatile("ds_read_b64_tr_b16 %0, %1" : "=&v"(dst) : "v"(addr) : "memory")
#define GLA_LWAIT() do { asm volatile("s_waitcnt lgkmcnt(0)" ::: "memory"); __builtin_amdgcn_sched_barrier(0); } while (0)

__device__ __forceinline__ void apass_job(const bf16* QT, const bf16* KT, bf16* AT, int job, int lane) {
    const int tile = job % 3, cc = job / 3, c = cc & (NCH - 1), bh = cc >> 6;
    const int tm = tile ? 1 : 0, tn = tile == 2 ? 1 : 0, r32 = lane & 31, h = lane >> 5;
    const bf16* qrow = QT + ((size_t)bh * SEQ + c * CH + 32 * tm + r32) * DK + 8 * h;
    const bf16* krow = KT + ((size_t)bh * SEQ + c * CH + 32 * tn + r32) * DK + 8 * h;
    f32x16 acc = {};
#pragma unroll
    for (int kb = 0; kb < 4; ++kb) {
        bf16x8 qa[4], ka[4];
#pragma unroll
        for (int k = 0; k < 4; ++k) { qa[k] = *(const bf16x8*)(qrow + 16 * (4 * kb + k)); ka[k] = *(const bf16x8*)(krow + 16 * (4 * kb + k)); }
#pragma unroll
        for (int k = 0; k < 4; ++k) acc = __builtin_amdgcn_mfma_f32_32x32x16_bf16(ka[k], qa[k], acc, 0, 0, 0);
    }
    const int t = 32 * tm + r32;
    bf16* dst = AT + (((size_t)bh * NCH + c) * CH + t) * CH + 32 * tn + 4 * h;
#pragma unroll
    for (int g = 0; g < 4; ++g) {
        const int s0 = 32 * tn + 8 * g + 4 * h;
        float v[4];
#pragma unroll
        for (int e = 0; e < 4; ++e) v[e] = (s0 + e <= t) ? acc[4 * g + e] : 0.f;
        *(v2u*)(dst + 8 * g) = (v2u){cvtpk(v[0], v[1]), cvtpk(v[2], v[3])};
    }
}

struct ScanRef { const bf16* QT; const bf16* KT; const bf16* VG; const bf16* AT; const float* EBL; float* O; };

__device__ __forceinline__ void dma_qk(const ScanRef& R, LAS unsigned char* lds, int n, int nb, int hw, int lane_) {
    int lane = lane_; asm volatile("" : "+v"(lane));
    const int c = n >> 1, hh = n & 1; LAS unsigned char* buf = lds + L_QK + nb * QK_BYTES;
#pragma unroll
    for (int i = 0; i < 8; ++i) {
        const int j = i * 4 + hw;
        const int img = j >> 3, j8 = j & 7, row = 4 * j8 + (lane >> 4), ch = (lane & 15) ^ (int)swz((unsigned)row);
        const bf16* src = ((img >> 1) ? R.KT : R.QT) + ((size_t)(c * CH + 32 * (img & 1) + row)) * DK + 128 * hh + 8 * ch;
        __builtin_amdgcn_global_load_lds((const unsigned*)src, (LAS unsigned*)(buf + img * 8192 + j8 * 1024), 16, 0, 0);
    }
}
__device__ __forceinline__ void dma_va(const ScanRef& R, LAS unsigned char* lds, int c, int hw, int lane_) {
    int lane = lane_; asm volatile("" : "+v"(lane));
    LAS unsigned char* buf = lds + L_VA + (c & 1) * VA_BYTES;
#pragma unroll
    for (int i = 0; i < 7; ++i) {
        const int j = i * 4 + hw;
        const int j8 = j & 7, row = 4 * j8 + (lane >> 4), ch = (lane & 15) ^ (int)swz((unsigned)row);
        if (j < 16) {
            const bf16* src = R.VG + ((size_t)(c * CH + 32 * (j >> 3) + row)) * DV + 8 * ch;
            __builtin_amdgcn_global_load_lds((const unsigned*)src, (LAS unsigned*)(buf + (j >> 3) * 8192 + j8 * 1024), 16, 0, 0);
        } else if (j < 24) {
            const int t = row + 32 * (ch >> 3), s0 = 8 * (ch & 7);
            const bf16* src = R.AT + ((size_t)c * CH + t) * CH + s0;
            __builtin_amdgcn_global_load_lds((const unsigned*)src, (LAS unsigned*)(buf + 16384 + j8 * 1024), 16, 0, 0);
        } else {
            const float* src = R.EBL + (size_t)c * DK + 4 * lane;
            __builtin_amdgcn_global_load_lds((const unsigned*)src, (LAS unsigned*)(buf + 24576), 16, 0, 0);
        }
    }
}

__device__ __forceinline__ unsigned vxor(unsigned a, const unsigned k) { unsigned r; asm volatile("v_xor_b32 %0, %1, %2" : "=v"(r) : "i"(k), "v"(a)); return r; }
#define GLA_TRRDO(dst, addr, off) asm volatile("ds_read_b64_tr_b16 %0, %1 offset:%2" : "=&v"(dst) : "v"(addr), "i"(off) : "memory")
#define GLA_LWAITN(n) do { asm volatile("s_waitcnt lgkmcnt(" #n ")" ::: "memory"); __builtin_amdgcn_sched_barrier(0); } while (0)
template <int HH>
__device__ __forceinline__ void scan_half(f32x16 (&S)[8], f32x16 (&acc)[2], bf16x8 (&vf)[4], unsigned qk, unsigned va, int w, float* Orow) {
    int t_ = threadIdx.x; asm volatile("" : "+v"(t_));
    const unsigned lane = (unsigned)t_ & 63u, r32 = lane & 31u, h = lane >> 5, blk = (lane >> 4) & 1u, q = (lane & 15u) >> 2, p = lane & 3u;
    const unsigned sw = swz(r32);
    const unsigned qbase = 256u * r32 + (sw << 4) + 8u * h + qk;
    const unsigned abase = (256u * r32 + (sw << 4)) ^ (h << 4);
    const unsigned tr0 = 256u * (8u * h + q) + 8u * (p & 1u) + 16u * ((2u * blk + (p >> 1)) ^ (2u * h)) + 64u * q;
    const unsigned tr1 = 256u * (8u * h + 4u + q) + 8u * (p & 1u) + 16u * ((2u * blk + (p >> 1)) ^ (2u * h + 1u)) + 64u * q;
    const unsigned kb0 = tr0 + qk + 16384u, kb1 = tr1 + qk + 16384u;
    s16x4 loA[4], hiA[4];
#define GLA_LOADK(il, lo, hi) do { const unsigned k0_ = vxor(kb0, (unsigned)((il) << 6)), k1_ = vxor(kb1, (unsigned)((il) << 6)); \
        _Pragma("unroll") for (int kk = 0; kk < 4; ++kk) { GLA_TRRDO(lo[kk], k0_, (kk >> 1) * 8192 + (kk & 1) * 4096); GLA_TRRDO(hi[kk], k1_, (kk >> 1) * 8192 + (kk & 1) * 4096); } } while (0)
#define GLA_MMAK(il, lo, hi) do { f32x16& X = S[4 * HH + (il)]; \
        _Pragma("unroll") for (int kk = 0; kk < 4; ++kk) X = __builtin_amdgcn_mfma_f32_32x32x16_bf16((bf16x8){lo[kk][0], lo[kk][1], lo[kk][2], lo[kk][3], hi[kk][0], hi[kk][1], hi[kk][2], hi[kk][3]}, vf[kk], X, 0, 0, 0); } while (0)
#define GLA_SCALE(il) do { f32x16& X = S[4 * HH + (il)]; \
        const LAS float* eb = (const LAS float*)(uintptr_t)(va + 24576u + 4u * (32u * (4 * HH + (il)) + 4u * h)); \
        _Pragma("unroll") for (int g = 0; g < 4; ++g) { const f32x4 e = *(const LAS f32x4*)(eb + 8 * g); X[4 * g + 0] *= e.x; X[4 * g + 1] *= e.y; X[4 * g + 2] *= e.z; X[4 * g + 3] *= e.w; } } while (0)
    if constexpr (HH == 0) {
        const unsigned v0 = (tr0 ^ ((unsigned)w << 6)) + va, v1 = (tr1 ^ ((unsigned)w << 6)) + va;
        s16x4 lo[4], hi[4];
#pragma unroll
        for (int kk = 0; kk < 4; ++kk) { GLA_TRRDO(lo[kk], v0, (kk >> 1) * 8192 + (kk & 1) * 4096); GLA_TRRDO(hi[kk], v1, (kk >> 1) * 8192 + (kk & 1) * 4096); }
        GLA_LWAITN(0);
#pragma unroll
        for (int kk = 0; kk < 4; ++kk) vf[kk] = (bf16x8){lo[kk][0], lo[kk][1], lo[kk][2], lo[kk][3], hi[kk][0], hi[kk][1], hi[kk][2], hi[kk][3]};
        acc[0] = f32x16{}; acc[1] = f32x16{};
        const unsigned ab = abase + va + 16384u;
#pragma unroll
        for (int m = 0; m < 2; ++m)
#pragma unroll
            for (int kk = 0; kk < 2 + 2 * m; ++kk) { const bf16x8 a = *(const LAS bf16x8*)(uintptr_t)vxor(ab, (unsigned)((4 * m + kk) << 5)); acc[m] = __builtin_amdgcn_mfma_f32_32x32x16_bf16(a, vf[kk], acc[m], 0, 0, 0); }
    }
    GLA_LOADK(0, loA, hiA);
#pragma unroll
    for (int il = 0; il < 4; ++il) {
        const f32x16& X = S[4 * HH + il];
#pragma unroll
        for (int s2 = 0; s2 < 2; ++s2) {
            const v4u bw = {cvtpk(X[8 * s2 + 0], X[8 * s2 + 1]), cvtpk(X[8 * s2 + 2], X[8 * s2 + 3]), cvtpk(X[8 * s2 + 4], X[8 * s2 + 5]), cvtpk(X[8 * s2 + 6], X[8 * s2 + 7])};
            const bf16x8 bfr = __builtin_bit_cast(bf16x8, bw);
            const unsigned a0 = vxor(qbase, (unsigned)((4 * il + 2 * s2) << 4)), a1 = vxor(qbase, (unsigned)((4 * il + 2 * s2 + 1) << 4));
#pragma unroll
            for (int m = 0; m < 2; ++m) {
                const v2u p0 = *(const LAS v2u*)(uintptr_t)(a0 + m * 8192), p1 = *(const LAS v2u*)(uintptr_t)(a1 + m * 8192);
                const v4u aw = {p0.x, p0.y, p1.x, p1.y};
                acc[m] = __builtin_amdgcn_mfma_f32_32x32x16_bf16(__builtin_bit_cast(bf16x8, aw), bfr, acc[m], 0, 0, 0);
            }
        }
    }
    if constexpr (HH == 1) {
        float* ob = Orow + (size_t)(4u * h) * DM + 32 * w + r32;
#pragma unroll
        for (int m = 0; m < 2; ++m)
#pragma unroll
            for (int r = 0; r < 16; ++r) ob[(size_t)(32 * m + (r & 3) + 8 * (r >> 2)) * DM] = acc[m][r];
    }
    GLA_LWAITN(0); GLA_MMAK(0, loA, hiA); __builtin_amdgcn_sched_barrier(0); GLA_LOADK(1, loA, hiA); GLA_SCALE(0);
    GLA_LWAITN(0); GLA_MMAK(1, loA, hiA); __builtin_amdgcn_sched_barrier(0); GLA_LOADK(2, loA, hiA); GLA_SCALE(1);
    GLA_LWAITN(0); GLA_MMAK(2, loA, hiA); __builtin_amdgcn_sched_barrier(0); GLA_LOADK(3, loA, hiA); GLA_SCALE(2);
    GLA_LWAITN(0); GLA_MMAK(3, loA, hiA); GLA_SCALE(3);
#undef GLA_LOADK
#undef GLA_MMAK
#undef GLA_SCALE
}

__device__ __forceinline__ void scan_item(const ScanRef& R, LAS unsigned char* lds) {
    int tid_ = threadIdx.x; asm volatile("" : "+v"(tid_));
    const int tid = tid_, wid = __builtin_amdgcn_readfirstlane(tid >> 6), lane = tid & 63;
    __syncthreads();
#define GLA_BAR() do { asm volatile("s_waitcnt lgkmcnt(0)" ::: "memory"); __builtin_amdgcn_s_barrier(); asm volatile("" ::: "memory"); } while (0)
    if (wid >= 4) {
        const int hw = wid & 3; int nb = 0;
        dma_qk(R, lds, 0, 0, hw, lane); dma_qk(R, lds, 1, 1, hw, lane); dma_va(R, lds, 0, hw, lane); asm volatile("s_waitcnt vmcnt(0)" ::: "memory");
        for (int c = 0; c < NCH; ++c) {
            GLA_BAR();
            { const int nb2 = nb >= 1 ? nb - 1 : 2;
              if (c + 1 < NCH) { dma_qk(R, lds, 2 * c + 2, nb2, hw, lane); dma_va(R, lds, c + 1, hw, lane); asm volatile("s_waitcnt vmcnt(15)" ::: "memory"); }
              else asm volatile("s_waitcnt vmcnt(0)" ::: "memory"); }
            nb = nb == 2 ? 0 : nb + 1;
            GLA_BAR();
            { const int nb2 = nb >= 1 ? nb - 1 : 2;
              if (c + 1 < NCH) { dma_qk(R, lds, 2 * c + 3, nb2, hw, lane); asm volatile("s_waitcnt vmcnt(8)" ::: "memory"); }
              else asm volatile("s_waitcnt vmcnt(0)" ::: "memory"); }
            nb = nb == 2 ? 0 : nb + 1;
        }
        GLA_BAR();
    } else {
        f32x16 S[8]; f32x16 acc[2]; bf16x8 vf[4]; int nb = 0;
#pragma unroll
        for (int i = 0; i < 8; ++i) S[i] = f32x16{};
        acc[0] = f32x16{}; acc[1] = f32x16{};
#pragma unroll
        for (int i = 0; i < 4; ++i) vf[i] = bf16x8{};
        for (int c = 0; c < NCH; ++c) {
            const unsigned va = (unsigned)(L_VA + (c & 1) * VA_BYTES);
            GLA_BAR();
            scan_half<0>(S, acc, vf, (unsigned)(L_QK + nb * QK_BYTES), va, wid, R.O + (size_t)c * CH * DM);
            nb = nb == 2 ? 0 : nb + 1;
            GLA_BAR();
            scan_half<1>(S, acc, vf, (unsigned)(L_QK + nb * QK_BYTES), va, wid, R.O + (size_t)c * CH * DM);
            nb = nb == 2 ? 0 : nb + 1;
        }
        GLA_BAR();
    }
#undef GLA_BAR
}
#undef GLA_TRRD
#undef GLA_TRRDO
#undef GLA_LWAIT
#undef GLA_LWAITN
}
constexpr int NWAVES = 8;
constexpr int LDS_BYTES = 163840;
constexpr int RING_BYTES = 131072;
constexpr int CTLW = 159744;

constexpr size_t MiB = (size_t)1 << 20;
constexpr size_t WS_CTL = 0, CTL_BYTES = 1 * MiB;
constexpr size_t WS_WTIN = CTL_BYTES;
constexpr size_t WS_WTBG = WS_WTIN + (size_t)INCP * DM * 2;
constexpr size_t WS_WTBF = WS_WTBG + (size_t)DM * DM * 2;
constexpr size_t WS_WTOUT = WS_WTBF + (size_t)DM * DM * 2;
constexpr size_t WS_WTMQ = WS_WTOUT + (size_t)DM * DM * 2;
constexpr size_t WS_WTMKV = WS_WTMQ + (size_t)512 * DM * 2;
constexpr size_t WS_WTMO = WS_WTMKV + (size_t)1024 * DM * 2;
constexpr size_t WS_WTUP = WS_WTMO + (size_t)DM * 512 * 2;
constexpr size_t WS_WTDN = WS_WTUP + (size_t)NE * 4096 * DM * 2;
constexpr size_t WS_WRT = WS_WTDN + (size_t)NE * DM * DM * 2;
constexpr size_t WS_QT = WS_WRT + (size_t)256 * DM * 2;
constexpr size_t WS_KT = WS_QT + (size_t)T * 1024 * 2;
constexpr size_t WS_VG = WS_KT + (size_t)T * 1024 * 2;
constexpr size_t WS_SG = WS_VG + (size_t)T * DM * 2;
constexpr size_t WS_FQH = WS_SG + (size_t)T * DM * 2;
constexpr size_t WS_FKH = WS_FQH + (size_t)T * DM * 2;
constexpr size_t WS_FVH = WS_FKH + (size_t)T * DM * 2;
constexpr size_t WS_GG = WS_FVH + (size_t)T * DM * 2;
constexpr size_t WS_GF = WS_GG + (size_t)T * DM * 2;
constexpr size_t WS_YB = WS_QT;
static_assert(WS_GF + (size_t)T * DM * 2 - WS_QT >= (size_t)PMAX * DM * 2, "YB overlay");
constexpr size_t WS_OGLA = WS_GF + (size_t)T * DM * 2;
constexpr size_t WS_Y2 = WS_OGLA + (size_t)T * DM * 4;
constexpr size_t WS_H = WS_Y2 + (size_t)T * DM * 4;
constexpr size_t WS_ACT = WS_OGLA;
static_assert(WS_H + (size_t)T * DM * 2 - WS_OGLA >= (size_t)PMAX * DM * 2, "ACT overlay");
constexpr size_t WS_Y1 = WS_H + (size_t)T * DM * 2;
constexpr size_t WS_X1 = WS_Y1 + (size_t)T * DM * 4;
constexpr size_t WS_X2 = WS_X1 + (size_t)T * DM * 4;
constexpr size_t WS_ATT = WS_X2 + (size_t)T * DM * 4;
constexpr size_t WS_ON = WS_ATT + (size_t)T * DM * 2;
constexpr size_t WS_MRG = WS_ON + (size_t)T * DM * 2;
constexpr size_t WS_H2 = WS_MRG + (size_t)T * DM * 2;
constexpr size_t WS_XS = WS_H2 + (size_t)T * DM * 2;
constexpr size_t WS_OM = WS_XS + (size_t)T * DM * 2;
constexpr size_t WS_MN = WS_OM + (size_t)T * 512 * 2;
constexpr size_t WS_QM = WS_MN + (size_t)1024 * DM * 2;
constexpr size_t WS_KV = WS_QM + (size_t)T * 1024 * 4;
constexpr size_t WS_ASG = WS_KV + (size_t)1024 * 4096 * 4;
constexpr size_t WS_TOKL = WS_ASG + (size_t)NASG * 8;
constexpr size_t WS_WL = WS_TOKL + (size_t)NE * T * 4;
constexpr size_t WS_RSL = WS_WL + (size_t)NE * T * 4;
constexpr size_t WS_RSS1 = WS_RSL + (size_t)NE * T * 4;
constexpr size_t WS_RSS2 = WS_RSS1 + (size_t)T * 32 * 4;
constexpr size_t WS_LOG = WS_RSS2 + (size_t)T * 32 * 4;
constexpr size_t WS_EBL = WS_LOG + (size_t)T * 128 * 4;
constexpr size_t WS_AT = WS_EBL + (size_t)16 * 64 * 256 * 4;
constexpr size_t WS_GAFF = WS_AT + (size_t)16 * 64 * 64 * 64 * 2;
constexpr size_t WS_CB = WS_GAFF + (size_t)T * 128 * 4;
constexpr size_t WS_QMB = WS_CB + (size_t)NB * 16 * SEQ * 4;
constexpr size_t WS_KNB = WS_QMB + (size_t)T * 512 * 2;
constexpr size_t WS_VB = WS_KNB + (size_t)NB * 4 * MEML * 128 * 2;
constexpr size_t WS_END = WS_VB + (size_t)NB * 4 * MEML * 128 * 2;
constexpr int CW_CNT = 0, CW_NT = 64, CW_FOXQ = 128  , CW_GLA = 1024  , CW_BAR = 4096;

struct Args { const float* in[27]; float* out; unsigned char* ws; int ph_lo, ph_hi; };
struct Frame { LAS unsigned char* lds; int tid, lane, wave, G, bid, gw, ngw; };

__device__ __forceinline__ void p0_transpose_item(const float* W, int K, int N, bf16* WT, LAS float* scr, int item, int lane) {
    const int nblk = N / 32, kb = item / nblk, nb = item % nblk, k0 = 64 * kb, n0 = 32 * nb;
#pragma unroll 8
    for (int i = 0; i < 32; ++i) { const int kk = 2 * i + (lane >> 5); scr[kk * 33 + (lane & 31)] = W[(size_t)(k0 + kk) * N + n0 + (lane & 31)]; }
    LDS_WAIT(); asm volatile("" ::: "memory");
    const int c = lane & 7;
#pragma unroll
    for (int j = 0; j < 4; ++j) { const int n = (lane >> 3) + 8 * j; const LAS float* s = scr + (8 * c) * 33 + n;
        v4u o; o.x = pk2(s[0 * 33], s[1 * 33]); o.y = pk2(s[2 * 33], s[3 * 33]); o.z = pk2(s[4 * 33], s[5 * 33]); o.w = pk2(s[6 * 33], s[7 * 33]);
        *(v4u*)(WT + (size_t)(n0 + n) * K + k0 + 8 * c) = o; }
    LDS_WAIT(); asm volatile("" ::: "memory");
}
__device__ __forceinline__ void transpose_job(Frame& F, const float* W, int K, int N, int batch, bf16* WT) {
    LAS float* scr = (LAS float*)(F.lds + F.wave * 16384);
    const int per = (K / 64) * (N / 32); const long total = (long)per * batch;
    for (long it = F.gw; it < total; it += F.ngw) { const int e = (int)(it / per), r = (int)(it % per);
        p0_transpose_item(W + (size_t)e * K * N, K, N, WT + (size_t)e * N * K, scr, r, F.lane); }
}
__device__ __forceinline__ void rms_row_bf16(const float* xrow, const float* g, bf16* orow, int lane) {
    const f32x4* xr = (const f32x4*)xrow + lane; const f32x4* gr = (const f32x4*)g + lane;
    f32x4 v[8]; float s = 0.f;
#pragma unroll
    for (int j = 0; j < 8; ++j) { v[j] = xr[64 * j]; s += (v[j].x * v[j].x + v[j].y * v[j].y) + (v[j].z * v[j].z + v[j].w * v[j].w); }
    const float r = 1.0f / sqrtf(wave_sum(s) * (1.f / DM) + EPS);
    v2u* o8 = (v2u*)orow + lane;
#pragma unroll
    for (int j = 0; j < 8; ++j) { const f32x4 gg = gr[64 * j]; v2u w; w.x = pk2(v[j].x * r * gg.x, v[j].y * r * gg.y); w.y = pk2(v[j].z * r * gg.z, v[j].w * r * gg.w); o8[64 * j] = w; }
}

__device__ __forceinline__ void rms_rows2_bf16(const float* xa, const float* xb, const float* g, bf16* oa, bf16* ob, int lane) {
    const f32x4* pa = (const f32x4*)xa + lane; const f32x4* pb = (const f32x4*)xb + lane; const f32x4* gr = (const f32x4*)g + lane;
    f32x4 va[8], vb[8]; float sa = 0.f, sb = 0.f;
#pragma unroll
    for (int j = 0; j < 8; ++j) va[j] = __builtin_nontemporal_load(pa + 64 * j);
#pragma unroll
    for (int j = 0; j < 8; ++j) vb[j] = __builtin_nontemporal_load(pb + 64 * j);
#pragma unroll
    for (int j = 0; j < 8; ++j) { sa += (va[j].x * va[j].x + va[j].y * va[j].y) + (va[j].z * va[j].z + va[j].w * va[j].w); sb += (vb[j].x * vb[j].x + vb[j].y * vb[j].y) + (vb[j].z * vb[j].z + vb[j].w * vb[j].w); }
    const float ra = __builtin_amdgcn_rsqf(wave_sum(sa) * (1.f / DM) + EPS), rb = __builtin_amdgcn_rsqf(wave_sum(sb) * (1.f / DM) + EPS);
    v2u* o8a = (v2u*)oa + lane; v2u* o8b = (v2u*)ob + lane;
#pragma unroll
    for (int j = 0; j < 8; ++j) { const f32x4 gg = gr[64 * j];
        __builtin_nontemporal_store((v2u){pk2(va[j].x * ra * gg.x, va[j].y * ra * gg.y), pk2(va[j].z * ra * gg.z, va[j].w * ra * gg.w)}, o8a + 64 * j);
        __builtin_nontemporal_store((v2u){pk2(vb[j].x * rb * gg.x, vb[j].y * rb * gg.y), pk2(vb[j].z * rb * gg.z, vb[j].w * rb * gg.w)}, o8b + 64 * j); }
}

__device__ __forceinline__ void naive_attn_row(const float* qrow, const float* Kb, size_t kstride, const float* Vb, size_t vstride, const float* cb, float ct, int nk, float scale,
                                               int lane, float& o0, float& o1) {
    const f32x2 q = *(const f32x2*)(qrow + 2 * lane);
    float m = -1e30f, l = 0.f, a0 = 0.f, a1 = 0.f;
#pragma unroll 4
    for (int s = 0; s < nk; ++s) {
        const f32x2 kk = *(const f32x2*)(Kb + (size_t)s * kstride + 2 * lane);
        const f32x2 vv = *(const f32x2*)(Vb + (size_t)s * vstride + 2 * lane);
        float d = wave_sum(q.x * kk.x + q.y * kk.y) * scale;
        if (cb) d += ct - cb[s];
        const float mn = fmaxf(m, d), alpha = __expf(m - mn), p = __expf(d - mn);
        l = l * alpha + p; a0 = a0 * alpha + p * vv.x; a1 = a1 * alpha + p * vv.y; m = mn;
    }
    o0 = a0 / l; o1 = a1 / l;
}

__device__ __forceinline__ int win_row(int n) { return n < 6144 ? n : n < 6160 ? 16384 + (n - 6144) : n < 12304 ? n - 16 : n < 12320 ? 16400 + (n - 12304) : n - 32; }
__device__ __forceinline__ void transpose_win(Frame& F, const float* W, bf16* WT) {
    LAS float* scr = (LAS float*)(F.lds + F.wave * 16384);
    constexpr int K = DM, N = INC, total = (K / 64) * 2;
    for (int it = F.gw; it < total; it += F.ngw) {
        const int kb = it >> 1, k0 = 64 * kb, n0 = (it & 1) ? 12304 : 6144, lane = F.lane;
#pragma unroll 8
        for (int i = 0; i < 16; ++i) { const int kk = 4 * i + (lane >> 4); scr[kk * 17 + (lane & 15)] = W[(size_t)(k0 + kk) * N + n0 + (lane & 15)]; }
        LDS_WAIT(); asm volatile("" ::: "memory");
        const int c = lane & 7, r0 = win_row(n0);
#pragma unroll
        for (int j = 0; j < 2; ++j) { const int n = (lane >> 3) + 8 * j; const LAS float* sp = scr + (8 * c) * 17 + n;
            v4u o; o.x = pk2(sp[0 * 17], sp[1 * 17]); o.y = pk2(sp[2 * 17], sp[3 * 17]); o.z = pk2(sp[4 * 17], sp[5 * 17]); o.w = pk2(sp[6 * 17], sp[7 * 17]);
            *(v4u*)(WT + (size_t)(r0 + n) * K + k0 + 8 * c) = o; }
        LDS_WAIT(); asm volatile("" ::: "memory");
    }
}
__device__ __forceinline__ void transpose_win64(LAS unsigned char* lds, const float* W, bf16* WT, int gw, int ngw) {
    int t_ = threadIdx.x; asm volatile("" : "+v"(t_));
    const int wid = __builtin_amdgcn_readfirstlane(t_ >> 6), lane = t_ & 63;
    LAS unsigned char* tile = lds + wid * 19456;
    const unsigned tbase = (unsigned)(size_t)tile;
    const int lr = lane >> 4, lc = lane & 15, g = lane >> 4, q = (lane & 15) >> 2, p = lane & 3;
    const unsigned wr_off = (unsigned)(lr * 160 + lc * 8), tr_off = (unsigned)(q * 160 + (g * 16 + 4 * p) * 2);
    const unsigned ldo = (unsigned)(lr * INC * 4 + lc * 16), sto = (unsigned)((lane >> 3) * (DM * 2) + (lane & 7) * 16);
    constexpr int total = (DM / 64) * 256; constexpr unsigned rs = 4u * INC * 4u;
#define TW_SRC(it_, sp_, dp_) do { const int kb_ = (it_) >> 8, d0_ = 64 * ((it_) & 255), n0_ = d0_ + (d0_ < 6144 ? 0 : d0_ < 12288 ? 16 : 32); \
        sp_ = (const char*)W + ((size_t)(64 * kb_) * INC + n0_) * 4; dp_ = (char*)WT + ((size_t)d0_ * DM + 64 * kb_) * 2; } while (0)
#define TW_LOAD(R_, sp_) do { _Pragma("unroll") for (int i = 0; i < 16; ++i) R_[i] = __builtin_nontemporal_load((const f32x4*)(sp_ + (ldo + (unsigned)i * rs))); } while (0)
#define TW_PROC(R_, dp_) do { \
        _Pragma("unroll") for (int i = 0; i < 16; ++i) { const v2u w = {pk2(R_[i].x, R_[i].y), pk2(R_[i].z, R_[i].w)}; *(LAS v2u*)(tile + wr_off + i * 640) = w; } \
        asm volatile("s_waitcnt lgkmcnt(0)" ::: "memory"); \
        _Pragma("unroll") for (int hb_ = 0; hb_ < 2; ++hb_) { v2u ta_[4], tb_[4]; \
            _Pragma("unroll") for (int jj = 0; jj < 4; ++jj) { \
                asm volatile("ds_read_b64_tr_b16 %0, %1 offset:%2" : "=&v"(ta_[jj]) : "v"(tbase + tr_off), "i"((4 * hb_ + jj) * 1280) : "memory"); \
                asm volatile("ds_read_b64_tr_b16 %0, %1 offset:%2" : "=&v"(tb_[jj]) : "v"(tbase + tr_off), "i"((4 * hb_ + jj) * 1280 + 640) : "memory"); } \
            asm volatile("s_waitcnt lgkmcnt(0)" : "+v"(ta_[0]), "+v"(ta_[1]), "+v"(ta_[2]), "+v"(ta_[3]), "+v"(tb_[0]), "+v"(tb_[1]), "+v"(tb_[2]), "+v"(tb_[3]) :: "memory"); \
            _Pragma("unroll") for (int jj = 0; jj < 4; ++jj) *(LAS v4u*)(tile + 10240 + lane * 144 + (4 * hb_ + jj) * 16) = (v4u){ta_[jj].x, ta_[jj].y, tb_[jj].x, tb_[jj].y}; } \
        asm volatile("s_waitcnt lgkmcnt(0)" ::: "memory"); \
        _Pragma("unroll") for (int hf_ = 0; hf_ < 2; ++hf_) { v4u ow_[4]; \
            _Pragma("unroll") for (int s_ = 0; s_ < 4; ++s_) ow_[s_] = *(const LAS v4u*)(tile + 10240 + (8 * (4 * hf_ + s_) + (lane >> 3)) * 144 + (lane & 7) * 16); \
            _Pragma("unroll") for (int s_ = 0; s_ < 4; ++s_) __builtin_nontemporal_store(ow_[s_], (v4u*)(dp_ + (sto + (unsigned)(8 * (4 * hf_ + s_)) * (unsigned)(DM * 2)))); \
            asm volatile("" ::: "memory"); } \
        asm volatile("s_waitcnt lgkmcnt(0)" ::: "memory"); } while (0)
    f32x4 RA[16], RB[16]; const char* sA; const char* sB; char* dA; char* dB;
    int it = gw;
    if (it < total) { TW_SRC(it, sA, dA); TW_LOAD(RA, sA); }
    while (it < total) {
        const int i1 = it + ngw, i2 = it + 2 * ngw;
        if (i1 < total) { TW_SRC(i1, sB, dB); TW_LOAD(RB, sB); }
        TW_PROC(RA, dA);
        if (i1 >= total) break;
        if (i2 < total) { TW_SRC(i2, sA, dA); TW_LOAD(RA, sA); }
        TW_PROC(RB, dB);
        it = i2;
    }
#undef TW_SRC
#undef TW_LOAD
#undef TW_PROC
}
__device__ __forceinline__ void transpose64(LAS unsigned char* lds, const float* W, int K, int N, bf16* WT, int gw, int ngw) {
    int t_ = threadIdx.x; asm volatile("" : "+v"(t_));
    const int wid = __builtin_amdgcn_readfirstlane(t_ >> 6), lane = t_ & 63;
    LAS unsigned char* tile = lds + wid * 19456;
    const unsigned tbase = (unsigned)(size_t)tile;
    const int lr = lane >> 4, lc = lane & 15, g = lane >> 4, q = (lane & 15) >> 2, p = lane & 3;
    const unsigned wr_off = (unsigned)(lr * 160 + lc * 8), tr_off = (unsigned)(q * 160 + (g * 16 + 4 * p) * 2);
    const unsigned ldo = (unsigned)(lr * N * 4 + lc * 16), sto = (unsigned)((lane >> 3) * (K * 2) + (lane & 7) * 16), rs = 16u * (unsigned)N, ds8 = 8u * (unsigned)(K * 2);
    const int nbk = N >> 6, total = (K >> 6) * nbk;
#define TG_SRC(it_, sp_, dp_) do { const int kb_ = (it_) / nbk, nb_ = (it_) - kb_ * nbk; \
        sp_ = (const char*)W + ((size_t)(64 * kb_) * N + 64 * nb_) * 4; dp_ = (char*)WT + ((size_t)(64 * nb_) * K + 64 * kb_) * 2; } while (0)
#define TG_LOAD(R_, sp_) do { _Pragma("unroll") for (int i = 0; i < 16; ++i) R_[i] = __builtin_nontemporal_load((const f32x4*)(sp_ + (ldo + (unsigned)i * rs))); } while (0)
#define TG_PROC(R_, dp_) do { \
        _Pragma("unroll") for (int i = 0; i < 16; ++i) { const v2u w = {pk2(R_[i].x, R_[i].y), pk2(R_[i].z, R_[i].w)}; *(LAS v2u*)(tile + wr_off + i * 640) = w; } \
        asm volatile("s_waitcnt lgkmcnt(0)" ::: "memory"); \
        _Pragma("unroll") for (int hb_ = 0; hb_ < 2; ++hb_) { v2u ta_[4], tb_[4]; \
            _Pragma("unroll") for (int jj = 0; jj < 4; ++jj) { \
                asm volatile("ds_read_b64_tr_b16 %0, %1 offset:%2" : "=&v"(ta_[jj]) : "v"(tbase + tr_off), "i"((4 * hb_ + jj) * 1280) : "memory"); \
                asm volatile("ds_read_b64_tr_b16 %0, %1 offset:%2" : "=&v"(tb_[jj]) : "v"(tbase + tr_off), "i"((4 * hb_ + jj) * 1280 + 640) : "memory"); } \
            asm volatile("s_waitcnt lgkmcnt(0)" : "+v"(ta_[0]), "+v"(ta_[1]), "+v"(ta_[2]), "+v"(ta_[3]), "+v"(tb_[0]), "+v"(tb_[1]), "+v"(tb_[2]), "+v"(tb_[3]) :: "memory"); \
            _Pragma("unroll") for (int jj = 0; jj < 4; ++jj) *(LAS v4u*)(tile + 10240 + lane * 144 + (4 * hb_ + jj) * 16) = (v4u){ta_[jj].x, ta_[jj].y, tb_[jj].x, tb_[jj].y}; } \
        asm volatile("s_waitcnt lgkmcnt(0)" ::: "memory"); \
        _Pragma("unroll") for (int hf_ = 0; hf_ < 2; ++hf_) { v4u ow_[4]; \
            _Pragma("unroll") for (int s_ = 0; s_ < 4; ++s_) ow_[s_] = *(const LAS v4u*)(tile + 10240 + (8 * (4 * hf_ + s_) + (lane >> 3)) * 144 + (lane & 7) * 16); \
            _Pragma("unroll") for (int s_ = 0; s_ < 4; ++s_) *(v4u*)(dp_ + (sto + (unsigned)(4 * hf_ + s_) * ds8)) = ow_[s_]; \
            asm volatile("" ::: "memory"); } \
        asm volatile("s_waitcnt lgkmcnt(0)" ::: "memory"); } while (0)
    f32x4 RA[16], RB[16]; const char* sA; const char* sB; char* dA; char* dB;
    int it = gw;
    if (it < total) { TG_SRC(it, sA, dA); TG_LOAD(RA, sA); }
    while (it < total) {
        const int i1 = it + ngw, i2 = it + 2 * ngw;
        if (i1 < total) { TG_SRC(i1, sB, dB); TG_LOAD(RB, sB); }
        TG_PROC(RA, dA);
        if (i1 >= total) break;
        if (i2 < total) { TG_SRC(i2, sA, dA); TG_LOAD(RA, sA); }
        TG_PROC(RB, dB);
        it = i2;
    }
#undef TG_SRC
#undef TG_LOAD
#undef TG_PROC
}
struct EpiInProj {
    static constexpr bool PERM = true;
    bf16 *QT, *VG, *SG, *FQ, *GG; float* GAFF;
    __device__ __forceinline__ void operator()(const f32x4 (&acc)[2][2][4][2], const pg8::Unit& u, int wr, int wc, int fr, int fq) const {
        const int pn = u.pn, row0 = u.pm * 256 + wr * 64 + fr, b = row0 >> 12, s0 = row0 & (SEQ - 1), cl = wc * 32 + 8 * fq;
        if (pn == 64) {
            if (wc == 0) {
#pragma unroll
                for (int ai = 0; ai < 2; ++ai)
#pragma unroll
                    for (int m = 0; m < 4; ++m) { float* d = GAFF + (size_t)(row0 + ai * 128 + m * 16) * 32 + 8 * fq; *(f32x4*)d = acc[ai][0][m][0]; *(f32x4*)(d + 4) = acc[ai][0][m][1]; }
            }
            return;
        }
        bf16* base0; bf16* base1; int rs, act = 0;
        if (pn < 8)       { base0 = QT + (size_t)(pn >> 2) * ((size_t)T * 1024) + (size_t)(b * 4 + (pn & 3)) * SEQ * 256 + cl; base1 = base0 + 128; rs = 256; }
        else if (pn < 16) { const int t = pn - 8; base0 = VG + (size_t)(b * 4 + (t >> 1)) * SEQ * 512 + 256 * (t & 1) + cl; base1 = base0 + 128; rs = 512; }
        else if (pn < 24) { base0 = SG + (size_t)b * SEQ * DM + 256 * (pn - 16) + cl; base1 = base0 + 128; rs = DM; act = 1; }
        else if (pn < 48) { const int t = (pn - 24) & 7; base0 = FQ + (size_t)((pn - 24) >> 3) * ((size_t)T * DM) + (size_t)(b * 16 + 2 * t) * SEQ * 128 + cl; base1 = base0 + (size_t)SEQ * 128; rs = 128; }
        else              { base0 = GG + (size_t)((pn - 48) >> 3) * ((size_t)T * DM) + (size_t)b * SEQ * DM + 256 * ((pn - 48) & 7) + cl; base1 = base0 + 128; rs = DM; act = 2; }
#pragma unroll
        for (int ai = 0; ai < 2; ++ai)
#pragma unroll
            for (int m = 0; m < 4; ++m) { const size_t ro = (size_t)(s0 + ai * 128 + m * 16) * rs;
#pragma unroll
                for (int bj = 0; bj < 2; ++bj) { f32x4 v0 = acc[ai][bj][m][0], v1 = acc[ai][bj][m][1];
                    if (act == 1) {
#pragma unroll
                        for (int j = 0; j < 4; ++j) { v0[j] = v0[j] * sigmoid_f(v0[j]); v1[j] = v1[j] * sigmoid_f(v1[j]); } }
                    else if (act == 2) {
#pragma unroll
                        for (int j = 0; j < 4; ++j) { v0[j] = sigmoid_f(v0[j]); v1[j] = sigmoid_f(v1[j]); } }
                    v4u w; w.x = pg8::cvt_pk_bf16(v0[0], v0[1]); w.y = pg8::cvt_pk_bf16(v0[2], v0[3]); w.z = pg8::cvt_pk_bf16(v1[0], v1[1]); w.w = pg8::cvt_pk_bf16(v1[2], v1[3]);
                    *(v4u*)((bj ? base1 : base0) + ro) = w; } }
    }
};


template <int STAGE> struct EpiGate {
    static constexpr bool PERM = true;
    bf16* Y; const bf16* G; bf16* M;
    __device__ __forceinline__ void operator()(const f32x4 (&acc)[2][2][4][2], const pg8::Unit& u, int wr, int wc, int fr, int fq) const {
        const size_t o00 = (size_t)(u.pm * 256 + wr * 64 + fr) * DM + u.pn * 256 + wc * 32 + 8 * fq;
#pragma unroll
        for (int ai = 0; ai < 2; ++ai) {
            v4u gw[4][2], yw[4][2];
#pragma unroll
            for (int m = 0; m < 4; ++m)
#pragma unroll
                for (int bj = 0; bj < 2; ++bj) { const size_t o = o00 + (size_t)(ai * 128 + m * 16) * DM + 128 * bj; gw[m][bj] = *(const v4u*)(G + o); if (STAGE == 1) yw[m][bj] = *(const v4u*)(Y + o); }
#pragma unroll
            for (int m = 0; m < 4; ++m)
#pragma unroll
                for (int bj = 0; bj < 2; ++bj) { const size_t o = o00 + (size_t)(ai * 128 + m * 16) * DM + 128 * bj; const v4u g = gw[m][bj];
                    const f32x4 g0 = {bf2f(g.x & 0xffffu), bf2f(g.x >> 16), bf2f(g.y & 0xffffu), bf2f(g.y >> 16)}, g1 = {bf2f(g.z & 0xffffu), bf2f(g.z >> 16), bf2f(g.w & 0xffffu), bf2f(g.w >> 16)};
                    f32x4 v0 = acc[ai][bj][m][0] * g0, v1 = acc[ai][bj][m][1] * g1;
                    if (STAGE == 1) { const v4u y = yw[m][bj]; v0 += (f32x4){bf2f(y.x & 0xffffu), bf2f(y.x >> 16), bf2f(y.y & 0xffffu), bf2f(y.y >> 16)}; v1 += (f32x4){bf2f(y.z & 0xffffu), bf2f(y.z >> 16), bf2f(y.w & 0xffffu), bf2f(y.w >> 16)}; }
                    *(v4u*)((STAGE == 0 ? Y : M) + o) = (v4u){pg8::cvt_pk_bf16(v0[0], v0[1]), pg8::cvt_pk_bf16(v0[2], v0[3]), pg8::cvt_pk_bf16(v1[0], v1[1]), pg8::cvt_pk_bf16(v1[2], v1[3])}; }
        }
    }
};
template <bool XBF16, bool BBF16> struct EpiRes {
    static constexpr bool PERM = true;
    const float* base; float* X; const float* gain; bf16* H; float* RSS;
    __device__ __forceinline__ void operator()(const f32x4 (&acc)[2][2][4][2], const pg8::Unit& u, int wr, int wc, int fr, int fq) const {
        const int row0 = u.pm * 256 + wr * 64 + fr, col0 = u.pn * 256 + wc * 32 + 8 * fq;
        f32x4 gv[2][2];
#pragma unroll
        for (int bj = 0; bj < 2; ++bj) { gv[bj][0] = *(const f32x4*)(gain + col0 + 128 * bj); gv[bj][1] = *(const f32x4*)(gain + col0 + 128 * bj + 4); }
#pragma unroll
        for (int ai = 0; ai < 2; ++ai) {
            f32x4 b0[4][2], b1[4][2];
#pragma unroll
            for (int m = 0; m < 4; ++m)
#pragma unroll
                for (int bj = 0; bj < 2; ++bj) { const size_t o = (size_t)(row0 + ai * 128 + m * 16) * DM + col0 + 128 * bj;
                    if (BBF16) { const v4u w = *(const v4u*)((const bf16*)base + o); b0[m][bj] = (f32x4){bf2f(w.x & 0xffffu), bf2f(w.x >> 16), bf2f(w.y & 0xffffu), bf2f(w.y >> 16)}; b1[m][bj] = (f32x4){bf2f(w.z & 0xffffu), bf2f(w.z >> 16), bf2f(w.w & 0xffffu), bf2f(w.w >> 16)}; }
                    else { b0[m][bj] = *(const f32x4*)(base + o); b1[m][bj] = *(const f32x4*)(base + o + 4); } }
#pragma unroll
            for (int m = 0; m < 4; ++m) { const int row = row0 + ai * 128 + m * 16; float ss = 0.f;
#pragma unroll
                for (int bj = 0; bj < 2; ++bj) { const size_t o = (size_t)row * DM + col0 + 128 * bj;
                    const f32x4 v0 = acc[ai][bj][m][0] + b0[m][bj], v1 = acc[ai][bj][m][1] + b1[m][bj];
                    if (XBF16) *(v4u*)((bf16*)X + o) = (v4u){pg8::cvt_pk_bf16(v0[0], v0[1]), pg8::cvt_pk_bf16(v0[2], v0[3]), pg8::cvt_pk_bf16(v1[0], v1[1]), pg8::cvt_pk_bf16(v1[2], v1[3])};
                    else { *(f32x4*)(X + o) = v0; *(f32x4*)(X + o + 4) = v1; }
                    ss += (v0[0] * v0[0] + v0[1] * v0[1] + v0[2] * v0[2] + v0[3] * v0[3]) + (v1[0] * v1[0] + v1[1] * v1[1] + v1[2] * v1[2] + v1[3] * v1[3]);
                    const f32x4 h0 = v0 * gv[bj][0], h1 = v1 * gv[bj][1];
                    *(v4u*)(H + o) = (v4u){pg8::cvt_pk_bf16(h0[0], h0[1]), pg8::cvt_pk_bf16(h0[2], h0[3]), pg8::cvt_pk_bf16(h1[0], h1[1]), pg8::cvt_pk_bf16(h1[2], h1[3])}; }
                ss += __shfl_xor(ss, 16); ss += __shfl_xor(ss, 32);
                if (fq == 0) RSS[(size_t)row * 32 + u.pn * 4 + wc] = ss; }
        }
    }
};

constexpr int MT_BASE = CTLW + 1024, MT_NRT = MT_BASE, MT_CNT = MT_BASE + 16, MT_PBASE = MT_CNT + 32 * 4, MT_TE = MT_PBASE + 36 * 4, MT_TP = MT_TE + MAXRT * 4, MT_END = MT_TP + MAXRT * 4;
static_assert(MT_END <= LDS_BYTES && gla::LDS_BYTES <= CTLW && fa::LDS_BYTES <= CTLW, "LDS map");
__device__ __forceinline__ void moe_tables(LAS unsigned char* lds, unsigned* ctl) {
    LAS int* nrt = (LAS int*)(lds + MT_NRT); LAS int* cnt = (LAS int*)(lds + MT_CNT); LAS int* pbase = (LAS int*)(lds + MT_PBASE); LAS int* te = (LAS int*)(lds + MT_TE); LAS int* tp = (LAS int*)(lds + MT_TP);
    __syncthreads();
    if (threadIdx.x < 64) {
        const int lane = threadIdx.x;
        const int c = lane < NE ? (int)xb_ld(ctl + CW_CNT + lane) : 0;
        const int nt = (c + 255) >> 8;
        int pre = nt;
#pragma unroll
        for (int o = 1; o < 32; o <<= 1) { const int y = __shfl_up(pre, o); if (lane >= o) pre += y; }
        const int first = pre - nt;
        if (lane < NE) { cnt[lane] = c; pbase[lane] = first * 256; for (int k = 0; k < nt; ++k) { te[first + k] = lane; tp[first + k] = k * 256; } }
        if (lane == NE - 1) { pbase[NE] = pre * 256; nrt[0] = pre; } }
    __syncthreads();
}
constexpr int SIDE_OFF = RING_BYTES, SIDE_STRIDE = 3072;
static_assert(SIDE_OFF + 3 * SIDE_STRIDE <= CTLW, "side tables");
template <bool UP> struct MoeOrder {
    static constexpr bool SIDE = true;
    LAS unsigned char* lds; const int* tokl; const float* rowscale; const float* bias; int nN, G, c;
    __device__ __forceinline__ bool next(int i, pg8::Unit& u) const {
        const int nrt = *(const LAS int*)(lds + MT_NRT); int rt, pn;
        if (G == 256) { const int x = c & 7, j = c >> 3, s = i * 8 + x, parts = nN >> 2, rg = s / parts, ph = s - rg * parts;
            rt = 8 * rg + (j >> 2); pn = 4 * ph + (j & 3); if (rt >= nrt) return false; }
        else { const long L = (long)i * G + c; if (L >= (long)nrt * nN) return false; rt = (int)(L / nN); pn = (int)(L % nN); }
        u.pm = rt; u.pn = pn; u.pb = ((const LAS int*)(lds + MT_TE))[rt] * nN + pn; u.kofs = 0; return true;
    }
    __device__ __forceinline__ void prefetch(const pg8::Unit& u, int sb, int wid, int lane) const {
        if (wid != 0) return;
        const int e = ((const LAS int*)(lds + MT_TE))[u.pm], p0 = ((const LAS int*)(lds + MT_TP))[u.pm];
        LAS unsigned char* dst = lds + SIDE_OFF + sb * SIDE_STRIDE;
        if (UP) __builtin_amdgcn_global_load_lds((const unsigned*)(tokl + (size_t)e * T + p0 + 4 * lane), (LAS unsigned*)dst, 16, 0, 0);
        __builtin_amdgcn_global_load_lds((const unsigned*)(rowscale + (size_t)e * T + p0 + 4 * lane), (LAS unsigned*)(dst + 1024), 16, 0, 0);
        const float* bsrc = UP ? bias + (size_t)e * 4096 + 128 * u.pn + (lane < 32 ? 4 * lane : 2048 + 4 * (lane - 32)) : bias + (size_t)e * DM + 256 * u.pn + 4 * lane;
        __builtin_amdgcn_global_load_lds((const unsigned*)bsrc, (LAS unsigned*)(dst + 2048), 16, 0, 0);
    }
    __device__ __forceinline__ const LAS int* tok_table(int sb) const { return (const LAS int*)(lds + SIDE_OFF + sb * SIDE_STRIDE); }
    __device__ __forceinline__ void a_ready(const pg8::Unit&) const {}
    __device__ __forceinline__ void done(const pg8::Unit&) const {}
};
struct EpiSwiglu {
    static constexpr bool PERM = true;
    bf16* act; LAS unsigned char* lds;
    __device__ __forceinline__ void operator()(const f32x4 (&acc)[2][2][4][2], const pg8::Unit& u, int wr, int wc, int fr, int fq) const {
        const int col = 128 * u.pn + wc * 32 + 8 * fq;
        const LAS unsigned char* side = lds + SIDE_OFF + u.sb * SIDE_STRIDE;
        const LAS float* rrow = (const LAS float*)(side + 1024) + wr * 64 + fr;
        const LAS float* bg = (const LAS float*)(side + 2048) + wc * 32 + 8 * fq;
        const f32x4 bg0 = *(const LAS f32x4*)bg, bg1 = *(const LAS f32x4*)(bg + 4), bl0 = *(const LAS f32x4*)(bg + 128), bl1 = *(const LAS f32x4*)(bg + 132);
        bf16* dst = act + (size_t)(u.pm * 256 + wr * 64 + fr) * DM + col;
#pragma unroll
        for (int ai = 0; ai < 2; ++ai)
#pragma unroll
            for (int m = 0; m < 4; ++m) {
                const float rs = rrow[ai * 128 + m * 16];
                const f32x4 g0 = acc[ai][0][m][0] * rs + bg0, g1 = acc[ai][0][m][1] * rs + bg1, l0 = acc[ai][1][m][0] * rs + bl0, l1 = acc[ai][1][m][1] * rs + bl1;
                float o[8];
#pragma unroll
                for (int j = 0; j < 4; ++j) { const float ga = fminf(g0[j], 7.f), gb = fminf(g1[j], 7.f), la_ = fminf(fmaxf(l0[j], -7.f), 7.f), lb = fminf(fmaxf(l1[j], -7.f), 7.f);
                    o[j] = ga * sigmoid_f(1.702f * ga) * (la_ + 1.f); o[4 + j] = gb * sigmoid_f(1.702f * gb) * (lb + 1.f); }
                *(v4u*)(dst + (size_t)(ai * 128 + m * 16) * DM) = (v4u){pg8::cvt_pk_bf16(o[0], o[1]), pg8::cvt_pk_bf16(o[2], o[3]), pg8::cvt_pk_bf16(o[4], o[5]), pg8::cvt_pk_bf16(o[6], o[7])};
            }
    }
};
struct EpiDown {
    static constexpr bool PERM = true;
    bf16* yb; LAS unsigned char* lds;
    __device__ __forceinline__ void operator()(const f32x4 (&acc)[2][2][4][2], const pg8::Unit& u, int wr, int wc, int fr, int fq) const {
        const int col = 256 * u.pn + wc * 32 + 8 * fq;
        const LAS unsigned char* side = lds + SIDE_OFF + u.sb * SIDE_STRIDE;
        const LAS float* wrow = (const LAS float*)(side + 1024) + wr * 64 + fr;
        const LAS float* bb = (const LAS float*)(side + 2048) + wc * 32 + 8 * fq; f32x4 bv[2][2];
#pragma unroll
        for (int bj = 0; bj < 2; ++bj) { bv[bj][0] = *(const LAS f32x4*)(bb + 128 * bj); bv[bj][1] = *(const LAS f32x4*)(bb + 128 * bj + 4); }
        bf16* dst = yb + (size_t)(u.pm * 256 + wr * 64 + fr) * DM + col;
#pragma unroll
        for (int ai = 0; ai < 2; ++ai)
#pragma unroll
            for (int m = 0; m < 4; ++m) { const float gt = wrow[ai * 128 + m * 16];
#pragma unroll
                for (int bj = 0; bj < 2; ++bj) { const f32x4 v0 = (acc[ai][bj][m][0] + bv[bj][0]) * gt, v1 = (acc[ai][bj][m][1] + bv[bj][1]) * gt;
                    *(v4u*)(dst + (size_t)(ai * 128 + m * 16) * DM + 128 * bj) = (v4u){pg8::cvt_pk_bf16(v0[0], v0[1]), pg8::cvt_pk_bf16(v0[2], v0[3]), pg8::cvt_pk_bf16(v1[0], v1[1]), pg8::cvt_pk_bf16(v1[2], v1[3])}; } }
    }
};
__device__ __forceinline__ void transpose_job_up(Frame& F, const float* W, bf16* WT) {
    LAS float* scr = (LAS float*)(F.lds + F.wave * 16384);
    constexpr int K = DM, N = 4096, per = (K / 64) * (N / 32); const long total = (long)per * NE;
    for (long it = F.gw; it < total; it += F.ngw) { const int e = (int)(it / per), item = (int)(it % per), lane = F.lane;
        const float* Wp = W + (size_t)e * K * N; bf16* WTp = WT + (size_t)e * N * K;
        const int nblk = N / 32, kb = item / nblk, nb = item % nblk, k0 = 64 * kb, n0 = 32 * nb;
        const int m0 = n0 & 2047, r0 = 256 * (m0 >> 7) + (n0 >= 2048 ? 128 : 0) + (m0 & 127);
#pragma unroll 8
        for (int i = 0; i < 32; ++i) { const int kk = 2 * i + (lane >> 5); scr[kk * 33 + (lane & 31)] = Wp[(size_t)(k0 + kk) * N + n0 + (lane & 31)]; }
        LDS_WAIT(); asm volatile("" ::: "memory");
        const int c = lane & 7;
#pragma unroll
        for (int j = 0; j < 4; ++j) { const int n = (lane >> 3) + 8 * j; const LAS float* sp = scr + (8 * c) * 33 + n;
            v4u o; o.x = pk2(sp[0 * 33], sp[1 * 33]); o.y = pk2(sp[2 * 33], sp[3 * 33]); o.z = pk2(sp[4 * 33], sp[5 * 33]); o.w = pk2(sp[6 * 33], sp[7 * 33]);
            *(v4u*)(WTp + (size_t)(r0 + n) * K + k0 + 8 * c) = o; }
        LDS_WAIT(); asm volatile("" ::: "memory");
    }
}


__device__ __forceinline__ void convert_expert_share(LAS unsigned char* lds, const float* Wup, const float* Wdn, bf16* WtUp, bf16* WtDn, int sh) {
    int t_ = threadIdx.x; asm volatile("" : "+v"(t_));
    const int wid = __builtin_amdgcn_readfirstlane(t_ >> 6), lane = t_ & 63;
    const int e = sh >> 3, part = sh & 7;
    LAS unsigned char* tile = lds + wid * 19456;
    const unsigned tbase = (unsigned)(size_t)tile;
    const int lr = lane >> 4, lc = lane & 15;
    const int g = lane >> 4, q = (lane & 15) >> 2, p = lane & 3;
    const unsigned wr_off = (unsigned)(lr * 160 + lc * 8), tr_off = (unsigned)(q * 160 + (g * 16 + 4 * p) * 2);
#define CES_SRC(it_, src_, N_, n0_, k0_, dst_, up_) do { const int it__ = (it_); \
        if (it__ < 32) { const int id = it__ * 8 + wid, kb = id >> 3, nb = id & 7; N_ = 4096; n0_ = part * 512 + nb * 64; k0_ = kb * 64; src_ = Wup + (size_t)e * DM * 4096; dst_ = WtUp + (size_t)e * 4096 * DM; up_ = true; } \
        else { const int id = (it__ - 32) * 8 + wid, kb = id >> 2, nb = id & 3; N_ = DM; n0_ = part * 256 + nb * 64; k0_ = kb * 64; src_ = Wdn + (size_t)e * DM * DM; dst_ = WtDn + (size_t)e * DM * DM; up_ = false; } } while (0)
#define CES_LOAD(R_, src_, N_, n0_, k0_) do { _Pragma("unroll") for (int i = 0; i < 16; ++i) R_[i] = __builtin_nontemporal_load((const f32x4*)(src_ + (size_t)(k0_ + 4 * i + lr) * N_ + n0_ + 4 * lc)); } while (0)
#define CES_PROC(R_, dst_, UP_, n0_, k0_) do { \
        _Pragma("unroll") for (int i = 0; i < 16; ++i) { const v2u w = {pk2(R_[i].x, R_[i].y), pk2(R_[i].z, R_[i].w)}; *(LAS v2u*)(tile + wr_off + i * 640) = w; } \
        asm volatile("s_waitcnt lgkmcnt(0)" ::: "memory"); \
          \
        _Pragma("unroll") for (int hb_ = 0; hb_ < 2; ++hb_) { v2u ta_[4], tb_[4]; \
            _Pragma("unroll") for (int jj = 0; jj < 4; ++jj) { \
                asm volatile("ds_read_b64_tr_b16 %0, %1 offset:%2" : "=&v"(ta_[jj]) : "v"(tbase + tr_off), "i"((4 * hb_ + jj) * 1280) : "memory"); \
                asm volatile("ds_read_b64_tr_b16 %0, %1 offset:%2" : "=&v"(tb_[jj]) : "v"(tbase + tr_off), "i"((4 * hb_ + jj) * 1280 + 640) : "memory"); } \
            asm volatile("s_waitcnt lgkmcnt(0)" : "+v"(ta_[0]), "+v"(ta_[1]), "+v"(ta_[2]), "+v"(ta_[3]), "+v"(tb_[0]), "+v"(tb_[1]), "+v"(tb_[2]), "+v"(tb_[3]) :: "memory"); \
            _Pragma("unroll") for (int jj = 0; jj < 4; ++jj) *(LAS v4u*)(tile + 10240 + lane * 144 + (4 * hb_ + jj) * 16) = (v4u){ta_[jj].x, ta_[jj].y, tb_[jj].x, tb_[jj].y}; } \
        asm volatile("s_waitcnt lgkmcnt(0)" ::: "memory"); \
          \
        _Pragma("unroll") for (int hf_ = 0; hf_ < 2; ++hf_) { v4u ow_[4]; \
            _Pragma("unroll") for (int s_ = 0; s_ < 4; ++s_) ow_[s_] = *(const LAS v4u*)(tile + 10240 + (8 * (4 * hf_ + s_) + (lane >> 3)) * 144 + (lane & 7) * 16); \
            _Pragma("unroll") for (int s_ = 0; s_ < 4; ++s_) { const int n = n0_ + 8 * (4 * hf_ + s_) + (lane >> 3); \
                const int m0 = n & 2047, drow = UP_ ? 256 * (m0 >> 7) + (n >= 2048 ? 128 : 0) + (m0 & 127) : n; \
                __builtin_nontemporal_store(ow_[s_], (v4u*)(dst_ + (size_t)drow * DM + k0_ + 8 * (lane & 7))); } \
            asm volatile("" ::: "memory"); } \
        asm volatile("s_waitcnt lgkmcnt(0)" ::: "memory"); } while (0)
    f32x4 RA[16], RB[16], RC[16];
    const float* sA; const float* sB; const float* sC; bf16* dA; bf16* dB; bf16* dC; int NA, NB_, NC, n0A, n0B, n0C, k0A, k0B, k0C; bool uA, uB, uC;
    CES_SRC(0, sA, NA, n0A, k0A, dA, uA); CES_LOAD(RA, sA, NA, n0A, k0A);
    CES_SRC(1, sB, NB_, n0B, k0B, dB, uB); CES_LOAD(RB, sB, NB_, n0B, k0B);
    for (int it = 0; it < 48; it += 3) {
        CES_SRC(it + 2, sC, NC, n0C, k0C, dC, uC); CES_LOAD(RC, sC, NC, n0C, k0C);
        CES_PROC(RA, dA, uA, n0A, k0A);
        if (it + 3 < 48) { CES_SRC(it + 3, sA, NA, n0A, k0A, dA, uA); CES_LOAD(RA, sA, NA, n0A, k0A); }
        CES_PROC(RB, dB, uB, n0B, k0B);
        if (it + 4 < 48) { CES_SRC(it + 4, sB, NB_, n0B, k0B, dB, uB); CES_LOAD(RB, sB, NB_, n0B, k0B); }
        CES_PROC(RC, dC, uC, n0C, k0C);
    }
#undef CES_SRC
#undef CES_LOAD
#undef CES_PROC
}

__global__ void __launch_bounds__(NWAVES * 64, 2) mk_fwd(Args args) {
    extern __shared__ __attribute__((aligned(16))) unsigned char lds_raw[];
    Frame F;
    F.lds = (LAS unsigned char*)lds_raw;
    F.tid = threadIdx.x; F.lane = F.tid & 63; F.wave = __builtin_amdgcn_readfirstlane(F.tid >> 6);
    F.G = gridDim.x; F.bid = blockIdx.x; F.gw = F.bid * NWAVES + F.wave; F.ngw = F.G * NWAVES;
    unsigned char* ws = args.ws;
    unsigned* ctl = (unsigned*)(ws + WS_CTL);
    for (int u = F.tid; u < (LDS_BYTES - CTLW) / 4; u += NWAVES * 64) ((LAS unsigned*)(F.lds + CTLW))[u] = 0u;
    __syncthreads();
    XcdBarrier bar = xcd_barrier_post(ctl + CW_BAR, (volatile LAS unsigned*)(F.lds + CTLW + 64));
#define GRID_BAR(k) do { if (IN(k) && IN((k) + 1)) xcd_barrier(bar); } while (0)
    const float* x = args.in[0]; const float* mem = args.in[1];
    bf16* WtIn = (bf16*)(ws + WS_WTIN); bf16* WtBg = (bf16*)(ws + WS_WTBG); bf16* WtBf = (bf16*)(ws + WS_WTBF); bf16* WtOut = (bf16*)(ws + WS_WTOUT);
    bf16* WtMq = (bf16*)(ws + WS_WTMQ); bf16* WtMkv = (bf16*)(ws + WS_WTMKV); bf16* WtMo = (bf16*)(ws + WS_WTMO); bf16* WtUp = (bf16*)(ws + WS_WTUP); bf16* WtDn = (bf16*)(ws + WS_WTDN);
    bf16* WrT = (bf16*)(ws + WS_WRT); bf16* yb = (bf16*)(ws + WS_YB); int* tokl = (int*)(ws + WS_TOKL); float* wl = (float*)(ws + WS_WL); float* rsl = (float*)(ws + WS_RSL); float* RSS1 = (float*)(ws + WS_RSS1); float* RSS2 = (float*)(ws + WS_RSS2); float* logits = (float*)(ws + WS_LOG);
    bf16* QT = (bf16*)(ws + WS_QT); bf16* KT = (bf16*)(ws + WS_KT); bf16* VG = (bf16*)(ws + WS_VG); float* EBL = (float*)(ws + WS_EBL); bf16* AT = (bf16*)(ws + WS_AT);
    bf16* SG = (bf16*)(ws + WS_SG); bf16* GG = (bf16*)(ws + WS_GG); bf16* GF = (bf16*)(ws + WS_GF); float* GAFF = (float*)(ws + WS_GAFF);
    float* ogla = (float*)(ws + WS_OGLA); float* Y1 = (float*)(ws + WS_Y1); float* Y2 = (float*)(ws + WS_Y2); float* X1 = (float*)(ws + WS_X1); float* X2 = (float*)(ws + WS_X2);
    bf16* hb = (bf16*)(ws + WS_H); bf16* attb = (bf16*)(ws + WS_ATT); bf16* onb = (bf16*)(ws + WS_ON); bf16* mrg = (bf16*)(ws + WS_MRG); bf16* h2 = (bf16*)(ws + WS_H2); bf16* xs = (bf16*)(ws + WS_XS);
    bf16* om = (bf16*)(ws + WS_OM); bf16* mn = (bf16*)(ws + WS_MN); float* qm = (float*)(ws + WS_QM); float* kv = (float*)(ws + WS_KV);
    bf16* act = (bf16*)(ws + WS_ACT);
    int* asg_e = (int*)(ws + WS_ASG); int* asg_pos = asg_e + NASG;
    bf16* fqh = (bf16*)(ws + WS_FQH); bf16* fkh = (bf16*)(ws + WS_FKH); bf16* fvh = (bf16*)(ws + WS_FVH); float* cbias = (float*)(ws + WS_CB);
    bf16* qmb = (bf16*)(ws + WS_QMB); bf16* knb = (bf16*)(ws + WS_KNB); bf16* vb = (bf16*)(ws + WS_VB);
    const int lo = args.ph_lo, hi = args.ph_hi;
#define IN(k) (lo <= (k) && (k) < hi)
#define REFRESH() do { int t_ = threadIdx.x; asm volatile("" : "+v"(t_)); F.tid = t_; F.lane = t_ & 63; F.wave = __builtin_amdgcn_readfirstlane(t_ >> 6); F.gw = F.bid * NWAVES + F.wave; } while (0)

    if (IN(0)) { REFRESH();
        transpose_win64(F.lds, args.in[3], WtIn, F.gw, F.ngw);
        __syncthreads();
        transpose_win(F, args.in[3], WtIn);
        { v4u* z = (v4u*)(WtIn + (size_t)(64 * 256 + 32) * DM); const int nz = (INCP - INC) * DM / 8; for (int i = F.bid * 512 + F.tid; i < nz; i += F.G * 512) z[i] = (v4u){0u, 0u, 0u, 0u}; }
        for (int m = F.gw; m < T; m += 2 * F.ngw) {
            const int m2 = m + F.ngw;
            if (m2 < T) rms_rows2_bf16(x + (size_t)m * DM, x + (size_t)m2 * DM, args.in[2], hb + (size_t)m * DM, hb + (size_t)m2 * DM, F.lane);
            else rms_row_bf16(x + (size_t)m * DM, args.in[2], hb + (size_t)m * DM, F.lane); }
    }
    GRID_BAR(0);
    if (IN(1)) { REFRESH();
        pg8::Gemm g{hb, WtIn, T, 16384, DM}; pg8::StaticOrder S; S.init(T, 16384, F.G, F.bid);
        EpiInProj E{QT, VG, SG, fqh, GG, GAFF};
        { const int r0 = F.bid & 15; pg8::StaticOrder Sa = S; Sa.iend = r0;
          pg8::gemm_phase<EpiInProj, pg8::StaticOrder>(F.lds, g, Sa, E);
          __syncthreads();
          for (int sh = F.bid; sh < 256; sh += F.G) convert_expert_share(F.lds, args.in[23], args.in[25], WtUp, WtDn, sh);
          __syncthreads();
          transpose64(F.lds, args.in[10], DM, DM, WtBg, F.gw, F.ngw);
          transpose64(F.lds, args.in[11], DM, DM, WtBf, F.gw, F.ngw);
          transpose64(F.lds, args.in[12], DM, DM, WtOut, F.gw, F.ngw);
          transpose64(F.lds, args.in[15], DM, 512, WtMq, F.gw, F.ngw);
          transpose64(F.lds, args.in[16], DM, 1024, WtMkv, F.gw, F.ngw);
          transpose64(F.lds, args.in[19], 512, DM, WtMo, F.gw, F.ngw);
          __syncthreads();
          transpose_job(F, args.in[21], DM, NE, 1, WrT);
          { v4u* z = (v4u*)tokl; const int nz = NE * T / 4; for (int i = F.bid * 512 + F.tid; i < nz; i += F.G * 512) z[i] = (v4u){0u, 0u, 0u, 0u}; }
          { v4u* z = (v4u*)(WrT + (size_t)NE * DM); const int nz = (256 - NE) * DM / 8; for (int i = F.bid * 512 + F.tid; i < nz; i += F.G * 512) z[i] = (v4u){0u, 0u, 0u, 0u}; }
          for (int m = F.gw; m < NB * MEML; m += F.ngw) rms_row_bf16(mem + (size_t)m * DM, args.in[14], mn + (size_t)m * DM, F.lane);
          __syncthreads();
          S.i0 = r0; }
        static_assert(WS_KT == WS_QT + (size_t)T * 1024 * 2 && WS_FKH == WS_FQH + (size_t)T * DM * 2 && WS_FVH == WS_FKH + (size_t)T * DM * 2 && WS_GF == WS_GG + (size_t)T * DM * 2, "epilogue pointer arithmetic");
        pg8::gemm_phase<EpiInProj, pg8::StaticOrder>(F.lds, g, S, E);
        { pg8::Gemm g2{hb, WtIn + (size_t)16384 * DM, T, 256, 512, DM}; pg8::SplitOrder S2{64, 1, 4, 512, F.G, F.bid}; pg8::EpiN32 E2{GAFF, 128};
          pg8::gemm_phase<pg8::EpiN32, pg8::SplitOrder>(F.lds, g2, S2, E2); }
    }
    GRID_BAR(1);
    if (IN(2)) { REFRESH();
        const float* aup = args.in[4]; const float* abias = args.in[5];
        LAS float* gaL = (LAS float*)F.lds;
        LAS float* bL = (LAS float*)(F.lds + 4096);
        for (int job = F.bid; job < 16 * 64; job += F.G) {
            const int bh = job >> 6, c = job & 63, b = bh >> 2, h = bh & 3; const size_t tok0 = (size_t)b * SEQ + c * 64;
            __syncthreads();
            if (F.tid < 256) { const float* gp_ = GAFF + (tok0 + (F.tid >> 2)) * 128 + 4 * (F.tid & 3); *(LAS f32x4*)(gaL + (F.tid >> 2) * 16 + 4 * (F.tid & 3)) = (*(const f32x4*)gp_ + *(const f32x4*)(gp_ + 32)) + (*(const f32x4*)(gp_ + 64) + *(const f32x4*)(gp_ + 96)); }
            __syncthreads();
            const int k = F.tid & 255, half = F.tid >> 8;
            { float au[16];
#pragma unroll
              for (int r = 0; r < 16; ++r) au[r] = aup[r * 1024 + h * 256 + k];
              const float ab = abias[h * 256 + k]; float run = 0.f;
#pragma unroll 4
              for (int tt = 0; tt < 32; ++tt) { const int t = 32 * half + tt; float a = ab;
#pragma unroll
                for (int r4 = 0; r4 < 4; ++r4) { const f32x4 g4 = *(const LAS f32x4*)(gaL + t * 16 + 4 * r4); a += g4.x * au[4 * r4] + g4.y * au[4 * r4 + 1] + g4.z * au[4 * r4 + 2] + g4.w * au[4 * r4 + 3]; }
                run += log_sigmoid_f(a) * (1.0f / 16.0f); bL[t * 256 + k] = run; } }
            __syncthreads();
            { const float add = half ? bL[31 * 256 + k] : 0.f;
              __syncthreads();
              if (half) {
#pragma unroll 8
                for (int tt = 0; tt < 32; ++tt) bL[(32 + tt) * 256 + k] += add; } }
            __syncthreads();
            if (F.tid < 256) EBL[((size_t)bh * 64 + c) * 256 + F.tid] = __expf(bL[63 * 256 + F.tid]);
            { bf16* qb = QT + ((size_t)bh * SEQ + c * 64) * 256; bf16* kb = KT + ((size_t)bh * SEQ + c * 64) * 256;
              v4u qv[4], kv_[4];
#pragma unroll
              for (int i = 0; i < 4; ++i) { const int it = F.tid + 512 * i, t = it >> 5, cg = it & 31; qv[i] = *(const v4u*)(qb + t * 256 + 8 * cg); kv_[i] = *(const v4u*)(kb + t * 256 + 8 * cg); }
#pragma unroll
              for (int i = 0; i < 4; ++i) { const int it = F.tid + 512 * i, t = it >> 5, cg = it & 31;
                const f32x4 b0 = *(const LAS f32x4*)(bL + t * 256 + 8 * cg), b1 = *(const LAS f32x4*)(bL + t * 256 + 8 * cg + 4);
                const float eb[8] = {__expf(b0.x), __expf(b0.y), __expf(b0.z), __expf(b0.w), __expf(b1.x), __expf(b1.y), __expf(b1.z), __expf(b1.w)};
                const unsigned qw[4] = {qv[i].x, qv[i].y, qv[i].z, qv[i].w}, kw[4] = {kv_[i].x, kv_[i].y, kv_[i].z, kv_[i].w}; unsigned qo[4], ko[4];
#pragma unroll
                for (int j = 0; j < 4; ++j) { const float e0 = eb[2 * j], e1 = eb[2 * j + 1];
                    qo[j] = pk2(bf2f(qw[j] & 0xffffu) * e0 * (1.0f / 16.0f), bf2f(qw[j] >> 16) * e1 * (1.0f / 16.0f));
                    ko[j] = pk2(bf2f(kw[j] & 0xffffu) * __builtin_amdgcn_rcpf(e0), bf2f(kw[j] >> 16) * __builtin_amdgcn_rcpf(e1)); }
                *(v4u*)(qb + t * 256 + 8 * cg) = (v4u){qo[0], qo[1], qo[2], qo[3]}; *(v4u*)(kb + t * 256 + 8 * cg) = (v4u){ko[0], ko[1], ko[2], ko[3]}; } }
        }
        VM_WAIT(); __syncthreads();
        { int nj = 0; for (int job = F.bid; job < 16 * 64; job += F.G) ++nj;
          for (int a = F.wave; a < 3 * nj; a += NWAVES) { const int job = F.bid + (a / 3) * F.G; gla::apass_job(QT, KT, AT, job * 3 + (a % 3), F.lane); } }
        __syncthreads();
        { pg8::Gemm g{mn, WtMkv, 1024, 1024, 512, DM}; pg8::SplitOrder S{4, 4, 4, 512, F.G, F.bid}; pg8::EpiF32 E{kv, 4096, nullptr}; pg8::gemm_phase<pg8::EpiF32, pg8::SplitOrder>(F.lds, g, S, E); }
        __syncthreads(); REFRESH();
        for (int job = F.bid - (F.G - 64); job >= 0 && job < NB * 16; job += F.G) {
            const int b = job >> 4, h = job & 15; const float fb = args.in[7][h];
            LAS double* wsum = (LAS double*)(F.lds + 4096 + 65536);
            float xv[8];
#pragma unroll
            for (int j = 0; j < 8; ++j) { const float* gp_ = GAFF + (size_t)(b * SEQ + 8 * F.tid + j) * 128 + 16 + h; xv[j] = log_sigmoid_f((gp_[0] + gp_[32]) + (gp_[64] + gp_[96]) + fb); }
            double loc = 0.0;
#pragma unroll
            for (int j = 0; j < 8; ++j) loc += (double)xv[j];
            double pre = loc;
#pragma unroll
            for (int o = 1; o < 64; o <<= 1) { const double y = __shfl_up(pre, o); if (F.lane >= o) pre += y; }
            __syncthreads();
            if (F.lane == 63) wsum[F.wave] = pre;
            __syncthreads();
            double run = pre - loc;
            for (int w = 0; w < F.wave; ++w) run += wsum[w];
#pragma unroll
            for (int j = 0; j < 8; ++j) { run += (double)xv[j]; cbias[(size_t)(b * 16 + h) * SEQ + 8 * F.tid + j] = (float)(-run * (double)(1.0f / fa::SCALE)); }
        }
        { int tl_ = threadIdx.x; asm volatile("" : "+v"(tl_));
          const int l16 = tl_ & 15, rsub = (tl_ & 63) >> 4;
          const f32x4 gq0 = *(const f32x4*)(args.in[8] + 8 * l16), gq1 = *(const f32x4*)(args.in[8] + 8 * l16 + 4), gk0 = *(const f32x4*)(args.in[9] + 8 * l16), gk1 = *(const f32x4*)(args.in[9] + 8 * l16 + 4);
#define QKN_LOAD(W_, r0_) do { _Pragma("unroll") for (int i = 0; i < 4; ++i) W_[i] = *(const v4u*)(fqh + (size_t)((r0_) + 4 * i + rsub) * 128 + 8 * l16); } while (0)
#define QKN_PROC(W_, r0_) do { const bool isk_ = (r0_) >= T * 16; const f32x4 g0 = isk_ ? gk0 : gq0, g1 = isk_ ? gk1 : gq1; \
            _Pragma("unroll") for (int i = 0; i < 4; ++i) { \
                float v[8] = {bf2f(W_[i].x & 0xffffu), bf2f(W_[i].x >> 16), bf2f(W_[i].y & 0xffffu), bf2f(W_[i].y >> 16), bf2f(W_[i].z & 0xffffu), bf2f(W_[i].z >> 16), bf2f(W_[i].w & 0xffffu), bf2f(W_[i].w >> 16)}; \
                float ss = 0.f; \
                _Pragma("unroll") for (int j = 0; j < 8; ++j) ss += v[j] * v[j]; \
                ss += __shfl_xor(ss, 1); ss += __shfl_xor(ss, 2); ss += __shfl_xor(ss, 4); ss += __shfl_xor(ss, 8); \
                const float r = 1.0f / sqrtf(ss * (1.f / 128.f) + EPS); \
                *(v4u*)(fqh + (size_t)((r0_) + 4 * i + rsub) * 128 + 8 * l16) = (v4u){pk2(v[0] * r * g0.x, v[1] * r * g0.y), pk2(v[2] * r * g0.z, v[3] * r * g0.w), pk2(v[4] * r * g1.x, v[5] * r * g1.y), pk2(v[6] * r * g1.z, v[7] * r * g1.w)}; } } while (0)
          const int step = F.ngw * 16, end = T * 32;
          v4u wa[4], wb[4];
          int r0 = F.gw * 16;
          if (r0 < end) { QKN_LOAD(wa, r0);
            for (;;) {
              const int r1 = r0 + step, r2 = r1 + step;
              if (r1 < end) QKN_LOAD(wb, r1);
              QKN_PROC(wa, r0);
              if (r1 >= end) break;
              if (r2 < end) QKN_LOAD(wa, r2);
              QKN_PROC(wb, r1);
              if (r2 >= end) break;
              r0 = r2;
            } }
#undef QKN_LOAD
#undef QKN_PROC
        }
    }
    GRID_BAR(2);
    if (IN(3)) { REFRESH();
        for (int item = F.bid; item < 64; item += F.G) {
            const int bh = item >> 2, grp = item & 3, b = bh >> 2, h = bh & 3;
            gla::ScanRef R{QT + (size_t)bh * SEQ * 256, KT + (size_t)bh * SEQ * 256, VG + (size_t)bh * SEQ * 512 + 128 * grp, AT + (size_t)bh * 64 * 64 * 64, EBL + (size_t)bh * 64 * 256,
                           ogla + (size_t)b * SEQ * DM + h * 512 + 128 * grp};
            gla::scan_item(R, F.lds);
            VM_WAIT(); __syncthreads();
            if (F.tid == 0) {
                unsigned* cw = ctl + CW_GLA + 64 * bh;
                __builtin_amdgcn_fence(__ATOMIC_RELEASE, "agent"); VM_WAIT();
                (void)xb_add(cw, 1u);
                unsigned sp = 0; while (xb_ld(cw) < 4u) { __builtin_amdgcn_s_sleep(2); if (++sp > (1u << 20)) { atomicAdd(ctl + CW_BAR + XB_TMO, 1u); break; } }
                __builtin_amdgcn_fence(__ATOMIC_ACQUIRE, "agent"); VM_WAIT();
            }
            __syncthreads();
            { const float* gp = args.in[6] + F.lane * 8; const f32x4 gq0 = *(const f32x4*)gp, gq1 = *(const f32x4*)(gp + 4);
              for (int tt = F.wave * 4; tt < 1024; tt += NWAVES * 4) {
                f32x4 v0[4], v1[4]; v4u sgw[4];
#pragma unroll
                for (int i = 0; i < 4; ++i) { const size_t o = ((size_t)b * SEQ + grp * 1024 + tt + i) * DM + h * 512 + F.lane * 8; v0[i] = *(const f32x4*)(ogla + o); v1[i] = *(const f32x4*)(ogla + o + 4); sgw[i] = *(const v4u*)(SG + o); }
#pragma unroll
                for (int i = 0; i < 4; ++i) { const size_t o = ((size_t)b * SEQ + grp * 1024 + tt + i) * DM + h * 512 + F.lane * 8;
                    const float ss = (v0[i].x * v0[i].x + v0[i].y * v0[i].y + v0[i].z * v0[i].z + v0[i].w * v0[i].w) + (v1[i].x * v1[i].x + v1[i].y * v1[i].y + v1[i].z * v1[i].z + v1[i].w * v1[i].w);
                    const float r = 1.0f / sqrtf(wave_sum(ss) * (1.f / 512.f) + EPS);
                    const float sg[8] = {bf2f(sgw[i].x & 0xffffu), bf2f(sgw[i].x >> 16), bf2f(sgw[i].y & 0xffffu), bf2f(sgw[i].y >> 16), bf2f(sgw[i].z & 0xffffu), bf2f(sgw[i].z >> 16), bf2f(sgw[i].w & 0xffffu), bf2f(sgw[i].w >> 16)};
                    *(v4u*)(onb + o) = (v4u){pk2(v0[i].x * r * gq0.x * sg[0], v0[i].y * r * gq0.y * sg[1]), pk2(v0[i].z * r * gq0.z * sg[2], v0[i].w * r * gq0.w * sg[3]),
                                             pk2(v1[i].x * r * gq1.x * sg[4], v1[i].y * r * gq1.y * sg[5]), pk2(v1[i].z * r * gq1.z * sg[6], v1[i].w * r * gq1.w * sg[7])}; } } }
        }
        __syncthreads();
        {
            constexpr int total = NB * 16 * 16, per_q = total / 8;
            volatile LAS int* qs = (volatile LAS int*)(F.lds + CTLW + 256);
            const unsigned myq = xb_xcc_id() & 7u;
#define FOX_FETCH(dst_) do { int got_ = total; for (unsigned k_ = 0; k_ < 8u; ++k_) { const unsigned q_ = (myq + k_) & 7u; \
                if (xb_ld(ctl + CW_FOXQ + 64 * q_) < (unsigned)per_q) { const unsigned v_ = atomicAdd(ctl + CW_FOXQ + 64 * q_, 1u); if (v_ < (unsigned)per_q) { got_ = (int)(q_ * per_q + v_); break; } } } (dst_) = got_; } while (0)
            if (F.tid == 0) { int a_, b_; FOX_FETCH(a_); FOX_FETCH(b_); qs[2] = a_; qs[3] = b_; }
            __syncthreads();
            int L = __builtin_amdgcn_readfirstlane(qs[2]), Ln = __builtin_amdgcn_readfirstlane(qs[3]), it = 0;
            if (L < total) {
#define FOX_REF(R_, L_) do { const int q_ = (L_) / per_q, i_ = (L_) - q_ * per_q, qb_ = 15 - (i_ >> 3), bh_ = (i_ & 7) * 8 + q_, b_ = bh_ >> 4, h_ = bh_ & 15; \
                (R_).Q = fqh + ((size_t)bh_ * SEQ + qb_ * 256) * 128; (R_).K = fkh + (size_t)bh_ * SEQ * 128; (R_).V = fvh + (size_t)bh_ * SEQ * 128; (R_).Bk = cbias + (size_t)bh_ * SEQ; \
                (R_).O = attb + ((size_t)(b_ * SEQ + qb_ * 256)) * DM + h_ * 128; (R_).P0 = qb_ * 256; } while (0)
                fa::BlockRef cur, nxt; fa::Seam S;
                FOX_REF(cur, L);
                fa::attn_prime<true, 128, 128, 128, DM>(cur, SEQ, (char*)lds_raw, S);
                for (;;) {
                    const bool last = Ln >= total;
                    if (last) nxt = cur; else FOX_REF(nxt, Ln);
                    if (F.tid == 0 && !last) { int a_; FOX_FETCH(a_); qs[it & 1] = a_; }
                    fa::attn_block<true, 128, 128, 128, DM>(cur, nxt, SEQ, SEQ, (char*)lds_raw, S);
                    if (last) break;
                    cur = nxt; L = Ln; Ln = __builtin_amdgcn_readfirstlane(qs[it & 1]); ++it;
                }
#undef FOX_REF
#undef FOX_FETCH
            }
        }
    }
    GRID_BAR(3);
    if (IN(5)) { REFRESH();
        { pg8::Gemm g{onb, WtBg, T, DM, DM}; pg8::StaticOrder S; S.init(T, DM, F.G, F.bid); EpiGate<0> E{(bf16*)Y1, GG, nullptr}; pg8::gemm_phase<EpiGate<0>, pg8::StaticOrder>(F.lds, g, S, E); }
        { pg8::Gemm g{attb, WtBf, T, DM, DM}; pg8::StaticOrder S; S.init(T, DM, F.G, F.bid); EpiGate<1> E{(bf16*)Y1, GF, mrg}; pg8::gemm_phase<EpiGate<1>, pg8::StaticOrder>(F.lds, g, S, E); }
    }
    GRID_BAR(5);
    if (IN(7)) { REFRESH(); pg8::Gemm g{mrg, WtOut, T, DM, DM}; pg8::StaticOrder S; S.init(T, DM, F.G, F.bid); EpiRes<true, false> E{x, X1, args.in[13], h2, RSS1}; pg8::gemm_phase<EpiRes<true, false>, pg8::StaticOrder>(F.lds, g, S, E); }
    GRID_BAR(7);
    if (IN(9)) { REFRESH();
        { pg8::Gemm g{h2, WtMq, T, 512, 1024, DM}; pg8::SplitOrder S{64, 2, 2, 1024, F.G, F.bid}; pg8::EpiF32 E{qm, 1024, nullptr}; pg8::gemm_phase<pg8::EpiF32, pg8::SplitOrder>(F.lds, g, S, E); }
    }
    GRID_BAR(9);
    if (IN(10)) { REFRESH();
        const int l16 = F.lane & 15, rsub = F.lane >> 4;
        for (int r0 = F.gw * 16; r0 < T * 4 + 1024 * 4; r0 += F.ngw * 16) {
            const bool isq = r0 < T * 4; const float* gp = args.in[isq ? 17 : 18] + 8 * l16; const f32x4 g0 = *(const f32x4*)gp, g1 = *(const f32x4*)(gp + 4);
            f32x4 a0[4], a1[4], c0[4], c1[4];
#pragma unroll
            for (int i = 0; i < 4; ++i) { const int r = (isq ? r0 : r0 - T * 4) + 4 * i + rsub, h = r & 3, row = r >> 2;
                if (isq) { const float* src = qm + (size_t)row * 1024 + h * 128 + 8 * l16; a0[i] = *(const f32x4*)src + *(const f32x4*)(src + 512); a1[i] = *(const f32x4*)(src + 4) + *(const f32x4*)(src + 516); }
                else { const float* src = kv + (size_t)row * 4096 + h * 128 + 8 * l16;
                    a0[i] = (*(const f32x4*)src + *(const f32x4*)(src + 1024)) + (*(const f32x4*)(src + 2048) + *(const f32x4*)(src + 3072));
                    a1[i] = (*(const f32x4*)(src + 4) + *(const f32x4*)(src + 1028)) + (*(const f32x4*)(src + 2052) + *(const f32x4*)(src + 3076));
                    c0[i] = (*(const f32x4*)(src + 512) + *(const f32x4*)(src + 1536)) + (*(const f32x4*)(src + 2560) + *(const f32x4*)(src + 3584));
                    c1[i] = (*(const f32x4*)(src + 516) + *(const f32x4*)(src + 1540)) + (*(const f32x4*)(src + 2564) + *(const f32x4*)(src + 3588)); } }
#pragma unroll
            for (int i = 0; i < 4; ++i) { const int r = (isq ? r0 : r0 - T * 4) + 4 * i + rsub, h = r & 3, row = r >> 2;
                float ss = (a0[i].x * a0[i].x + a0[i].y * a0[i].y + a0[i].z * a0[i].z + a0[i].w * a0[i].w) + (a1[i].x * a1[i].x + a1[i].y * a1[i].y + a1[i].z * a1[i].z + a1[i].w * a1[i].w);
                ss += __shfl_xor(ss, 1); ss += __shfl_xor(ss, 2); ss += __shfl_xor(ss, 4); ss += __shfl_xor(ss, 8);
                float epsq = EPS;
                if (isq) { const f32x2 p2 = *(const f32x2*)(RSS1 + (size_t)row * 32 + 2 * l16); float ms = p2.x + p2.y; ms += __shfl_xor(ms, 1); ms += __shfl_xor(ms, 2); ms += __shfl_xor(ms, 4); ms += __shfl_xor(ms, 8); epsq = EPS * (ms * (1.f / DM) + EPS); }
                const float rr = 1.0f / sqrtf(ss * (1.f / 128.f) + epsq);
                const v4u w = {pk2(a0[i].x * rr * g0.x, a0[i].y * rr * g0.y), pk2(a0[i].z * rr * g0.z, a0[i].w * rr * g0.w), pk2(a1[i].x * rr * g1.x, a1[i].y * rr * g1.y), pk2(a1[i].z * rr * g1.z, a1[i].w * rr * g1.w)};
                if (isq) *(v4u*)(qmb + (size_t)row * 512 + h * 128 + 8 * l16) = w;
                else { const size_t o = ((size_t)((row >> 8) * 4 + h) * MEML + (row & 255)) * 128 + 8 * l16; *(v4u*)(knb + o) = w;
                       *(v4u*)(vb + o) = (v4u){pk2(c0[i].x, c0[i].y), pk2(c0[i].z, c0[i].w), pk2(c1[i].x, c1[i].y), pk2(c1[i].z, c1[i].w)}; } }
        }
    }
    GRID_BAR(10);
    if (IN(11)) { REFRESH();
        {
            constexpr int total = NB * 4 * 16; const int stride = F.G; int L = F.bid;
            if (L < total) {
#define MEM_REF(R_, L_) do { const int bh_ = (L_) >> 4, qb_ = (L_) & 15, b_ = bh_ >> 2, h_ = bh_ & 3; \
                (R_).Q = qmb + ((size_t)(b_ * SEQ + qb_ * 256)) * 512 + h_ * 128; (R_).K = knb + (size_t)bh_ * MEML * 128; (R_).V = vb + (size_t)bh_ * MEML * 128; (R_).Bk = nullptr; \
                (R_).O = om + ((size_t)(b_ * SEQ + qb_ * 256)) * 512 + h_ * 128; (R_).P0 = MEML; } while (0)
                fa::BlockRef cur, nxt; fa::Seam S;
                MEM_REF(cur, L);
                fa::attn_prime<false, 512, 128, 128, 512>(cur, 1 << 30, (char*)lds_raw, S);
                for (;;) {
                    const bool more_item = L + stride < total; const int Ln = more_item ? L + stride : L;
                    if (!more_item) nxt = cur; else MEM_REF(nxt, Ln);
                    fa::attn_block<false, 512, 128, 128, 512>(cur, nxt, MEML, 1 << 30, (char*)lds_raw, S);
                    if (!more_item) break;
                    cur = nxt; L = Ln;
                }
#undef MEM_REF
            }
        }
    }
    GRID_BAR(11);
    if (IN(12)) { REFRESH(); pg8::Gemm g{om, WtMo, T, DM, 512}; pg8::StaticOrder S; S.init(T, DM, F.G, F.bid); EpiRes<true, true> E{X1, X2, args.in[20], xs, RSS2}; pg8::gemm_phase<EpiRes<true, true>, pg8::StaticOrder>(F.lds, g, S, E); }
    GRID_BAR(12);
    if (IN(15)) { REFRESH();
        const float* br = args.in[22];
        LAS int* hist = (LAS int*)F.lds; LAS int* gbase = hist + NE;
        LAS float* part = (LAS float*)(F.lds + 1024);
        for (int m0 = F.bid * 64; m0 < T; m0 += F.G * 64) {
            __syncthreads();
            if (F.tid < NE) hist[F.tid] = 0;
            { const int fr = F.lane & 15, fq = F.lane >> 4;
              f32x4 acc[4][2];
#pragma unroll
              for (int tb = 0; tb < 4; ++tb)
#pragma unroll
                  for (int eb = 0; eb < 2; ++eb) acc[tb][eb] = (f32x4){0.f, 0.f, 0.f, 0.f};
              const bf16* ap = xs + (size_t)(m0 + fr) * DM + 256 * F.wave + 8 * fq;
              const bf16* bp = WrT + (size_t)fr * DM + 256 * F.wave + 8 * fq;
              bf16x8 a[8][4], bw[8][2];
#pragma unroll
              for (int ks = 0; ks < 8; ++ks) {
#pragma unroll
                  for (int tb = 0; tb < 4; ++tb) a[ks][tb] = *(const bf16x8*)(ap + (size_t)tb * 16 * DM + ks * 32);
#pragma unroll
                  for (int eb = 0; eb < 2; ++eb) bw[ks][eb] = *(const bf16x8*)(bp + (size_t)eb * 16 * DM + ks * 32); }
#pragma unroll
              for (int ks = 0; ks < 8; ++ks)
#pragma unroll
                  for (int tb = 0; tb < 4; ++tb)
#pragma unroll
                      for (int eb = 0; eb < 2; ++eb) acc[tb][eb] = __builtin_amdgcn_mfma_f32_16x16x32_bf16(a[ks][tb], bw[ks][eb], acc[tb][eb], 0, 0, 0);
#pragma unroll
              for (int tb = 0; tb < 4; ++tb)
#pragma unroll
                  for (int eb = 0; eb < 2; ++eb)
#pragma unroll
                      for (int i = 0; i < 4; ++i) part[(F.wave * 64 + tb * 16 + 4 * fq + i) * 32 + eb * 16 + fr] = acc[tb][eb][i]; }
            __syncthreads();
            int ti[TOPK], rk[TOPK]; float gt[TOPK], rstd = 0.f; const int m = m0 + F.tid;
            if (F.tid < 64) {
                float ms = 0.f;
#pragma unroll
                for (int q = 0; q < 8; ++q) { const f32x4 p4 = *(const f32x4*)(RSS2 + (size_t)m * 32 + 4 * q); ms += (p4.x + p4.y) + (p4.z + p4.w); }
                rstd = 1.0f / sqrtf(ms * (1.f / DM) + EPS);
                float lg[NE];
#pragma unroll
                for (int q = 0; q < 8; ++q) { const LAS float* lp_ = part + F.tid * 32 + 4 * q;
                    const f32x4 l4 = ((*(const LAS f32x4*)lp_ + *(const LAS f32x4*)(lp_ + 2048)) + (*(const LAS f32x4*)(lp_ + 4096) + *(const LAS f32x4*)(lp_ + 6144)))
                                   + ((*(const LAS f32x4*)(lp_ + 8192) + *(const LAS f32x4*)(lp_ + 10240)) + (*(const LAS f32x4*)(lp_ + 12288) + *(const LAS f32x4*)(lp_ + 14336))), b4 = *(const f32x4*)(br + 4 * q);
                    lg[4 * q] = l4.x * rstd + b4.x; lg[4 * q + 1] = l4.y * rstd + b4.y; lg[4 * q + 2] = l4.z * rstd + b4.z; lg[4 * q + 3] = l4.w * rstd + b4.w; }
                unsigned taken = 0u; float tv[TOPK];
#pragma unroll
                for (int k = 0; k < TOPK; ++k) { float best = -3.0e38f; int bi = 0;
#pragma unroll
                    for (int e = 0; e < NE; ++e) { const bool ok = !((taken >> e) & 1u) && lg[e] > best; best = ok ? lg[e] : best; bi = ok ? e : bi; }
                    taken |= 1u << bi; tv[k] = best; ti[k] = bi; }
                float ps = 0.f;
#pragma unroll
                for (int k = 0; k < TOPK; ++k) { gt[k] = __expf(tv[k] - tv[0]); ps += gt[k]; }
#pragma unroll
                for (int k = 0; k < TOPK; ++k) { gt[k] /= ps; rk[k] = __hip_atomic_fetch_add(&hist[ti[k]], 1, __ATOMIC_RELAXED, __HIP_MEMORY_SCOPE_WORKGROUP); }
            }
            __syncthreads();
            if (F.tid < NE) gbase[F.tid] = (int)atomicAdd(ctl + CW_CNT + F.tid, (unsigned)hist[F.tid]);
            __syncthreads();
            if (F.tid < 64) {
#pragma unroll
                for (int k = 0; k < TOPK; ++k) { const int pos = gbase[ti[k]] + rk[k]; asg_e[m * TOPK + k] = ti[k]; asg_pos[m * TOPK + k] = pos;
                    const size_t li = (size_t)ti[k] * T + pos; tokl[li] = m; wl[li] = gt[k]; rsl[li] = rstd; }
            }
        }
    }
    GRID_BAR(15);
    if (IN(16)) { REFRESH();
        moe_tables(F.lds, ctl);
        pg8::Gemm g{xs, WtUp, PMAX, 4096, DM}; MoeOrder<true> S{F.lds, tokl, rsl, args.in[24], 16, F.G, F.bid}; EpiSwiglu E{act, F.lds};
        pg8::gemm_phase_gather<EpiSwiglu, MoeOrder<true>>(F.lds, g, S, E);
    }
    GRID_BAR(16);
    if (IN(17)) { REFRESH();
        moe_tables(F.lds, ctl);
        pg8::Gemm g{act, WtDn, PMAX, DM, DM}; MoeOrder<false> S{F.lds, tokl, wl, args.in[26], 8, F.G, F.bid}; EpiDown E{yb, F.lds};
        pg8::gemm_phase<EpiDown, MoeOrder<false>>(F.lds, g, S, E);
    }
    GRID_BAR(17);
    if (IN(18)) { REFRESH();
        moe_tables(F.lds, ctl);
        const LAS int* pbase = (const LAS int*)(F.lds + MT_PBASE);
        for (int t = F.gw; t < T; t += F.ngw) {
            int slot[TOPK];
#pragma unroll
            for (int k = 0; k < TOPK; ++k) slot[k] = pbase[asg_e[t * TOPK + k]] + asg_pos[t * TOPK + k];
            f32x4 o0[4], o1[4]; v4u w[4][TOPK];
#pragma unroll
            for (int p = 0; p < 4; ++p) { const int j = 512 * p + 8 * F.lane; { const v4u xw = *(const v4u*)((const bf16*)X2 + (size_t)t * DM + j); o0[p] = (f32x4){bf2f(xw.x & 0xffffu), bf2f(xw.x >> 16), bf2f(xw.y & 0xffffu), bf2f(xw.y >> 16)}; o1[p] = (f32x4){bf2f(xw.z & 0xffffu), bf2f(xw.z >> 16), bf2f(xw.w & 0xffffu), bf2f(xw.w >> 16)}; }
#pragma unroll
                for (int k = 0; k < TOPK; ++k) w[p][k] = *(const v4u*)(yb + (size_t)slot[k] * DM + j); }
#pragma unroll
            for (int p = 0; p < 4; ++p) { const int j = 512 * p + 8 * F.lane;
#pragma unroll
                for (int k = 0; k < TOPK; ++k) { const v4u q = w[p][k];
                    o0[p].x += bf2f(q.x & 0xffffu); o0[p].y += bf2f(q.x >> 16); o0[p].z += bf2f(q.y & 0xffffu); o0[p].w += bf2f(q.y >> 16);
                    o1[p].x += bf2f(q.z & 0xffffu); o1[p].y += bf2f(q.z >> 16); o1[p].z += bf2f(q.w & 0xffffu); o1[p].w += bf2f(q.w >> 16); }
                *(f32x4*)(args.out + (size_t)t * DM + j) = o0[p]; *(f32x4*)(args.out + (size_t)t * DM + j + 4) = o1[p]; }
        }
    }
#undef IN
}

constexpr int NPHASE = 19;
extern "C" void kernel_launch(void* const* d_in, const int* in_sizes, int n_in, void* d_out, int out_size, void* d_ws, size_t ws_size, hipStream_t stream) {
    static int grid = 0;
    static_assert(WS_END <= (size_t)4290 * 1000 * 1000, "d_ws map too large");
    if (grid == 0) {
        if (n_in != 27 || out_size != T * DM || ws_size < WS_END) { fprintf(stderr, "kernel_launch: unexpected shapes (n_in %d, out %d, ws %zu, need %zu)\n", n_in, out_size, ws_size, (size_t)WS_END); grid = -1; return; }
        int dev = 0, cus = 0, per_cu = 0;
        if (hipGetDevice(&dev) != hipSuccess || hipDeviceGetAttribute(&cus, hipDeviceAttributeMultiprocessorCount, dev) != hipSuccess) { grid = -1; return; }
        if (hipFuncSetAttribute((const void*)mk_fwd, hipFuncAttributeMaxDynamicSharedMemorySize, LDS_BYTES) != hipSuccess) { fprintf(stderr, "kernel_launch: hipFuncSetAttribute failed\n"); grid = -1; return; }
        if (hipOccupancyMaxActiveBlocksPerMultiprocessor(&per_cu, (const void*)mk_fwd, NWAVES * 64, LDS_BYTES) != hipSuccess || per_cu < 1) fprintf(stderr, "kernel_launch: occupancy query says %d\n", per_cu);
        (void)hipGetLastError();
        grid = cus;
    }
    if (grid < 0) return;
    (void)hipMemsetAsync((char*)d_ws + WS_CTL, 0, CTL_BYTES, stream);
    Args a{};
    for (int i = 0; i < 27; ++i) a.in[i] = (const float*)d_in[i];
    a.out = (float*)d_out; a.ws = (unsigned char*)d_ws;
    #ifndef MK_PER_PHASE
    a.ph_lo = 0; a.ph_hi = NPHASE; hipLaunchKernelGGL(mk_fwd, dim3(grid), dim3(NWAVES * 64), LDS_BYTES, stream, a);
#ifdef PROBE_LO
    (void)hipMemsetAsync((char*)d_ws + WS_CTL, 0, CTL_BYTES, stream);
    a.ph_lo = PROBE_LO; a.ph_hi = PROBE_HI; hipLaunchKernelGGL(mk_fwd, dim3(grid), dim3(NWAVES * 64), LDS_BYTES, stream, a);
#endif
#else
    for (int p = 0; p < NPHASE; ++p) { a.ph_lo = p; a.ph_hi = p + 1; hipLaunchKernelGGL(mk_fwd, dim3(grid), dim3(NWAVES * 64), LDS_BYTES, stream, a); }
#endif
}
```

```cpp
#include <hip/hip_runtime.h>
#include <cstdio>
#include <cstdint>

#define GAS __attribute__((address_space(1)))
#define LAS __attribute__((address_space(3)))
typedef unsigned short bf16;
typedef unsigned v4u __attribute__((ext_vector_type(4)));
typedef unsigned v2u __attribute__((ext_vector_type(2)));
typedef float f32x4 __attribute__((ext_vector_type(4)));
typedef float f32x2 __attribute__((ext_vector_type(2)));
typedef short bf16x8 __attribute__((ext_vector_type(8)));

constexpr int T = 16384, DM = 2048, NB = 4, SEQ = 4096, MEML = 256;
constexpr float EPS = 1e-6f;
constexpr int INC = 16416, INCP = 16640;
constexpr int C_GQ = 0, C_GK = 1024, C_GV = 2048, C_GR = 4096, C_GA = 6144, C_FQ = 6160, C_FK = 8208, C_FV = 10256, C_FF = 12304, C_GG = 12320, C_GF = 14368;
constexpr int NE = 32, TOPK = 4, NASG = T * TOPK, PMAX = NASG + NE * 256;
constexpr int MAXRT = PMAX / 256;

__device__ __forceinline__ unsigned f2bf(float f) { unsigned u = __builtin_bit_cast(unsigned, f); return (u + 0x7fffu + ((u >> 16) & 1u)) >> 16; }
__device__ __forceinline__ unsigned pk2(float lo, float hi) { unsigned r; asm("v_cvt_pk_bf16_f32 %0, %1, %2" : "=v"(r) : "v"(lo), "v"(hi)); return r; }
__device__ __forceinline__ float bf2f(unsigned b) { return __builtin_bit_cast(float, b << 16); }
__device__ __forceinline__ float wave_sum(float v) {
#pragma unroll
    for (int o = 1; o < 64; o <<= 1) v += __shfl_xor(v, o);
    return v;
}
__device__ __forceinline__ float sigmoid_f(float x) { return __builtin_amdgcn_rcpf(1.0f + __expf(-x)); }
__device__ __forceinline__ float log_sigmoid_f(float x) { return fminf(x, 0.f) - __logf(1.0f + __expf(-fabsf(x))); }
#define LDS_WAIT() asm volatile("s_waitcnt lgkmcnt(0)" ::: "memory")
#define VM_WAIT() asm volatile("s_waitcnt vmcnt(0)" ::: "memory")
#define XB_TMO      128
#define XB_XCNT(j)  (256  + 64 * (j))
#define XB_XSUB(j)  (1280 + 64 * (j))
#define XB_XGEN(j)  (2304 + 64 * (j))
#define XB_TOP      3328
#define XB_TOPGEN   3392
#define XCD_BAR_WORDS 3456
#define XB_SPIN_CAP (1u << 18)

__device__ __forceinline__ unsigned xb_ld(unsigned* p)              { return __hip_atomic_load(p, __ATOMIC_RELAXED, __HIP_MEMORY_SCOPE_AGENT); }
__device__ __forceinline__ unsigned xb_add(unsigned* p, unsigned v) { return __hip_atomic_fetch_add(p, v, __ATOMIC_RELAXED, __HIP_MEMORY_SCOPE_AGENT); }
__device__ __forceinline__ unsigned xb_xcc_id() { return (unsigned)__builtin_amdgcn_s_getreg((3 << 11) | 20) & 0xFu; }
#define XB_SPIN(cond, bar) do { unsigned _sp = 0; while (cond) { __builtin_amdgcn_s_sleep(1); \
    if ((++_sp & 255u) == 0u) { if (xb_ld(&(bar)[XB_TMO])) break; if (_sp > XB_SPIN_CAP) { atomicAdd(&(bar)[XB_TMO], 1u); break; } } } } while (0)

struct XcdBarrier {
    unsigned* bar; unsigned x;
    volatile LAS unsigned* st;
};
__device__ __forceinline__ XcdBarrier xcd_barrier_post(unsigned* bar, volatile LAS unsigned* st) {
    XcdBarrier b; b.bar = bar; b.x = xb_xcc_id(); b.st = st;
    if (threadIdx.x == 0) (void)xb_add(&bar[XB_XCNT(b.x)], 1u);
    return b;
}
__device__ __forceinline__ void xcd_barrier_complete(unsigned* bar, unsigned x, unsigned& nloc, unsigned& nx) {
    const unsigned G = gridDim.x * gridDim.y * gridDim.z;
    unsigned sum, cnt, mine, sp = 0u;
    for (;;) {
        sum = 0u; cnt = 0u; mine = 0u;
#pragma unroll
        for (unsigned j = 0; j < 16; ++j) { const unsigned c = xb_ld(&bar[XB_XCNT(j)]); sum += c; cnt += (c > 0u) ? 1u : 0u; mine = (j == x) ? c : mine; }
        if (sum == G) break;
        __builtin_amdgcn_s_sleep(1);
        if ((++sp & 255u) == 0u) { if (xb_ld(&bar[XB_TMO])) break; if (sp > XB_SPIN_CAP) { atomicAdd(&bar[XB_TMO], 1u); break; } }
    }
    nloc = mine > 0u ? mine : 1u; nx = cnt > 0u ? cnt : 1u;
}
__device__ __forceinline__ void xcd_barrier(const XcdBarrier& b) {
    asm volatile("s_waitcnt vmcnt(0)" ::: "memory");
    __syncthreads();
    if (threadIdx.x == 0) {
        unsigned* bar = b.bar;
        __builtin_amdgcn_s_waitcnt(0);
        unsigned nloc = b.st[0], nx = b.st[1];
        if (nloc == 0u) { xcd_barrier_complete(bar, b.x, nloc, nx); b.st[0] = nloc; b.st[1] = nx; }
        const unsigned old = xb_add(&bar[XB_XSUB(b.x)], 1u);
        const unsigned gen = old / nloc;
        if (old + 1u == (gen + 1u) * nloc) {
            __builtin_amdgcn_fence(__ATOMIC_RELEASE, "agent");
            asm volatile("s_waitcnt vmcnt(0)" ::: "memory");
            const unsigned og = xb_add(&bar[XB_TOP], 1u);
            const unsigned tg = og / nx;
            if (og + 1u == (tg + 1u) * nx) xb_add(&bar[XB_TOPGEN], 1u);
            else XB_SPIN(xb_ld(&bar[XB_TOPGEN]) == tg, bar);
            __builtin_amdgcn_fence(__ATOMIC_ACQUIRE, "agent");
            xb_add(&bar[XB_XGEN(b.x)], 1u);
            asm volatile("s_waitcnt vmcnt(0)" ::: "memory");
        } else {
            XB_SPIN(xb_ld(&bar[XB_XGEN(b.x)]) == gen, bar);
            __builtin_amdgcn_fence(__ATOMIC_ACQUIRE, "agent");
            asm volatile("s_waitcnt vmcnt(0)" ::: "memory");
        }
    }
    __syncthreads();
}
namespace pg8 {
#define PG8_LAS __attribute__((address_space(3)))
typedef unsigned short bf16_t;
typedef short bf16x8 __attribute__((ext_vector_type(8)));
typedef float f32x4 __attribute__((ext_vector_type(4)));
typedef unsigned u32x4 __attribute__((ext_vector_type(4)));
constexpr int BM = 256, BK = 64, HALF = 128, HTB = HALF * BK * 2  , STAGE_BYTES = 8 * HTB, NXCD = 8, WGM = 8;

__host__ __device__ __forceinline__ int lds_byte(int r, int c) { const int st = (r >> 4) * 2 + (c >> 5), rr = r & 15, cc = c & 31, ob = rr * 64 + cc * 2; return st * 1024 + (ob ^ (((ob >> 9) & 1) << 5)); }
__host__ __device__ __forceinline__ void stage_rc(int b, int& R, int& C) { const int st = b / 1024, sb = b % 1024, swz = sb ^ (((sb >> 9) & 1) << 5); R = (st >> 1) * 16 + swz / 64; C = (st & 1) * 32 + (swz % 64) / 2; }
__host__ __device__ __forceinline__ int perm32(int rho) { const int n = rho >> 4, i = rho & 15; return 8 * (i >> 2) + 4 * n + (i & 3); }

struct Unit { int pm, pn, pb, kofs, sb; };
struct Gemm { const bf16_t* A; const bf16_t* Bt; int M, N, K, ld; };

struct StaticOrder {
    int nM, nN, nwg, G, c, i0 = 0, iend = 1 << 30;
    __host__ __device__ void init(int M, int N, int G_, int c_) { nM = M / BM; nN = N / BM; nwg = nM * nN; G = G_; c = c_; }
    __host__ __device__ bool next(int i, Unit& u) const {
        if (i + i0 >= iend) return false;
        const long L = (long)(i + i0) * G + c; if (L >= nwg) return false;
        int wgid = (int)L; { const int q = nwg / NXCD, r = nwg % NXCD, xcd = wgid % NXCD, off = wgid / NXCD; wgid = (xcd < r ? xcd * (q + 1) : r * (q + 1) + (xcd - r) * q) + off; }
        const int nig = WGM * nN, gid = wgid / nig, fm = gid * WGM, gsz = (nM - fm) < WGM ? (nM - fm) : WGM;
        u.pm = fm + ((wgid % nig) % gsz); u.pn = (wgid % nig) / gsz; u.pb = u.pn; u.kofs = 0; return true;
    }
    static constexpr bool SIDE = false;
    __device__ __forceinline__ void prefetch(const Unit&, int, int, int) const {}
    __device__ __forceinline__ void a_ready(const Unit&) const {}
    __device__ __forceinline__ void done(const Unit&) const {}
};

struct SplitOrder {
    int nM, nN, nS, Ks, G, c;
    __host__ __device__ bool next(int i, Unit& u) const {
        const long L = (long)i * G + c; if (L >= (long)nM * nN * nS) return false;
        const int s = (int)(L % nS), r = (int)(L / nS); u.pm = r / nN; const int pn = r % nN; u.pn = s * nN + pn; u.pb = pn; u.kofs = s * Ks; return true;
    }
    static constexpr bool SIDE = false;
    __device__ __forceinline__ void prefetch(const Unit&, int, int, int) const {}
    __device__ __forceinline__ void a_ready(const Unit&) const {}
    __device__ __forceinline__ void done(const Unit&) const {}
};

__device__ __forceinline__ unsigned cvt_pk_bf16(float lo, float hi) { unsigned r; asm volatile("v_cvt_pk_bf16_f32 %0, %1, %2" : "=v"(r) : "v"(lo), "v"(hi)); return r; }

struct EpiF32 {
    static constexpr bool PERM = false;
    float* C; int ldc; const float* bias;
    __device__ __forceinline__ void operator()(const f32x4 (&acc)[2][2][4][2], const Unit& u, int wr, int wc, int fr, int fq) const {
        const int row0 = u.pm * BM + wr * 64 + fr, col0 = u.pn * BM + wc * 32 + 4 * fq;
        f32x4 bv[2][2];
#pragma unroll
        for (int bj = 0; bj < 2; ++bj)
#pragma unroll
            for (int n = 0; n < 2; ++n) bv[bj][n] = bias ? *(const f32x4*)(bias + col0 + bj * HALF + n * 16) : (f32x4){0.f, 0.f, 0.f, 0.f};
#pragma unroll
        for (int ai = 0; ai < 2; ++ai)
#pragma unroll
            for (int m = 0; m < 4; ++m) { float* rowp = C + (size_t)(row0 + ai * HALF + m * 16) * ldc + col0;
#pragma unroll
                for (int bj = 0; bj < 2; ++bj)
#pragma unroll
                    for (int n = 0; n < 2; ++n) *(f32x4*)(rowp + bj * HALF + n * 16) = acc[ai][bj][m][n] + bv[bj][n]; }
    }
};

struct EpiN32 {
    static constexpr bool PERM = false;
    float* C; int ldc;
    __device__ __forceinline__ void operator()(const f32x4 (&acc)[2][2][4][2], const Unit& u, int wr, int wc, int fr, int fq) const {
        if (wc != 0) return;
        const int row0 = u.pm * BM + wr * 64 + fr;
#pragma unroll
        for (int ai = 0; ai < 2; ++ai)
#pragma unroll
            for (int m = 0; m < 4; ++m) { float* rowp = C + (size_t)(row0 + ai * HALF + m * 16) * ldc + 32 * u.pn + 4 * fq;
                *(f32x4*)rowp = acc[ai][0][m][0]; *(f32x4*)(rowp + 16) = acc[ai][0][m][1]; }
    }
};

template <class Epi, class Sched>
__device__ __forceinline__ void gemm_phase(PG8_LAS unsigned char* lds, const Gemm g, const Sched& S, const Epi& E) {
    const int tid = threadIdx.x, wid = __builtin_amdgcn_readfirstlane(tid >> 6), lane = tid & 63, wr = wid >> 2, wc = wid & 3, fr = lane & 15, fq = lane >> 4;
    const int K = g.K, nt = K / BK, LD = g.ld ? g.ld : g.K;
    unsigned voffA[2], voffB[2];
#pragma unroll
    for (int i = 0; i < 2; ++i) { int R, C; stage_rc(tid * 16 + i * 8192, R, C); const int Rb = Epi::PERM ? ((R & ~31) + perm32(R & 31)) : R;
        voffA[i] = (unsigned)(R * LD + C) * 2u; voffB[i] = (unsigned)(Rb * LD + C) * 2u; }
    const size_t kstep = (size_t)(BK * 2);
    const size_t hstep = (size_t)HALF * LD * 2;
    const size_t tstep = 2 * hstep;
    const unsigned ldsw = (unsigned)wid * 1024u;
    const int aoff = lds_byte(wr * 64 + fr, fq * 8), boff = lds_byte(wc * 32 + fr, fq * 8);
#define PG8_SA(b, h) (((b) * 2 + (h)) * HTB)
#define PG8_SB(b, h) ((4 + (b) * 2 + (h)) * HTB)
#define PG8_STAGE(bufoff, gbase, voff) do { _Pragma("unroll") for (int _i = 0; _i < 2; ++_i) \
        __builtin_amdgcn_global_load_lds((const unsigned*)((const char*)(gbase) + (voff)[_i]), (PG8_LAS unsigned*)(lds + (bufoff) + ldsw + _i * 8192), 16, 0, 0); } while (0)
#define PG8_LDA(dst, b, h) do { _Pragma("unroll") for (int m = 0; m < 4; ++m) _Pragma("unroll") for (int k = 0; k < 2; ++k) dst[m][k] = *(const PG8_LAS bf16x8*)(lds + PG8_SA(b, h) + aoff + m * 2048 + k * 1024); } while (0)
#define PG8_LDB(dst, b, h) do { _Pragma("unroll") for (int n = 0; n < 2; ++n) _Pragma("unroll") for (int k = 0; k < 2; ++k) dst[n][k] = *(const PG8_LAS bf16x8*)(lds + PG8_SB(b, h) + boff + n * 2048 + k * 1024); } while (0)
#define PG8_MMA(ai, bj, At, Bt) do { __builtin_amdgcn_s_setprio(1); _Pragma("unroll") for (int m = 0; m < 4; ++m) _Pragma("unroll") for (int n = 0; n < 2; ++n) _Pragma("unroll") for (int k = 0; k < 2; ++k) \
        acc[ai][bj][m][n] = __builtin_amdgcn_mfma_f32_16x16x32_bf16(Bt[n][k], At[m][k], acc[ai][bj][m][n], 0, 0, 0); __builtin_amdgcn_s_setprio(0); } while (0)
#define PG8_WAIT_V(n) asm volatile("s_waitcnt vmcnt(" #n ")" ::: "memory")
#define PG8_WAIT_L(n) asm volatile("s_waitcnt lgkmcnt(" #n ")" ::: "memory")
#define PG8_BAR __builtin_amdgcn_s_barrier()
#define PG8_SCHED __builtin_amdgcn_sched_barrier(0)
    Unit cur, nxt; int ui = 0;
    if (!S.next(0, cur)) return;
    f32x4 acc[2][2][4][2];
#pragma unroll
    for (int a = 0; a < 2; ++a)
#pragma unroll
        for (int b = 0; b < 2; ++b)
#pragma unroll
            for (int m = 0; m < 4; ++m)
#pragma unroll
                for (int n = 0; n < 2; ++n) acc[a][b][m][n] = (f32x4){0.f, 0.f, 0.f, 0.f};
    bf16x8 At[4][2], B0[2][2], B1[2][2];
    const char* cA = (const char*)g.A + (size_t)cur.pm * tstep + (size_t)cur.kofs * 2; const char* cB = (const char*)g.Bt + (size_t)cur.pb * tstep + (size_t)cur.kofs * 2;
    S.a_ready(cur); cur.sb = 0;
    if constexpr (Sched::SIDE) S.prefetch(cur, 0, wid, lane);
    PG8_STAGE(PG8_SB(0, 0), cB, voffB); PG8_STAGE(PG8_SA(0, 0), cA, voffA); PG8_STAGE(PG8_SB(0, 1), cB + hstep, voffB); PG8_STAGE(PG8_SA(0, 1), cA + hstep, voffA);
    if (wr == 1) PG8_BAR;
    PG8_WAIT_V(4); PG8_BAR;
    PG8_STAGE(PG8_SB(1, 0), cB + kstep, voffB); PG8_STAGE(PG8_SA(1, 0), cA + kstep, voffA); PG8_STAGE(PG8_SB(1, 1), cB + hstep + kstep, voffB);
    PG8_WAIT_V(6); PG8_BAR;
    for (;;) {
        const bool has_next = S.next(ui + 1, nxt); nxt.sb = cur.sb == 2 ? 0 : cur.sb + 1;
        if constexpr (Sched::SIDE) { if (has_next) S.prefetch(nxt, nxt.sb, wid, lane); }
        const char* nA = has_next ? (const char*)g.A + (size_t)nxt.pm * tstep + (size_t)nxt.kofs * 2 : cA; const char* nB = has_next ? (const char*)g.Bt + (size_t)nxt.pb * tstep + (size_t)nxt.kofs * 2 : cB;
        for (int t = 0; t < nt; t += 2) {
            const bool last = (t == nt - 2);
            const char* a1 = cA + (size_t)(t + 1) * kstep;
            const char* a2 = last ? nA : cA + (size_t)(t + 2) * kstep; const char* b2 = last ? nB : cB + (size_t)(t + 2) * kstep;
            const char* a3 = a2 + kstep; const char* b3 = b2 + kstep;
            if (last && has_next) S.a_ready(nxt);
            PG8_LDB(B0, 0, 0); PG8_SCHED; PG8_LDA(At, 0, 0); PG8_STAGE(PG8_SA(1, 1), a1 + hstep, voffA);
            PG8_WAIT_L(8); PG8_BAR; PG8_WAIT_L(0); PG8_MMA(0, 0, At, B0); PG8_BAR; PG8_SCHED;
            PG8_LDB(B1, 0, 1); PG8_STAGE(PG8_SB(0, 0), b2, voffB);
            PG8_BAR; PG8_WAIT_L(0); PG8_MMA(0, 1, At, B1); PG8_BAR;
            PG8_LDA(At, 0, 1); PG8_STAGE(PG8_SA(0, 0), a2, voffA);
            PG8_BAR; PG8_WAIT_L(0); PG8_MMA(1, 0, At, B0); PG8_BAR; PG8_SCHED;
            PG8_STAGE(PG8_SB(0, 1), b2 + hstep, voffB);
            PG8_WAIT_V(6); PG8_BAR; PG8_MMA(1, 1, At, B1); PG8_BAR;
            PG8_LDB(B0, 1, 0); PG8_SCHED; PG8_LDA(At, 1, 0); PG8_STAGE(PG8_SA(0, 1), a2 + hstep, voffA);
            PG8_WAIT_L(8); PG8_BAR; PG8_WAIT_L(0); PG8_MMA(0, 0, At, B0); PG8_BAR; PG8_SCHED;
            PG8_LDB(B1, 1, 1); PG8_STAGE(PG8_SB(1, 0), b3, voffB);
            PG8_BAR; PG8_WAIT_L(0); PG8_MMA(0, 1, At, B1); PG8_BAR;
            PG8_LDA(At, 1, 1); PG8_STAGE(PG8_SA(1, 0), a3, voffA);
            PG8_BAR; PG8_WAIT_L(0); PG8_MMA(1, 0, At, B0); PG8_BAR; PG8_SCHED;
            PG8_STAGE(PG8_SB(1, 1), b3 + hstep, voffB);
            PG8_WAIT_V(6); PG8_BAR; PG8_MMA(1, 1, At, B1); PG8_BAR;
        }
        E(acc, cur, wr, wc, fr, fq); S.done(cur);
        if (!has_next) break;
#pragma unroll
        for (int a = 0; a < 2; ++a)
#pragma unroll
            for (int b = 0; b < 2; ++b)
#pragma unroll
                for (int m = 0; m < 4; ++m)
#pragma unroll
                    for (int n = 0; n < 2; ++n) acc[a][b][m][n] = (f32x4){0.f, 0.f, 0.f, 0.f};
        cur = nxt; cA = nA; cB = nB; ++ui;
    }
    PG8_WAIT_V(0);
    if (wr == 0) PG8_BAR;
    PG8_BAR;
#undef PG8_SA
#undef PG8_SB
#undef PG8_STAGE
#undef PG8_LDA
#undef PG8_LDB
#undef PG8_MMA
#undef PG8_WAIT_V
#undef PG8_WAIT_L
#undef PG8_BAR
#undef PG8_SCHED
}
template <class Epi, class Sched>
__device__ __forceinline__ void gemm_phase_gather(PG8_LAS unsigned char* lds, const Gemm g, const Sched& S, const Epi& E) {
    const int tid = threadIdx.x, wid = __builtin_amdgcn_readfirstlane(tid >> 6), lane = tid & 63, wr = wid >> 2, wc = wid & 3, fr = lane & 15, fq = lane >> 4;
    const int K = g.K, nt = K / BK;
    unsigned voffB[2]; int RA[2], CA[2];
#pragma unroll
    for (int i = 0; i < 2; ++i) { int R, C; stage_rc(tid * 16 + i * 8192, R, C); const int Rb = Epi::PERM ? ((R & ~31) + perm32(R & 31)) : R;
        RA[i] = R; CA[i] = C * 2; voffB[i] = (unsigned)(Rb * K + C) * 2u; }
    unsigned va0[2], va1[2], vn0[2], vn1[2];
#define PG8_ROWS(u_, d0, d1) do { const PG8_LAS int* tk_ = S.tok_table((u_).sb); _Pragma("unroll") for (int _i = 0; _i < 2; ++_i) { d0[_i] = (unsigned)tk_[RA[_i]] * (unsigned)(K * 2) + (unsigned)CA[_i]; d1[_i] = (unsigned)tk_[HALF + RA[_i]] * (unsigned)(K * 2) + (unsigned)CA[_i]; } } while (0)
    const size_t kstep = (size_t)(BK * 2);
    const size_t hstep = (size_t)HALF * K * 2;
    const size_t tstep = 2 * hstep;
    const unsigned ldsw = (unsigned)wid * 1024u;
    const int aoff = lds_byte(wr * 64 + fr, fq * 8), boff = lds_byte(wc * 32 + fr, fq * 8);
#define PG8_SA(b, h) (((b) * 2 + (h)) * HTB)
#define PG8_SB(b, h) ((4 + (b) * 2 + (h)) * HTB)
#define PG8_STAGE(bufoff, gbase, voff) do { _Pragma("unroll") for (int _i = 0; _i < 2; ++_i) \
        __builtin_amdgcn_global_load_lds((const unsigned*)((const char*)(gbase) + (voff)[_i]), (PG8_LAS unsigned*)(lds + (bufoff) + ldsw + _i * 8192), 16, 0, 0); } while (0)
#define PG8_LDA(dst, b, h) do { _Pragma("unroll") for (int m = 0; m < 4; ++m) _Pragma("unroll") for (int k = 0; k < 2; ++k) dst[m][k] = *(const PG8_LAS bf16x8*)(lds + PG8_SA(b, h) + aoff + m * 2048 + k * 1024); } while (0)
#define PG8_LDB(dst, b, h) do { _Pragma("unroll") for (int n = 0; n < 2; ++n) _Pragma("unroll") for (int k = 0; k < 2; ++k) dst[n][k] = *(const PG8_LAS bf16x8*)(lds + PG8_SB(b, h) + boff + n * 2048 + k * 1024); } while (0)
#define PG8_MMA(ai, bj, At, Bt) do { __builtin_amdgcn_s_setprio(1); _Pragma("unroll") for (int m = 0; m < 4; ++m) _Pragma("unroll") for (int n = 0; n < 2; ++n) _Pragma("unroll") for (int k = 0; k < 2; ++k) \
        acc[ai][bj][m][n] = __builtin_amdgcn_mfma_f32_16x16x32_bf16(Bt[n][k], At[m][k], acc[ai][bj][m][n], 0, 0, 0); __builtin_amdgcn_s_setprio(0); } while (0)
#define PG8_WAIT_V(n) asm volatile("s_waitcnt vmcnt(" #n ")" ::: "memory")
#define PG8_WAIT_L(n) asm volatile("s_waitcnt lgkmcnt(" #n ")" ::: "memory")
#define PG8_BAR __builtin_amdgcn_s_barrier()
#define PG8_SCHED __builtin_amdgcn_sched_barrier(0)
    Unit cur, nxt; int ui = 0;
    if (!S.next(0, cur)) return;
    f32x4 acc[2][2][4][2];
#pragma unroll
    for (int a = 0; a < 2; ++a)
#pragma unroll
        for (int b = 0; b < 2; ++b)
#pragma unroll
            for (int m = 0; m < 4; ++m)
#pragma unroll
                for (int n = 0; n < 2; ++n) acc[a][b][m][n] = (f32x4){0.f, 0.f, 0.f, 0.f};
    bf16x8 At[4][2], B0[2][2], B1[2][2];
    const char* cA = (const char*)g.A; const char* cB = (const char*)g.Bt + (size_t)cur.pb * tstep;
    S.a_ready(cur); cur.sb = 0;
    S.prefetch(cur, 0, wid, lane); PG8_WAIT_V(0); __syncthreads();
    PG8_ROWS(cur, va0, va1);
    PG8_STAGE(PG8_SB(0, 0), cB, voffB); PG8_STAGE(PG8_SA(0, 0), cA, va0); PG8_STAGE(PG8_SB(0, 1), cB + hstep, voffB); PG8_STAGE(PG8_SA(0, 1), cA, va1);
    if (wr == 1) PG8_BAR;
    PG8_WAIT_V(4); PG8_BAR;
    PG8_STAGE(PG8_SB(1, 0), cB + kstep, voffB); PG8_STAGE(PG8_SA(1, 0), cA + kstep, va0); PG8_STAGE(PG8_SB(1, 1), cB + hstep + kstep, voffB);
    PG8_WAIT_V(6); PG8_BAR;
    for (;;) {
        const bool has_next = S.next(ui + 1, nxt); nxt.sb = cur.sb == 2 ? 0 : cur.sb + 1;
        const char* nB = has_next ? (const char*)g.Bt + (size_t)nxt.pb * tstep : cB;
        if (has_next) S.prefetch(nxt, nxt.sb, wid, lane);
        for (int t = 0; t < nt; t += 2) {
            const bool last = (t == nt - 2);
            const char* a1 = cA + (size_t)(t + 1) * kstep;
            const char* a2 = last ? cA : cA + (size_t)(t + 2) * kstep; const char* b2 = last ? nB : cB + (size_t)(t + 2) * kstep;
            int tkr0[2], tkr1[2];
            { const PG8_LAS int* tk_ = S.tok_table(nxt.sb);
#pragma unroll
              for (int _i = 0; _i < 2; ++_i) { tkr0[_i] = tk_[RA[_i]]; tkr1[_i] = tk_[HALF + RA[_i]]; } }
            PG8_SCHED;
            const char* a3 = a2 + kstep; const char* b3 = b2 + kstep;
            if (last && has_next) S.a_ready(nxt);
            PG8_LDB(B0, 0, 0); PG8_SCHED; PG8_LDA(At, 0, 0); PG8_STAGE(PG8_SA(1, 1), a1, va1);
            PG8_WAIT_L(8); PG8_BAR; PG8_WAIT_L(0); PG8_MMA(0, 0, At, B0); PG8_BAR; PG8_SCHED;
            PG8_LDB(B1, 0, 1); PG8_STAGE(PG8_SB(0, 0), b2, voffB);
            PG8_BAR; PG8_WAIT_L(0); PG8_MMA(0, 1, At, B1); PG8_BAR;
            unsigned x0[2], x1[2];
#pragma unroll
            for (int _i = 0; _i < 2; ++_i) { vn0[_i] = has_next ? (unsigned)tkr0[_i] * (unsigned)(K * 2) + (unsigned)CA[_i] : va0[_i]; vn1[_i] = has_next ? (unsigned)tkr1[_i] * (unsigned)(K * 2) + (unsigned)CA[_i] : va1[_i];
                x0[_i] = last ? vn0[_i] : va0[_i]; x1[_i] = last ? vn1[_i] : va1[_i]; }
            PG8_SCHED;
            PG8_LDA(At, 0, 1); PG8_STAGE(PG8_SA(0, 0), a2, x0);
            PG8_BAR; PG8_WAIT_L(0); PG8_MMA(1, 0, At, B0); PG8_BAR; PG8_SCHED;
            PG8_STAGE(PG8_SB(0, 1), b2 + hstep, voffB);
            PG8_WAIT_V(6); PG8_BAR; PG8_MMA(1, 1, At, B1); PG8_BAR;
            PG8_LDB(B0, 1, 0); PG8_SCHED; PG8_LDA(At, 1, 0); PG8_STAGE(PG8_SA(0, 1), a2, x1);
            PG8_WAIT_L(8); PG8_BAR; PG8_WAIT_L(0); PG8_MMA(0, 0, At, B0); PG8_BAR; PG8_SCHED;
            PG8_LDB(B1, 1, 1); PG8_STAGE(PG8_SB(1, 0), b3, voffB);
            PG8_BAR; PG8_WAIT_L(0); PG8_MMA(0, 1, At, B1); PG8_BAR;
            PG8_LDA(At, 1, 1); PG8_STAGE(PG8_SA(1, 0), a3, x0);
            PG8_BAR; PG8_WAIT_L(0); PG8_MMA(1, 0, At, B0); PG8_BAR; PG8_SCHED;
            PG8_STAGE(PG8_SB(1, 1), b3 + hstep, voffB);
            PG8_WAIT_V(6); PG8_BAR; PG8_MMA(1, 1, At, B1); PG8_BAR;
        }
        E(acc, cur, wr, wc, fr, fq); S.done(cur);
        if (!has_next) break;
#pragma unroll
        for (int a = 0; a < 2; ++a)
#pragma unroll
            for (int b = 0; b < 2; ++b)
#pragma unroll
                for (int m = 0; m < 4; ++m)
#pragma unroll
                    for (int n = 0; n < 2; ++n) acc[a][b][m][n] = (f32x4){0.f, 0.f, 0.f, 0.f};
        cur = nxt; cB = nB; ++ui;
#pragma unroll
        for (int _i = 0; _i < 2; ++_i) { va0[_i] = vn0[_i]; va1[_i] = vn1[_i]; }
    }
    PG8_WAIT_V(0);
    if (wr == 0) PG8_BAR;
    PG8_BAR;
#undef PG8_ROWS
#undef PG8_SA
#undef PG8_SB
#undef PG8_STAGE
#undef PG8_LDA
#undef PG8_LDB
#undef PG8_MMA
#undef PG8_WAIT_V
#undef PG8_WAIT_L
#undef PG8_BAR
#undef PG8_SCHED
}
}
namespace fa {
constexpr float SCALE = 0.08838834764831845f;
constexpr float THR = 8.f;
constexpr int D = 128, NW = 8, QBLK = 32, KVBLK = 64, QB = NW * QBLK;
constexpr int SHM_V = KVBLK * D * 2, SHM_K = KVBLK * D * 2;
constexpr int OFF_WS = 2 * SHM_V + 2 * SHM_K, OFF_BIAS = OFF_WS + NW * 64 * 4, LDS_BYTES = OFF_BIAS + 2 * 256;
typedef short s16x4 __attribute__((ext_vector_type(4)));
typedef float f32x16 __attribute__((ext_vector_type(16)));
typedef unsigned u32x4 __attribute__((ext_vector_type(4)));

#define KSWZ(row, colB) ((row) * 256 + ((colB) ^ (((row) & 7) << 4)))
#define SBAR() __builtin_amdgcn_sched_barrier(0)
__device__ __forceinline__ int v_st(int k, int c) { const int kk = (k & ~0xC) | ((k & 4) << 1) | ((k & 8) >> 1); return ((kk >> 3) * 4 + (c >> 5)) * 512 + ((kk & 7) * 32 + (c & 31)) * 2; }
__device__ __forceinline__ int v_rd_base(int lane) { return ((lane & 3) << 3) | (((lane >> 2) & 3) << 6) | (((lane >> 4) & 1) << 5) | (((lane >> 5) & 1) << 8); }
constexpr int v_rd_off(int d0, int ks, int half) { return d0 * 512 + ks * 4096 + half * 2048; }
__device__ __forceinline__ int crow(int r, int hi) { return (r & 3) + 8 * (r >> 2) + 4 * hi; }
__device__ __forceinline__ unsigned cvtpk(float lo, float hi) { unsigned r; asm volatile("v_cvt_pk_bf16_f32 %0, %1, %2" : "=v"(r) : "v"(lo), "v"(hi)); return r; }
__device__ __forceinline__ bf16x8 load8(const bf16* p) { return *reinterpret_cast<const bf16x8*>(p); }
__device__ __forceinline__ void mask_tile(f32x16& p0, f32x16& p1, int dq, unsigned W) {
    const float NEG = -__builtin_inff();
#pragma unroll
    for (int r = 0; r < 16; ++r) {
        const int c = (r & 3) + 8 * (r >> 2);
        if ((unsigned)(dq - c) >= W) p0[r] = NEG;
        if ((unsigned)(dq - c - 32) >= W) p1[r] = NEG;
    }
}
__device__ __forceinline__ void partialSM(f32x16& p0, f32x16& p1, float& m_reg, float& mn, float& alpha) {
    float pmax = p0[0]; for (int r = 1; r < 16; ++r) pmax = fmaxf(pmax, p0[r]); for (int r = 0; r < 16; ++r) pmax = fmaxf(pmax, p1[r]);
    { auto rr = __builtin_amdgcn_permlane32_swap(__float_as_uint(pmax), __float_as_uint(pmax), false, false);
      pmax = fmaxf(__uint_as_float(rr[0]), __uint_as_float(rr[1])); }
    constexpr float C2 = 1.4426950408889634f * SCALE;
    if (__builtin_expect(__all((pmax - m_reg) * SCALE <= THR), 1)) { mn = m_reg; alpha = 1.f; }
    else { mn = fmaxf(m_reg, pmax); alpha = __builtin_amdgcn_exp2f((m_reg - mn) * C2); m_reg = mn; }
    const float mnL = -mn * C2;
    for (int r = 0; r < 16; ++r) p0[r] = fmaf(p0[r], C2, mnL); for (int r = 0; r < 16; ++r) p1[r] = fmaf(p1[r], C2, mnL);
    for (int r = 0; r < 16; ++r) p0[r] = __builtin_amdgcn_exp2f(p0[r]);
}
__device__ __forceinline__ void finishSM(f32x16& p0, f32x16& p1, float alpha, float& l_reg, bf16x8& pa0, bf16x8& pa1, bf16x8& pa2, bf16x8& pa3) {
    for (int r = 0; r < 16; ++r) p1[r] = __builtin_amdgcn_exp2f(p1[r]);
    float ps = 0; for (int r = 0; r < 16; ++r) ps += p0[r]; for (int r = 0; r < 16; ++r) ps += p1[r];
    { auto rr = __builtin_amdgcn_permlane32_swap(__float_as_uint(ps), __float_as_uint(ps), false, false);
      ps = __uint_as_float(rr[0]) + __uint_as_float(rr[1]); }
    l_reg = l_reg * alpha + ps;
#define PK4(P, B_, OUT) do { unsigned a0 = cvtpk(P[B_+0], P[B_+1]), a1 = cvtpk(P[B_+2], P[B_+3]);                          \
        unsigned b0 = cvtpk(P[B_+4], P[B_+5]), b1 = cvtpk(P[B_+6], P[B_+7]);                                             \
        auto r0 = __builtin_amdgcn_permlane32_swap(a0, b0, false, false); auto r1 = __builtin_amdgcn_permlane32_swap(a1, b1, false, false); \
        u32x4 w = {r0[0], r1[0], r0[1], r1[1]}; OUT = *reinterpret_cast<bf16x8*>(&w); } while (0)
    PK4(p0, 0, pa0); PK4(p0, 8, pa1); PK4(p1, 0, pa2); PK4(p1, 8, pa3);
#undef PK4
}
template <int KB, bool BIAS>
__device__ __forceinline__ void qkt(f32x16& p0, f32x16& p1, const char* K_lds, const char* B_lds, int r32, int hi, const bf16x8* qr) {
    if constexpr (BIAS) {
        const f32x4* bl = reinterpret_cast<const f32x4*>(B_lds + KB * 256 + hi * 16);
        const f32x4 a0 = bl[0], a1 = bl[2], a2 = bl[4], a3 = bl[6];
        p0 = (f32x16){a0.x, a0.y, a0.z, a0.w, a1.x, a1.y, a1.z, a1.w, a2.x, a2.y, a2.z, a2.w, a3.x, a3.y, a3.z, a3.w};
        const f32x4 c0 = bl[8], c1 = bl[10], c2 = bl[12], c3 = bl[14];
        p1 = (f32x16){c0.x, c0.y, c0.z, c0.w, c1.x, c1.y, c1.z, c1.w, c2.x, c2.y, c2.z, c2.w, c3.x, c3.y, c3.z, c3.w};
    } else { p0 = f32x16{}; p1 = f32x16{}; }
    const char* kb[4];
#pragma unroll
    for (int dd = 0; dd < 4; ++dd) kb[dd] = K_lds + KB * SHM_K + KSWZ(r32, (dd * 16 + hi * 8) * 2);
#pragma unroll
    for (int d0 = 0; d0 < 8; ++d0) { const char* a = kb[d0 & 3] + (d0 >> 2) * 128;
        bf16x8 b0 = *reinterpret_cast<const bf16x8*>(a);
        bf16x8 b1 = *reinterpret_cast<const bf16x8*>(a + 32 * 256);
        p0 = __builtin_amdgcn_mfma_f32_32x32x16_bf16(b0, qr[d0], p0, 0, 0, 0);
        p1 = __builtin_amdgcn_mfma_f32_32x32x16_bf16(b1, qr[d0], p1, 0, 0, 0); }
}
template <int KB>
__device__ __forceinline__ void add_bias(f32x16& p0, f32x16& p1, const char* B_lds, int hi) {
    const f32x4* bl = reinterpret_cast<const f32x4*>(B_lds + KB * 256 + hi * 16);
#pragma unroll
    for (int g = 0; g < 4; ++g) { const f32x4 a = bl[2 * g], c = bl[8 + 2 * g];
        p0[4 * g + 0] += a.x; p0[4 * g + 1] += a.y; p0[4 * g + 2] += a.z; p0[4 * g + 3] += a.w;
        p1[4 * g + 0] += c.x; p1[4 * g + 1] += c.y; p1[4 * g + 2] += c.z; p1[4 * g + 3] += c.w; }
}
template <int VB>
__device__ __forceinline__ void pv_tile(f32x16* o, int vb0, bf16x8 pa0, bf16x8 pa1, bf16x8 pa2, bf16x8 pa3) {
#define TRRD(dst, off) asm volatile("ds_read_b64_tr_b16 %0, %1 offset:%2" : "=&v"(dst) : "v"(vb0), "i"(off) : "memory")
#define PV_D0(d0) do { s16x4 l0, l1, l2, l3, h0, h1, h2, h3; constexpr int b_ = VB * SHM_V + v_rd_off(d0, 0, 0);   \
        TRRD(l0, b_); TRRD(h0, b_ + 2048); TRRD(l1, b_ + 4096); TRRD(h1, b_ + 6144); TRRD(l2, b_ + 8192); TRRD(h2, b_ + 10240); TRRD(l3, b_ + 12288); TRRD(h3, b_ + 14336); \
        asm volatile("s_waitcnt lgkmcnt(0)" ::: "memory"); SBAR();   \
        o[d0] = __builtin_amdgcn_mfma_f32_32x32x16_bf16(pa0, (bf16x8){l0[0], l0[1], l0[2], l0[3], h0[0], h0[1], h0[2], h0[3]}, o[d0], 0, 0, 0);   \
        o[d0] = __builtin_amdgcn_mfma_f32_32x32x16_bf16(pa1, (bf16x8){l1[0], l1[1], l1[2], l1[3], h1[0], h1[1], h1[2], h1[3]}, o[d0], 0, 0, 0);   \
        o[d0] = __builtin_amdgcn_mfma_f32_32x32x16_bf16(pa2, (bf16x8){l2[0], l2[1], l2[2], l2[3], h2[0], h2[1], h2[2], h2[3]}, o[d0], 0, 0, 0);   \
        o[d0] = __builtin_amdgcn_mfma_f32_32x32x16_bf16(pa3, (bf16x8){l3[0], l3[1], l3[2], l3[3], h3[0], h3[1], h3[2], h3[3]}, o[d0], 0, 0, 0); } while (0)
    PV_D0(0); PV_D0(1); PV_D0(2); PV_D0(3);
#undef PV_D0
#undef TRRD
}

struct BlockRef { const bf16* Q; const bf16* K; const bf16* V; const float* Bk; bf16* O; int P0; };
struct Seam { bf16x8 qr[8]; bf16x8 st_v0, st_v1, st_k0, st_k1; };
__device__ __forceinline__ int swa_jlo(int P0, int W) { const int lowk = P0 - W + 1; return lowk > 0 ? lowk / KVBLK : 0; }

#define ROWK(p, k0, rr) ((p) + (size_t)((k0) + (rr)) * KS + sc)
#define ROWV(p, k0, rr) ((p) + (size_t)((k0) + (rr)) * VS + sc)
#define VMW() asm volatile("s_waitcnt vmcnt(0)" ::: "memory")
#define VMWN(n) asm volatile("s_waitcnt vmcnt(%0)" :: "i"(n) : "memory")
#define SLOAD_H(R_, k0, bfb) do { S.st_v0 = load8(ROWV((R_).V, k0, sr)); S.st_v1 = load8(ROWV((R_).V, k0, 32 + sr));              \
                         S.st_k0 = load8(ROWK((R_).K, k0, sr)); S.st_k1 = load8(ROWK((R_).K, k0, 32 + sr));                  \
                         if constexpr (BIAS) { if (wid == 0) __builtin_amdgcn_global_load_lds((const unsigned*)((R_).Bk + (k0) + lane), (LAS unsigned*)((LAS char*)B_lds + (bfb) * 256), 4, 0, 0); } } while (0)
#define SWRITE_HK(bf) do { *(bf16x8*)(K_lds + (bf) * SHM_K + kws) = S.st_k0; *(bf16x8*)(K_lds + (bf) * SHM_K + kws + 32 * 256) = S.st_k1; } while (0)
#define SWRITE_HV(bf) do { *(bf16x8*)(V_lds + (bf) * SHM_V + vst0) = S.st_v0; *(bf16x8*)(V_lds + (bf) * SHM_V + vst1) = S.st_v1; } while (0)
#define SWRITE_H(bf) do { SWRITE_HV(bf); SWRITE_HK(bf); } while (0)

template <bool BIAS, int QS, int KS, int VS, int OS>
__device__ __forceinline__ void attn_prime(const BlockRef& cur, int W, char* lds, Seam& S) {
    const int tid = threadIdx.x, wid = __builtin_amdgcn_readfirstlane(tid >> 6), lane = tid & 63, r32 = lane & 31, hi = lane >> 5;
    const int sr = tid >> 4, sc = (tid & 15) * 8, kws = KSWZ(sr, sc * 2); char* K_lds = lds + 2 * SHM_V; char* B_lds = lds + OFF_BIAS;
    const int kb0 = swa_jlo(cur.P0, W) * KVBLK;
    for (int d0 = 0; d0 < 8; ++d0) S.qr[d0] = load8(cur.Q + (size_t)(wid * QBLK + r32) * QS + d0 * 16 + hi * 8);
    SLOAD_H(cur, kb0, 0); VMW(); SWRITE_HK(0);
    __syncthreads();
}
template <bool BIAS, int QS, int KS, int VS, int OS>
__device__ __forceinline__ void attn_block(const BlockRef& cur, const BlockRef& nxt, int skv, int W, char* lds, Seam& S) {
    int tid_ = threadIdx.x; asm volatile("" : "+v"(tid_));
    const int tid = tid_, wid = __builtin_amdgcn_readfirstlane(tid >> 6), lane = tid & 63, r32 = lane & 31, hi = lane >> 5;
    const int j_lo = swa_jlo(cur.P0, W);
    int j_hi = (cur.P0 + QB - 1) / KVBLK + 1; if (j_hi > skv / KVBLK) j_hi = skv / KVBLK;
    const int NT = j_hi - j_lo;
    const int kbn = swa_jlo(nxt.P0, W) * KVBLK;
    const int qlo = cur.P0 + wid * QBLK, qm = qlo + r32 - 4 * hi;
    char* V_lds = lds; char* K_lds = lds + 2 * SHM_V; char* B_lds = lds + OFF_BIAS;
    float* ws = (float*)(lds + OFF_WS) + wid * 64; float* li_l = ws, * al_l = ws + 32;
    float m_reg = -1e30f, l_reg = 0; f32x16 o[4] = {};
    const int sr = tid >> 4, sc = (tid & 15) * 8, vst0 = v_st(sr, sc), vst1 = v_st(32 + sr, sc), kws = KSWZ(sr, sc * 2);
    const int vb0 = (int)(uintptr_t)V_lds + v_rd_base(lane);
#define RESC(a) do { if (__any((a) < 1.f)) { if (hi == 0) al_l[r32] = (a); asm volatile("s_waitcnt lgkmcnt(0)" ::: "memory");              \
                     for (int d_ = 0; d_ < 4; ++d_) for (int r = 0; r < 16; ++r) o[d_][r] *= al_l[crow(r, hi)]; } } while (0)
#define KBASE(t) ((j_lo + (t)) * KVBLK)
#define MASKT(P0_, P1_, t, KB_) do { const int kb_ = KBASE(t); if (kb_ + KVBLK - 1 > qlo || kb_ <= qlo + QBLK - 1 - W) mask_tile(P0_, P1_, qm - kb_, (unsigned)W); } while (0)
    constexpr int NQL = 8;
#define SEAM_K0() do { VMWN(NQL); SWRITE_HK(0); SBAR(); } while (0)
    f32x16 pA0, pA1, pB0, pB1; float mnA, mnB, alA, alB; bf16x8 pa0, pa1, pa2, pa3;
    SWRITE_HV(0); SBAR();
    if (NT > 1) { SLOAD_H(cur, KBASE(1), 1); }
    SBAR(); qkt<0, BIAS>(pA0, pA1, K_lds, B_lds, r32, hi, S.qr);
    MASKT(pA0, pA1, 0, 0); partialSM(pA0, pA1, m_reg, mnA, alA);
    if (NT > 1) { VMW(); SWRITE_H(1); }
    __syncthreads();
#define HALF_STEP(PX0, PX1, mnX, alX, PY0, PY1, alY, t, KB, VB, SB) do {                                                      \
        SBAR(); qkt<KB, BIAS>(PX0, PX1, K_lds, B_lds, r32, hi, S.qr);                                                         \
        finishSM(PY0, PY1, alY, l_reg, pa0, pa1, pa2, pa3); SBAR();                                                           \
        if ((t) + 1 < NT) { SLOAD_H(cur, KBASE((t) + 1), SB); SBAR(); }                                                           \
        pv_tile<VB>(o, vb0, pa0, pa1, pa2, pa3); MASKT(PX0, PX1, (t), KB); partialSM(PX0, PX1, m_reg, mnX, alX);                  \
        __syncthreads();                                                                                                      \
        if ((t) + 1 < NT) { VMW(); SWRITE_H(SB); }                                                                            \
        RESC(alX); __syncthreads(); } while (0)
    for (int t = 1; t + 1 < NT; t += 2) {
        HALF_STEP(pB0, pB1, mnB, alB, pA0, pA1, alA, t, 1, 0, 0);
        HALF_STEP(pA0, pA1, mnA, alA, pB0, pB1, alB, t + 1, 0, 1, 1);
    }
    const bool even = (NT & 1) == 0;
    if (even) { SBAR(); qkt<1, BIAS>(pB0, pB1, K_lds, B_lds, r32, hi, S.qr); SBAR(); }
    SLOAD_H(nxt, kbn, 0); SBAR();
#pragma unroll
    for (int d0 = 0; d0 < 8; ++d0) S.qr[d0] = load8(nxt.Q + (size_t)(wid * QBLK + r32) * QS + d0 * 16 + hi * 8);
    SBAR();
    finishSM(pA0, pA1, alA, l_reg, pa0, pa1, pa2, pa3); SBAR();
    pv_tile<0>(o, vb0, pa0, pa1, pa2, pa3);
    if (even) { MASKT(pB0, pB1, NT - 1, 1); partialSM(pB0, pB1, m_reg, mnB, alB); __syncthreads(); RESC(alB);
        finishSM(pB0, pB1, alB, l_reg, pa0, pa1, pa2, pa3); SBAR(); pv_tile<1>(o, vb0, pa0, pa1, pa2, pa3); }
    SBAR(); SEAM_K0();
    if (hi == 0) li_l[r32] = l_reg; asm volatile("s_waitcnt lgkmcnt(0)" ::: "memory");
    float rli[16];
#pragma unroll
    for (int r = 0; r < 16; ++r) rli[r] = __builtin_amdgcn_rcpf(li_l[crow(r, hi)]);
    int tid_e = threadIdx.x; asm volatile("" : "+v"(tid_e)); const int lane_e = tid_e & 63;
    const int r32e = lane_e & 31, hie = lane_e >> 5;
    bf16* Ow = cur.O + (size_t)(wid * QBLK + 4 * hie) * OS + r32e;
#pragma unroll
    for (int r = 0; r < 16; ++r) { const int orow = (r & 3) + 8 * (r >> 2);
#pragma unroll
        for (int d0 = 0; d0 < 4; ++d0) { const float v = o[d0][r] * rli[r];
            const float vn = __shfl_xor(v, 1);
            if ((r32e & 1) == 0) *(unsigned*)(Ow + (size_t)orow * OS + d0 * 32) = cvtpk(v, vn); } }
    __syncthreads();
#undef RESC
#undef KBASE
#undef MASKT
#undef SEAM_K0
#undef HALF_STEP
}
#undef ROWK
#undef ROWV
#undef VMW
#undef VMWN
#undef SLOAD_H
#undef SWRITE_HK
#undef SWRITE_HV
#undef SWRITE_H
#undef KSWZ
#undef SBAR
}
namespace gla {
typedef float f32x16 __attribute__((ext_vector_type(16)));
typedef short s16x4 __attribute__((ext_vector_type(4)));
constexpr int CH = 64, NCH = SEQ / CH, DK = 256, DV = 512, NH = 4;
constexpr int L_QK = 0, QK_BYTES = 32768, NQK = 3;
constexpr int L_VA = NQK * QK_BYTES, VA_BYTES = 25600;
constexpr int LDS_BYTES = L_VA + 2 * VA_BYTES;

__device__ __forceinline__ unsigned swz(unsigned row) { return ((row & 3u) << 2) | ((row >> 2) & 3u); }
__device__ __forceinline__ unsigned off_b(unsigned row, unsigned ch) { return 256u * row + 16u * (ch ^ swz(row)); }
__device__ __forceinline__ unsigned row_read_addr(unsigned lane, unsigned s) { return off_b(lane & 31u, 2u * s + (lane >> 5)); }
__device__ __forceinline__ unsigned tr_read_addr(unsigned lane, unsigned c, unsigned ks, unsigned t) {
    const unsigned h = lane >> 5, blk = (lane >> 4) & 1u, q = (lane & 15u) >> 2, p = lane & 3u;
    return off_b(16u * ks + 8u * h + 4u * t + q, 4u * c + 2u * blk + (p >> 1)) + 8u * (p & 1u);
}
__device__ __forceinline__ unsigned cvtpk(float lo, float hi) { unsigned r; asm volatile("v_cvt_pk_bf16_f32 %0, %1, %2" : "=v"(r) : "v"(lo), "v"(hi)); return r; }
#define GLA_TRRD(dst, addr) asm volatile("ds_read_b64_tr_b16 %0, %1" : "=&v"(dst) : "v"(addr) : "memory")
#define GLA_LWAIT() do { asm volatile("s_waitcnt lgkmcnt(0)" ::: "memory"); __builtin_amdgcn_sched_barrier(0); } while (0)

__device__ __forceinline__ void apass_job(const bf16* QT, const bf16* KT, bf16* AT, int job, int lane) {
    const int tile = job % 3, cc = job / 3, c = cc & (NCH - 1), bh = cc >> 6;
    const int tm = tile ? 1 : 0, tn = tile == 2 ? 1 : 0, r32 = lane & 31, h = lane >> 5;
    const bf16* qrow = QT + ((size_t)bh * SEQ + c * CH + 32 * tm + r32) * DK + 8 * h;
    const bf16* krow = KT + ((size_t)bh * SEQ + c * CH + 32 * tn + r32) * DK + 8 * h;
    f32x16 acc = {};
#pragma unroll
    for (int kb = 0; kb < 4; ++kb) {
        bf16x8 qa[4], ka[4];
#pragma unroll
        for (int k = 0; k < 4; ++k) { qa[k] = *(const bf16x8*)(qrow + 16 * (4 * kb + k)); ka[k] = *(const bf16x8*)(krow + 16 * (4 * kb + k)); }
#pragma unroll
        for (int k = 0; k < 4; ++k) acc = __builtin_amdgcn_mfma_f32_32x32x16_bf16(ka[k], qa[k], acc, 0, 0, 0);
    }
    const int t = 32 * tm + r32;
    bf16* dst = AT + (((size_t)bh * NCH + c) * CH + t) * CH + 32 * tn + 4 * h;
#pragma unroll
    for (int g = 0; g < 4; ++g) {
        const int s0 = 32 * tn + 8 * g + 4 * h;
        float v[4];
#pragma unroll
        for (int e = 0; e < 4; ++e) v[e] = (s0 + e <= t) ? acc[4 * g + e] : 0.f;
        *(v2u*)(dst + 8 * g) = (v2u){cvtpk(v[0], v[1]), cvtpk(v[2], v[3])};
    }
}

struct ScanRef { const bf16* QT; const bf16* KT; const bf16* VG; const bf16* AT; const float* EBL; float* O; };

__device__ __forceinline__ void dma_qk(const ScanRef& R, LAS unsigned char* lds, int n, int nb, int hw, int lane_) {
    int lane = lane_; asm volatile("" : "+v"(lane));
    const int c = n >> 1, hh = n & 1; LAS unsigned char* buf = lds + L_QK + nb * QK_BYTES;
#pragma unroll
    for (int i = 0; i < 8; ++i) {
        const int j = i * 4 + hw;
        const int img = j >> 3, j8 = j & 7, row = 4 * j8 + (lane >> 4), ch = (lane & 15) ^ (int)swz((unsigned)row);
        const bf16* src = ((img >> 1) ? R.KT : R.QT) + ((size_t)(c * CH + 32 * (img & 1) + row)) * DK + 128 * hh + 8 * ch;
        __builtin_amdgcn_global_load_lds((const unsigned*)src, (LAS unsigned*)(buf + img * 8192 + j8 * 1024), 16, 0, 0);
    }
}
__device__ __forceinline__ void dma_va(const ScanRef& R, LAS unsigned char* lds, int c, int hw, int lane_) {
    int lane = lane_; asm volatile("" : "+v"(lane));
    LAS unsigned char* buf = lds + L_VA + (c & 1) * VA_BYTES;
#pragma unroll
    for (int i = 0; i < 7; ++i) {
        const int j = i * 4 + hw;
        const int j8 = j & 7, row = 4 * j8 + (lane >> 4), ch = (lane & 15) ^ (int)swz((unsigned)row);
        if (j < 16) {
            const bf16* src = R.VG + ((size_t)(c * CH + 32 * (j >> 3) + row)) * DV + 8 * ch;
            __builtin_amdgcn_global_load_lds((const unsigned*)src, (LAS unsigned*)(buf + (j >> 3) * 8192 + j8 * 1024), 16, 0, 0);
        } else if (j < 24) {
            const int t = row + 32 * (ch >> 3), s0 = 8 * (ch & 7);
            const bf16* src = R.AT + ((size_t)c * CH + t) * CH + s0;
            __builtin_amdgcn_global_load_lds((const unsigned*)src, (LAS unsigned*)(buf + 16384 + j8 * 1024), 16, 0, 0);
        } else {
            const float* src = R.EBL + (size_t)c * DK + 4 * lane;
            __builtin_amdgcn_global_load_lds((const unsigned*)src, (LAS unsigned*)(buf + 24576), 16, 0, 0);
        }
    }
}

__device__ __forceinline__ unsigned vxor(unsigned a, const unsigned k) { unsigned r; asm volatile("v_xor_b32 %0, %1, %2" : "=v"(r) : "i"(k), "v"(a)); return r; }
#define GLA_TRRDO(dst, addr, off) asm volatile("ds_read_b64_tr_b16 %0, %1 offset:%2" : "=&v"(dst) : "v"(addr), "i"(off) : "memory")
#define GLA_LWAITN(n) do { asm volatile("s_waitcnt lgkmcnt(" #n ")" ::: "memory"); __builtin_amdgcn_sched_barrier(0); } while (0)
template <int HH>
__device__ __forceinline__ void scan_half(f32x16 (&S)[8], f32x16 (&acc)[2], bf16x8 (&vf)[4], unsigned qk, unsigned va, int w, float* Orow) {
    int t_ = threadIdx.x; asm volatile("" : "+v"(t_));
    const unsigned lane = (unsigned)t_ & 63u, r32 = lane & 31u, h = lane >> 5, blk = (lane >> 4) & 1u, q = (lane & 15u) >> 2, p = lane & 3u;
    const unsigned sw = swz(r32);
    const unsigned qbase = 256u * r32 + (sw << 4) + 8u * h + qk;
    const unsigned abase = (256u * r32 + (sw << 4)) ^ (h << 4);
    const unsigned tr0 = 256u * (8u * h + q) + 8u * (p & 1u) + 16u * ((2u * blk + (p >> 1)) ^ (2u * h)) + 64u * q;
    const unsigned tr1 = 256u * (8u * h + 4u + q) + 8u * (p & 1u) + 16u * ((2u * blk + (p >> 1)) ^ (2u * h + 1u)) + 64u * q;
    const unsigned kb0 = tr0 + qk + 16384u, kb1 = tr1 + qk + 16384u;
    s16x4 loA[4], hiA[4];
#define GLA_LOADK(il, lo, hi) do { const unsigned k0_ = vxor(kb0, (unsigned)((il) << 6)), k1_ = vxor(kb1, (unsigned)((il) << 6)); \
        _Pragma("unroll") for (int kk = 0; kk < 4; ++kk) { GLA_TRRDO(lo[kk], k0_, (kk >> 1) * 8192 + (kk & 1) * 4096); GLA_TRRDO(hi[kk], k1_, (kk >> 1) * 8192 + (kk & 1) * 4096); } } while (0)
#define GLA_MMAK(il, lo, hi) do { f32x16& X = S[4 * HH + (il)]; \
        _Pragma("unroll") for (int kk = 0; kk < 4; ++kk) X = __builtin_amdgcn_mfma_f32_32x32x16_bf16((bf16x8){lo[kk][0], lo[kk][1], lo[kk][2], lo[kk][3], hi[kk][0], hi[kk][1], hi[kk][2], hi[kk][3]}, vf[kk], X, 0, 0, 0); } while (0)
#define GLA_SCALE(il) do { f32x16& X = S[4 * HH + (il)]; \
        const LAS float* eb = (const LAS float*)(uintptr_t)(va + 24576u + 4u * (32u * (4 * HH + (il)) + 4u * h)); \
        _Pragma("unroll") for (int g = 0; g < 4; ++g) { const f32x4 e = *(const LAS f32x4*)(eb + 8 * g); X[4 * g + 0] *= e.x; X[4 * g + 1] *= e.y; X[4 * g + 2] *= e.z; X[4 * g + 3] *= e.w; } } while (0)
    if constexpr (HH == 0) {
        const unsigned v0 = (tr0 ^ ((unsigned)w << 6)) + va, v1 = (tr1 ^ ((unsigned)w << 6)) + va;
        s16x4 lo[4], hi[4];
#pragma unroll
        for (int kk = 0; kk < 4; ++kk) { GLA_TRRDO(lo[kk], v0, (kk >> 1) * 8192 + (kk & 1) * 4096); GLA_TRRDO(hi[kk], v1, (kk >> 1) * 8192 + (kk & 1) * 4096); }
        GLA_LWAITN(0);
#pragma unroll
        for (int kk = 0; kk < 4; ++kk) vf[kk] = (bf16x8){lo[kk][0], lo[kk][1], lo[kk][2], lo[kk][3], hi[kk][0], hi[kk][1], hi[kk][2], hi[kk][3]};
        acc[0] = f32x16{}; acc[1] = f32x16{};
        const unsigned ab = abase + va + 16384u;
#pragma unroll
        for (int m = 0; m < 2; ++m)
#pragma unroll
            for (int kk = 0; kk < 2 + 2 * m; ++kk) { const bf16x8 a = *(const LAS bf16x8*)(uintptr_t)vxor(ab, (unsigned)((4 * m + kk) << 5)); acc[m] = __builtin_amdgcn_mfma_f32_32x32x16_bf16(a, vf[kk], acc[m], 0, 0, 0); }
    }
    GLA_LOADK(0, loA, hiA);
#pragma unroll
    for (int il = 0; il < 4; ++il) {
        const f32x16& X = S[4 * HH + il];
#pragma unroll
        for (int s2 = 0; s2 < 2; ++s2) {
            const v4u bw = {cvtpk(X[8 * s2 + 0], X[8 * s2 + 1]), cvtpk(X[8 * s2 + 2], X[8 * s2 + 3]), cvtpk(X[8 * s2 + 4], X[8 * s2 + 5]), cvtpk(X[8 * s2 + 6], X[8 * s2 + 7])};
            const bf16x8 bfr = __builtin_bit_cast(bf16x8, bw);
            const unsigned a0 = vxor(qbase, (unsigned)((4 * il + 2 * s2) << 4)), a1 = vxor(qbase, (unsigned)((4 * il + 2 * s2 + 1) << 4));
#pragma unroll
            for (int m = 0; m < 2; ++m) {
                const v2u p0 = *(const LAS v2u*)(uintptr_t)(a0 + m * 8192), p1 = *(const LAS v2u*)(uintptr_t)(a1 + m * 8192);
                const v4u aw = {p0.x, p0.y, p1.x, p1.y};
                acc[m] = __builtin_amdgcn_mfma_f32_32x32x16_bf16(__builtin_bit_cast(bf16x8, aw), bfr, acc[m], 0, 0, 0);
            }
        }
    }
    if constexpr (HH == 1) {
        float* ob = Orow + (size_t)(4u * h) * DM + 32 * w + r32;
#pragma unroll
        for (int m = 0; m < 2; ++m)
#pragma unroll
            for (int r = 0; r < 16; ++r) ob[(size_t)(32 * m + (r & 3) + 8 * (r >> 2)) * DM] = acc[m][r];
    }
    GLA_LWAITN(0); GLA_MMAK(0, loA, hiA); __builtin_amdgcn_sched_barrier(0); GLA_LOADK(1, loA, hiA); GLA_SCALE(0);
    GLA_LWAITN(0); GLA_MMAK(1, loA, hiA); __builtin_amdgcn_sched_barrier(0); GLA_LOADK(2, loA, hiA); GLA_SCALE(1);
    GLA_LWAITN(0); GLA_MMAK(2, loA, hiA); __builtin_amdgcn_sched_barrier(0); GLA_LOADK(3, loA, hiA); GLA_SCALE(2);
    GLA_LWAITN(0); GLA_MMAK(3, loA, hiA); GLA_SCALE(3);
#undef GLA_LOADK
#undef GLA_MMAK
#undef GLA_SCALE
}

__device__ __forceinline__ void scan_item(const ScanRef& R, LAS unsigned char* lds) {
    int tid_ = threadIdx.x; asm volatile("" : "+v"(tid_));
    const int tid = tid_, wid = __builtin_amdgcn_readfirstlane(tid >> 6), lane = tid & 63;
    __syncthreads();
#define GLA_BAR() do { asm volatile("s_waitcnt lgkmcnt(0)" ::: "memory"); __builtin_amdgcn_s_barrier(); asm volatile("" ::: "memory"); } while (0)
    if (wid >= 4) {
        const int hw = wid & 3; int nb = 0;
        dma_qk(R, lds, 0, 0, hw, lane); dma_qk(R, lds, 1, 1, hw, lane); dma_va(R, lds, 0, hw, lane); asm volatile("s_waitcnt vmcnt(0)" ::: "memory");
        for (int c = 0; c < NCH; ++c) {
            GLA_BAR();
            { const int nb2 = nb >= 1 ? nb - 1 : 2;
              if (c + 1 < NCH) { dma_qk(R, lds, 2 * c + 2, nb2, hw, lane); dma_va(R, lds, c + 1, hw, lane); asm volatile("s_waitcnt vmcnt(15)" ::: "memory"); }
              else asm volatile("s_waitcnt vmcnt(0)" ::: "memory"); }
            nb = nb == 2 ? 0 : nb + 1;
            GLA_BAR();
            { const int nb2 = nb >= 1 ? nb - 1 : 2;
              if (c + 1 < NCH) { dma_qk(R, lds, 2 * c + 3, nb2, hw, lane); asm volatile("s_waitcnt vmcnt(8)" ::: "memory"); }
              else asm volatile("s_waitcnt vmcnt(0)" ::: "memory"); }
            nb = nb == 2 ? 0 : nb + 1;
        }
        GLA_BAR();
    } else {
        f32x16 S[8]; f32x16 acc[2]; bf16x8 vf[4]; int nb = 0;
#pragma unroll
        for (int i = 0; i < 8; ++i) S[i] = f32x16{};
        acc[0] = f32x16{}; acc[1] = f32x16{};
#pragma unroll
        for (int i = 0; i < 4; ++i) vf[i] = bf16x8{};
        for (int c = 0; c < NCH; ++c) {
            const unsigned va = (unsigned)(L_VA + (c & 1) * VA_BYTES);
            GLA_BAR();
            scan_half<0>(S, acc, vf, (unsigned)(L_QK + nb * QK_BYTES), va, wid, R.O + (size_t)c * CH * DM);
            nb = nb == 2 ? 0 : nb + 1;
            GLA_BAR();
            scan_half<1>(S, acc, vf, (unsigned)(L_QK + nb * QK_BYTES), va, wid, R.O + (size_t)c * CH * DM);
            nb = nb == 2 ? 0 : nb + 1;
        }
        GLA_BAR();
    }
#undef GLA_BAR
}
#undef GLA_TRRD
#undef GLA_TRRDO
#undef GLA_LWAIT
#undef GLA_LWAITN
}
constexpr int NWAVES = 8;
constexpr int LDS_BYTES = 163840;
constexpr int RING_BYTES = 131072;
constexpr int CTLW = 159744;

constexpr size_t MiB = (size_t)1 << 20;
constexpr size_t WS_CTL = 0, CTL_BYTES = 1 * MiB;
constexpr size_t WS_WTIN = CTL_BYTES;
constexpr size_t WS_WTBG = WS_WTIN + (size_t)INCP * DM * 2;
constexpr size_t WS_WTBF = WS_WTBG + (size_t)DM * DM * 2;
constexpr size_t WS_WTOUT = WS_WTBF + (size_t)DM * DM * 2;
constexpr size_t WS_WTMQ = WS_WTOUT + (size_t)DM * DM * 2;
constexpr size_t WS_WTMKV = WS_WTMQ + (size_t)512 * DM * 2;
constexpr size_t WS_WTMO = WS_WTMKV + (size_t)1024 * DM * 2;
constexpr size_t WS_WTUP = WS_WTMO + (size_t)DM * 512 * 2;
constexpr size_t WS_WTDN = WS_WTUP + (size_t)NE * 4096 * DM * 2;
constexpr size_t WS_WRT = WS_WTDN + (size_t)NE * DM * DM * 2;
constexpr size_t WS_QT = WS_WRT + (size_t)256 * DM * 2;
constexpr size_t WS_KT = WS_QT + (size_t)T * 1024 * 2;
constexpr size_t WS_VG = WS_KT + (size_t)T * 1024 * 2;
constexpr size_t WS_SG = WS_VG + (size_t)T * DM * 2;
constexpr size_t WS_FQH = WS_SG + (size_t)T * DM * 2;
constexpr size_t WS_FKH = WS_FQH + (size_t)T * DM * 2;
constexpr size_t WS_FVH = WS_FKH + (size_t)T * DM * 2;
constexpr size_t WS_GG = WS_FVH + (size_t)T * DM * 2;
constexpr size_t WS_GF = WS_GG + (size_t)T * DM * 2;
constexpr size_t WS_YB = WS_QT;
static_assert(WS_GF + (size_t)T * DM * 2 - WS_QT >= (size_t)PMAX * DM * 2, "YB overlay");
constexpr size_t WS_OGLA = WS_GF + (size_t)T * DM * 2;
constexpr size_t WS_Y2 = WS_OGLA + (size_t)T * DM * 4;
constexpr size_t WS_H = WS_Y2 + (size_t)T * DM * 4;
constexpr size_t WS_ACT = WS_OGLA;
static_assert(WS_H + (size_t)T * DM * 2 - WS_OGLA >= (size_t)PMAX * DM * 2, "ACT overlay");
constexpr size_t WS_Y1 = WS_H + (size_t)T * DM * 2;
constexpr size_t WS_X1 = WS_Y1 + (size_t)T * DM * 4;
constexpr size_t WS_X2 = WS_X1 + (size_t)T * DM * 4;
constexpr size_t WS_ATT = WS_X2 + (size_t)T * DM * 4;
constexpr size_t WS_ON = WS_ATT + (size_t)T * DM * 2;
constexpr size_t WS_MRG = WS_ON + (size_t)T * DM * 2;
constexpr size_t WS_H2 = WS_MRG + (size_t)T * DM * 2;
constexpr size_t WS_XS = WS_H2 + (size_t)T * DM * 2;
constexpr size_t WS_OM = WS_XS + (size_t)T * DM * 2;
constexpr size_t WS_MN = WS_OM + (size_t)T * 512 * 2;
constexpr size_t WS_QM = WS_MN + (size_t)1024 * DM * 2;
constexpr size_t WS_KV = WS_QM + (size_t)T * 1024 * 4;
constexpr size_t WS_ASG = WS_KV + (size_t)1024 * 4096 * 4;
constexpr size_t WS_TOKL = WS_ASG + (size_t)NASG * 8;
constexpr size_t WS_WL = WS_TOKL + (size_t)NE * T * 4;
constexpr size_t WS_RSL = WS_WL + (size_t)NE * T * 4;
constexpr size_t WS_RSS1 = WS_RSL + (size_t)NE * T * 4;
constexpr size_t WS_RSS2 = WS_RSS1 + (size_t)T * 32 * 4;
constexpr size_t WS_LOG = WS_RSS2 + (size_t)T * 32 * 4;
constexpr size_t WS_EBL = WS_LOG + (size_t)T * 128 * 4;
constexpr size_t WS_AT = WS_EBL + (size_t)16 * 64 * 256 * 4;
constexpr size_t WS_GAFF = WS_AT + (size_t)16 * 64 * 64 * 64 * 2;
constexpr size_t WS_CB = WS_GAFF + (size_t)T * 128 * 4;
constexpr size_t WS_QMB = WS_CB + (size_t)NB * 16 * SEQ * 4;
constexpr size_t WS_KNB = WS_QMB + (size_t)T * 512 * 2;
constexpr size_t WS_VB = WS_KNB + (size_t)NB * 4 * MEML * 128 * 2;
constexpr size_t WS_END = WS_VB + (size_t)NB * 4 * MEML * 128 * 2;
constexpr int CW_CNT = 0, CW_NT = 64, CW_FOXQ = 128  , CW_GLA = 1024  , CW_BAR = 4096;

struct Args { const float* in[27]; float* out; unsigned char* ws; int ph_lo, ph_hi; };
struct Frame { LAS unsigned char* lds; int tid, lane, wave, G, bid, gw, ngw; };

__device__ __forceinline__ void p0_transpose_item(const float* W, int K, int N, bf16* WT, LAS float* scr, int item, int lane) {
    const int nblk = N / 32, kb = item / nblk, nb = item % nblk, k0 = 64 * kb, n0 = 32 * nb;
#pragma unroll 8
    for (int i = 0; i < 32; ++i) { const int kk = 2 * i + (lane >> 5); scr[kk * 33 + (lane & 31)] = W[(size_t)(k0 + kk) * N + n0 + (lane & 31)]; }
    LDS_WAIT(); asm volatile("" ::: "memory");
    const int c = lane & 7;
#pragma unroll
    for (int j = 0; j < 4; ++j) { const int n = (lane >> 3) + 8 * j; const LAS float* s = scr + (8 * c) * 33 + n;
        v4u o; o.x = pk2(s[0 * 33], s[1 * 33]); o.y = pk2(s[2 * 33], s[3 * 33]); o.z = pk2(s[4 * 33], s[5 * 33]); o.w = pk2(s[6 * 33], s[7 * 33]);
        *(v4u*)(WT + (size_t)(n0 + n) * K + k0 + 8 * c) = o; }
    LDS_WAIT(); asm volatile("" ::: "memory");
}
__device__ __forceinline__ void transpose_job(Frame& F, const float* W, int K, int N, int batch, bf16* WT) {
    LAS float* scr = (LAS float*)(F.lds + F.wave * 16384);
    const int per = (K / 64) * (N / 32); const long total = (long)per * batch;
    for (long it = F.gw; it < total; it += F.ngw) { const int e = (int)(it / per), r = (int)(it % per);
        p0_transpose_item(W + (size_t)e * K * N, K, N, WT + (size_t)e * N * K, scr, r, F.lane); }
}
__device__ __forceinline__ void rms_row_bf16(const float* xrow, const float* g, bf16* orow, int lane) {
    const f32x4* xr = (const f32x4*)xrow + lane; const f32x4* gr = (const f32x4*)g + lane;
    f32x4 v[8]; float s = 0.f;
#pragma unroll
    for (int j = 0; j < 8; ++j) { v[j] = xr[64 * j]; s += (v[j].x * v[j].x + v[j].y * v[j].y) + (v[j].z * v[j].z + v[j].w * v[j].w); }
    const float r = 1.0f / sqrtf(wave_sum(s) * (1.f / DM) + EPS);
    v2u* o8 = (v2u*)orow + lane;
#pragma unroll
    for (int j = 0; j < 8; ++j) { const f32x4 gg = gr[64 * j]; v2u w; w.x = pk2(v[j].x * r * gg.x, v[j].y * r * gg.y); w.y = pk2(v[j].z * r * gg.z, v[j].w * r * gg.w); o8[64 * j] = w; }
}

__device__ __forceinline__ void rms_rows2_bf16(const float* xa, const float* xb, const float* g, bf16* oa, bf16* ob, int lane) {
    const f32x4* pa = (const f32x4*)xa + lane; const f32x4* pb = (const f32x4*)xb + lane; const f32x4* gr = (const f32x4*)g + lane;
    f32x4 va[8], vb[8]; float sa = 0.f, sb = 0.f;
#pragma unroll
    for (int j = 0; j < 8; ++j) va[j] = __builtin_nontemporal_load(pa + 64 * j);
#pragma unroll
    for (int j = 0; j < 8; ++j) vb[j] = __builtin_nontemporal_load(pb + 64 * j);
#pragma unroll
    for (int j = 0; j < 8; ++j) { sa += (va[j].x * va[j].x + va[j].y * va[j].y) + (va[j].z * va[j].z + va[j].w * va[j].w); sb += (vb[j].x * vb[j].x + vb[j].y * vb[j].y) + (vb[j].z * vb[j].z + vb[j].w * vb[j].w); }
    const float ra = __builtin_amdgcn_rsqf(wave_sum(sa) * (1.f / DM) + EPS), rb = __builtin_amdgcn_rsqf(wave_sum(sb) * (1.f / DM) + EPS);
    v2u* o8a = (v2u*)oa + lane; v2u* o8b = (v2u*)ob + lane;
#pragma unroll
    for (int j = 0; j < 8; ++j) { const f32x4 gg = gr[64 * j];
        __builtin_nontemporal_store((v2u){pk2(va[j].x * ra * gg.x, va[j].y * ra * gg.y), pk2(va[j].z * ra * gg.z, va[j].w * ra * gg.w)}, o8a + 64 * j);
        __builtin_nontemporal_store((v2u){pk2(vb[j].x * rb * gg.x, vb[j].y * rb * gg.y), pk2(vb[j].z * rb * gg.z, vb[j].w * rb * gg.w)}, o8b + 64 * j); }
}

__device__ __forceinline__ void naive_attn_row(const float* qrow, const float* Kb, size_t kstride, const float* Vb, size_t vstride, const float* cb, float ct, int nk, float scale,
                                               int lane, float& o0, float& o1) {
    const f32x2 q = *(const f32x2*)(qrow + 2 * lane);
    float m = -1e30f, l = 0.f, a0 = 0.f, a1 = 0.f;
#pragma unroll 4
    for (int s = 0; s < nk; ++s) {
        const f32x2 kk = *(const f32x2*)(Kb + (size_t)s * kstride + 2 * lane);
        const f32x2 vv = *(const f32x2*)(Vb + (size_t)s * vstride + 2 * lane);
        float d = wave_sum(q.x * kk.x + q.y * kk.y) * scale;
        if (cb) d += ct - cb[s];
        const float mn = fmaxf(m, d), alpha = __expf(m - mn), p = __expf(d - mn);
        l = l * alpha + p; a0 = a0 * alpha + p * vv.x; a1 = a1 * alpha + p * vv.y; m = mn;
    }
    o0 = a0 / l; o1 = a1 / l;
}

__device__ __forceinline__ int win_row(int n) { return n < 6144 ? n : n < 6160 ? 16384 + (n - 6144) : n < 12304 ? n - 16 : n < 12320 ? 16400 + (n - 12304) : n - 32; }
__device__ __forceinline__ void transpose_win(Frame& F, const float* W, bf16* WT) {
    LAS float* scr = (LAS float*)(F.lds + F.wave * 16384);
    constexpr int K = DM, N = INC, total = (K / 64) * 2;
    for (int it = F.gw; it < total; it += F.ngw) {
        const int kb = it >> 1, k0 = 64 * kb, n0 = (it & 1) ? 12304 : 6144, lane = F.lane;
#pragma unroll 8
        for (int i = 0; i < 16; ++i) { const int kk = 4 * i + (lane >> 4); scr[kk * 17 + (lane & 15)] = W[(size_t)(k0 + kk) * N + n0 + (lane & 15)]; }
        LDS_WAIT(); asm volatile("" ::: "memory");
        const int c = lane & 7, r0 = win_row(n0);
#pragma unroll
        for (int j = 0; j < 2; ++j) { const int n = (lane >> 3) + 8 * j; const LAS float* sp = scr + (8 * c) * 17 + n;
            v4u o; o.x = pk2(sp[0 * 17], sp[1 * 17]); o.y = pk2(sp[2 * 17], sp[3 * 17]); o.z = pk2(sp[4 * 17], sp[5 * 17]); o.w = pk2(sp[6 * 17], sp[7 * 17]);
            *(v4u*)(WT + (size_t)(r0 + n) * K + k0 + 8 * c) = o; }
        LDS_WAIT(); asm volatile("" ::: "memory");
    }
}
__device__ __forceinline__ void transpose_win64(LAS unsigned char* lds, const float* W, bf16* WT, int gw, int ngw) {
    int t_ = threadIdx.x; asm volatile("" : "+v"(t_));
    const int wid = __builtin_amdgcn_readfirstlane(t_ >> 6), lane = t_ & 63;
    LAS unsigned char* tile = lds + wid * 19456;
    const unsigned tbase = (unsigned)(size_t)tile;
    const int lr = lane >> 4, lc = lane & 15, g = lane >> 4, q = (lane & 15) >> 2, p = lane & 3;
    const unsigned wr_off = (unsigned)(lr * 160 + lc * 8), tr_off = (unsigned)(q * 160 + (g * 16 + 4 * p) * 2);
    const unsigned ldo = (unsigned)(lr * INC * 4 + lc * 16), sto = (unsigned)((lane >> 3) * (DM * 2) + (lane & 7) * 16);
    constexpr int total = (DM / 64) * 256; constexpr unsigned rs = 4u * INC * 4u;
#define TW_SRC(it_, sp_, dp_) do { const int kb_ = (it_) >> 8, d0_ = 64 * ((it_) & 255), n0_ = d0_ + (d0_ < 6144 ? 0 : d0_ < 12288 ? 16 : 32); \
        sp_ = (const char*)W + ((size_t)(64 * kb_) * INC + n0_) * 4; dp_ = (char*)WT + ((size_t)d0_ * DM + 64 * kb_) * 2; } while (0)
#define TW_LOAD(R_, sp_) do { _Pragma("unroll") for (int i = 0; i < 16; ++i) R_[i] = __builtin_nontemporal_load((const f32x4*)(sp_ + (ldo + (unsigned)i * rs))); } while (0)
#define TW_PROC(R_, dp_) do { \
        _Pragma("unroll") for (int i = 0; i < 16; ++i) { const v2u w = {pk2(R_[i].x, R_[i].y), pk2(R_[i].z, R_[i].w)}; *(LAS v2u*)(tile + wr_off + i * 640) = w; } \
        asm volatile("s_waitcnt lgkmcnt(0)" ::: "memory"); \
        _Pragma("unroll") for (int hb_ = 0; hb_ < 2; ++hb_) { v2u ta_[4], tb_[4]; \
            _Pragma("unroll") for (int jj = 0; jj < 4; ++jj) { \
                asm volatile("ds_read_b64_tr_b16 %0, %1 offset:%2" : "=&v"(ta_[jj]) : "v"(tbase + tr_off), "i"((4 * hb_ + jj) * 1280) : "memory"); \
                asm volatile("ds_read_b64_tr_b16 %0, %1 offset:%2" : "=&v"(tb_[jj]) : "v"(tbase + tr_off), "i"((4 * hb_ + jj) * 1280 + 640) : "memory"); } \
            asm volatile("s_waitcnt lgkmcnt(0)" : "+v"(ta_[0]), "+v"(ta_[1]), "+v"(ta_[2]), "+v"(ta_[3]), "+v"(tb_[0]), "+v"(tb_[1]), "+v"(tb_[2]), "+v"(tb_[3]) :: "memory"); \
            _Pragma("unroll") for (int jj = 0; jj < 4; ++jj) *(LAS v4u*)(tile + 10240 + lane * 144 + (4 * hb_ + jj) * 16) = (v4u){ta_[jj].x, ta_[jj].y, tb_[jj].x, tb_[jj].y}; } \
        asm volatile("s_waitcnt lgkmcnt(0)" ::: "memory"); \
        _Pragma("unroll") for (int hf_ = 0; hf_ < 2; ++hf_) { v4u ow_[4]; \
            _Pragma("unroll") for (int s_ = 0; s_ < 4; ++s_) ow_[s_] = *(const LAS v4u*)(tile + 10240 + (8 * (4 * hf_ + s_) + (lane >> 3)) * 144 + (lane & 7) * 16); \
            _Pragma("unroll") for (int s_ = 0; s_ < 4; ++s_) __builtin_nontemporal_store(ow_[s_], (v4u*)(dp_ + (sto + (unsigned)(8 * (4 * hf_ + s_)) * (unsigned)(DM * 2)))); \
            asm volatile("" ::: "memory"); } \
        asm volatile("s_waitcnt lgkmcnt(0)" ::: "memory"); } while (0)
    f32x4 RA[16], RB[16]; const char* sA; const char* sB; char* dA; char* dB;
    int it = gw;
    if (it < total) { TW_SRC(it, sA, dA); TW_LOAD(RA, sA); }
    while (it < total) {
        const int i1 = it + ngw, i2 = it + 2 * ngw;
        if (i1 < total) { TW_SRC(i1, sB, dB); TW_LOAD(RB, sB); }
        TW_PROC(RA, dA);
        if (i1 >= total) break;
        if (i2 < total) { TW_SRC(i2, sA, dA); TW_LOAD(RA, sA); }
        TW_PROC(RB, dB);
        it = i2;
    }
#undef TW_SRC
#undef TW_LOAD
#undef TW_PROC
}
__device__ __forceinline__ void transpose64(LAS unsigned char* lds, const float* W, int K, int N, bf16* WT, int gw, int ngw) {
    int t_ = threadIdx.x; asm volatile("" : "+v"(t_));
    const int wid = __builtin_amdgcn_readfirstlane(t_ >> 6), lane = t_ & 63;
    LAS unsigned char* tile = lds + wid * 19456;
    const unsigned tbase = (unsigned)(size_t)tile;
    const int lr = lane >> 4, lc = lane & 15, g = lane >> 4, q = (lane & 15) >> 2, p = lane & 3;
    const unsigned wr_off = (unsigned)(lr * 160 + lc * 8), tr_off = (unsigned)(q * 160 + (g * 16 + 4 * p) * 2);
    const unsigned ldo = (unsigned)(lr * N * 4 + lc * 16), sto = (unsigned)((lane >> 3) * (K * 2) + (lane & 7) * 16), rs = 16u * (unsigned)N, ds8 = 8u * (unsigned)(K * 2);
    const int nbk = N >> 6, total = (K >> 6) * nbk;
#define TG_SRC(it_, sp_, dp_) do { const int kb_ = (it_) / nbk, nb_ = (it_) - kb_ * nbk; \
        sp_ = (const char*)W + ((size_t)(64 * kb_) * N + 64 * nb_) * 4; dp_ = (char*)WT + ((size_t)(64 * nb_) * K + 64 * kb_) * 2; } while (0)
#define TG_LOAD(R_, sp_) do { _Pragma("unroll") for (int i = 0; i < 16; ++i) R_[i] = __builtin_nontemporal_load((const f32x4*)(sp_ + (ldo + (unsigned)i * rs))); } while (0)
#define TG_PROC(R_, dp_) do { \
        _Pragma("unroll") for (int i = 0; i < 16; ++i) { const v2u w = {pk2(R_[i].x, R_[i].y), pk2(R_[i].z, R_[i].w)}; *(LAS v2u*)(tile + wr_off + i * 640) = w; } \
        asm volatile("s_waitcnt lgkmcnt(0)" ::: "memory"); \
        _Pragma("unroll") for (int hb_ = 0; hb_ < 2; ++hb_) { v2u ta_[4], tb_[4]; \
            _Pragma("unroll") for (int jj = 0; jj < 4; ++jj) { \
                asm volatile("ds_read_b64_tr_b16 %0, %1 offset:%2" : "=&v"(ta_[jj]) : "v"(tbase + tr_off), "i"((4 * hb_ + jj) * 1280) : "memory"); \
                asm volatile("ds_read_b64_tr_b16 %0, %1 offset:%2" : "=&v"(tb_[jj]) : "v"(tbase + tr_off), "i"((4 * hb_ + jj) * 1280 + 640) : "memory"); } \
            asm volatile("s_waitcnt lgkmcnt(0)" : "+v"(ta_[0]), "+v"(ta_[1]), "+v"(ta_[2]), "+v"(ta_[3]), "+v"(tb_[0]), "+v"(tb_[1]), "+v"(tb_[2]), "+v"(tb_[3]) :: "memory"); \
            _Pragma("unroll") for (int jj = 0; jj < 4; ++jj) *(LAS v4u*)(tile + 10240 + lane * 144 + (4 * hb_ + jj) * 16) = (v4u){ta_[jj].x, ta_[jj].y, tb_[jj].x, tb_[jj].y}; } \
        asm volatile("s_waitcnt lgkmcnt(0)" ::: "memory"); \
        _Pragma("unroll") for (int hf_ = 0; hf_ < 2; ++hf_) { v4u ow_[4]; \
            _Pragma("unroll") for (int s_ = 0; s_ < 4; ++s_) ow_[s_] = *(const LAS v4u*)(tile + 10240 + (8 * (4 * hf_ + s_) + (lane >> 3)) * 144 + (lane & 7) * 16); \
            _Pragma("unroll") for (int s_ = 0; s_ < 4; ++s_) *(v4u*)(dp_ + (sto + (unsigned)(4 * hf_ + s_) * ds8)) = ow_[s_]; \
            asm volatile("" ::: "memory"); } \
        asm volatile("s_waitcnt lgkmcnt(0)" ::: "memory"); } while (0)
    f32x4 RA[16], RB[16]; const char* sA; const char* sB; char* dA; char* dB;
    int it = gw;
    if (it < total) { TG_SRC(it, sA, dA); TG_LOAD(RA, sA); }
    while (it < total) {
        const int i1 = it + ngw, i2 = it + 2 * ngw;
        if (i1 < total) { TG_SRC(i1, sB, dB); TG_LOAD(RB, sB); }
        TG_PROC(RA, dA);
        if (i1 >= total) break;
        if (i2 < total) { TG_SRC(i2, sA, dA); TG_LOAD(RA, sA); }
        TG_PROC(RB, dB);
        it = i2;
    }
#undef TG_SRC
#undef TG_LOAD
#undef TG_PROC
}
struct EpiInProj {
    static constexpr bool PERM = true;
    bf16 *QT, *VG, *SG, *FQ, *GG; float* GAFF;
    __device__ __forceinline__ void operator()(const f32x4 (&acc)[2][2][4][2], const pg8::Unit& u, int wr, int wc, int fr, int fq) const {
        const int pn = u.pn, row0 = u.pm * 256 + wr * 64 + fr, b = row0 >> 12, s0 = row0 & (SEQ - 1), cl = wc * 32 + 8 * fq;
        if (pn == 64) {
            if (wc == 0) {
#pragma unroll
                for (int ai = 0; ai < 2; ++ai)
#pragma unroll
                    for (int m = 0; m < 4; ++m) { float* d = GAFF + (size_t)(row0 + ai * 128 + m * 16) * 32 + 8 * fq; *(f32x4*)d = acc[ai][0][m][0]; *(f32x4*)(d + 4) = acc[ai][0][m][1]; }
            }
            return;
        }
        bf16* base0; bf16* base1; int rs, act = 0;
        if (pn < 8)       { base0 = QT + (size_t)(pn >> 2) * ((size_t)T * 1024) + (size_t)(b * 4 + (pn & 3)) * SEQ * 256 + cl; base1 = base0 + 128; rs = 256; }
        else if (pn < 16) { const int t = pn - 8; base0 = VG + (size_t)(b * 4 + (t >> 1)) * SEQ * 512 + 256 * (t & 1) + cl; base1 = base0 + 128; rs = 512; }
        else if (pn < 24) { base0 = SG + (size_t)b * SEQ * DM + 256 * (pn - 16) + cl; base1 = base0 + 128; rs = DM; act = 1; }
        else if (pn < 48) { const int t = (pn - 24) & 7; base0 = FQ + (size_t)((pn - 24) >> 3) * ((size_t)T * DM) + (size_t)(b * 16 + 2 * t) * SEQ * 128 + cl; base1 = base0 + (size_t)SEQ * 128; rs = 128; }
        else              { base0 = GG + (size_t)((pn - 48) >> 3) * ((size_t)T * DM) + (size_t)b * SEQ * DM + 256 * ((pn - 48) & 7) + cl; base1 = base0 + 128; rs = DM; act = 2; }
#pragma unroll
        for (int ai = 0; ai < 2; ++ai)
#pragma unroll
            for (int m = 0; m < 4; ++m) { const size_t ro = (size_t)(s0 + ai * 128 + m * 16) * rs;
#pragma unroll
                for (int bj = 0; bj < 2; ++bj) { f32x4 v0 = acc[ai][bj][m][0], v1 = acc[ai][bj][m][1];
                    if (act == 1) {
#pragma unroll
                        for (int j = 0; j < 4; ++j) { v0[j] = v0[j] * sigmoid_f(v0[j]); v1[j] = v1[j] * sigmoid_f(v1[j]); } }
                    else if (act == 2) {
#pragma unroll
                        for (int j = 0; j < 4; ++j) { v0[j] = sigmoid_f(v0[j]); v1[j] = sigmoid_f(v1[j]); } }
                    v4u w; w.x = pg8::cvt_pk_bf16(v0[0], v0[1]); w.y = pg8::cvt_pk_bf16(v0[2], v0[3]); w.z = pg8::cvt_pk_bf16(v1[0], v1[1]); w.w = pg8::cvt_pk_bf16(v1[2], v1[3]);
                    *(v4u*)((bj ? base1 : base0) + ro) = w; } }
    }
};


template <int STAGE> struct EpiGate {
    static constexpr bool PERM = true;
    bf16* Y; const bf16* G; bf16* M;
    __device__ __forceinline__ void operator()(const f32x4 (&acc)[2][2][4][2], const pg8::Unit& u, int wr, int wc, int fr, int fq) const {
        const size_t o00 = (size_t)(u.pm * 256 + wr * 64 + fr) * DM + u.pn * 256 + wc * 32 + 8 * fq;
#pragma unroll
        for (int ai = 0; ai < 2; ++ai) {
            v4u gw[4][2], yw[4][2];
#pragma unroll
            for (int m = 0; m < 4; ++m)
#pragma unroll
                for (int bj = 0; bj < 2; ++bj) { const size_t o = o00 + (size_t)(ai * 128 + m * 16) * DM + 128 * bj; gw[m][bj] = *(const v4u*)(G + o); if (STAGE == 1) yw[m][bj] = *(const v4u*)(Y + o); }
#pragma unroll
            for (int m = 0; m < 4; ++m)
#pragma unroll
                for (int bj = 0; bj < 2; ++bj) { const size_t o = o00 + (size_t)(ai * 128 + m * 16) * DM + 128 * bj; const v4u g = gw[m][bj];
                    const f32x4 g0 = {bf2f(g.x & 0xffffu), bf2f(g.x >> 16), bf2f(g.y & 0xffffu), bf2f(g.y >> 16)}, g1 = {bf2f(g.z & 0xffffu), bf2f(g.z >> 16), bf2f(g.w & 0xffffu), bf2f(g.w >> 16)};
                    f32x4 v0 = acc[ai][bj][m][0] * g0, v1 = acc[ai][bj][m][1] * g1;
                    if (STAGE == 1) { const v4u y = yw[m][bj]; v0 += (f32x4){bf2f(y.x & 0xffffu), bf2f(y.x >> 16), bf2f(y.y & 0xffffu), bf2f(y.y >> 16)}; v1 += (f32x4){bf2f(y.z & 0xffffu), bf2f(y.z >> 16), bf2f(y.w & 0xffffu), bf2f(y.w >> 16)}; }
                    *(v4u*)((STAGE == 0 ? Y : M) + o) = (v4u){pg8::cvt_pk_bf16(v0[0], v0[1]), pg8::cvt_pk_bf16(v0[2], v0[3]), pg8::cvt_pk_bf16(v1[0], v1[1]), pg8::cvt_pk_bf16(v1[2], v1[3])}; }
        }
    }
};
template <bool XBF16, bool BBF16> struct EpiRes {
    static constexpr bool PERM = true;
    const float* base; float* X; const float* gain; bf16* H; float* RSS;
    __device__ __forceinline__ void operator()(const f32x4 (&acc)[2][2][4][2], const pg8::Unit& u, int wr, int wc, int fr, int fq) const {
        const int row0 = u.pm * 256 + wr * 64 + fr, col0 = u.pn * 256 + wc * 32 + 8 * fq;
        f32x4 gv[2][2];
#pragma unroll
        for (int bj = 0; bj < 2; ++bj) { gv[bj][0] = *(const f32x4*)(gain + col0 + 128 * bj); gv[bj][1] = *(const f32x4*)(gain + col0 + 128 * bj + 4); }
#pragma unroll
        for (int ai = 0; ai < 2; ++ai) {
            f32x4 b0[4][2], b1[4][2];
#pragma unroll
            for (int m = 0; m < 4; ++m)
#pragma unroll
                for (int bj = 0; bj < 2; ++bj) { const size_t o = (size_t)(row0 + ai * 128 + m * 16) * DM + col0 + 128 * bj;
                    if (BBF16) { const v4u w = *(const v4u*)((const bf16*)base + o); b0[m][bj] = (f32x4){bf2f(w.x & 0xffffu), bf2f(w.x >> 16), bf2f(w.y & 0xffffu), bf2f(w.y >> 16)}; b1[m][bj] = (f32x4){bf2f(w.z & 0xffffu), bf2f(w.z >> 16), bf2f(w.w & 0xffffu), bf2f(w.w >> 16)}; }
                    else { b0[m][bj] = *(const f32x4*)(base + o); b1[m][bj] = *(const f32x4*)(base + o + 4); } }
#pragma unroll
            for (int m = 0; m < 4; ++m) { const int row = row0 + ai * 128 + m * 16; float ss = 0.f;
#pragma unroll
                for (int bj = 0; bj < 2; ++bj) { const size_t o = (size_t)row * DM + col0 + 128 * bj;
                    const f32x4 v0 = acc[ai][bj][m][0] + b0[m][bj], v1 = acc[ai][bj][m][1] + b1[m][bj];
                    if (XBF16) *(v4u*)((bf16*)X + o) = (v4u){pg8::cvt_pk_bf16(v0[0], v0[1]), pg8::cvt_pk_bf16(v0[2], v0[3]), pg8::cvt_pk_bf16(v1[0], v1[1]), pg8::cvt_pk_bf16(v1[2], v1[3])};
                    else { *(f32x4*)(X + o) = v0; *(f32x4*)(X + o + 4) = v1; }
                    ss += (v0[0] * v0[0] + v0[1] * v0[1] + v0[2] * v0[2] + v0[3] * v0[3]) + (v1[0] * v1[0] + v1[1] * v1[1] + v1[2] * v1[2] + v1[3] * v1[3]);
                    const f32x4 h0 = v0 * gv[bj][0], h1 = v1 * gv[bj][1];
                    *(v4u*)(H + o) = (v4u){pg8::cvt_pk_bf16(h0[0], h0[1]), pg8::cvt_pk_bf16(h0[2], h0[3]), pg8::cvt_pk_bf16(h1[0], h1[1]), pg8::cvt_pk_bf16(h1[2], h1[3])}; }
                ss += __shfl_xor(ss, 16); ss += __shfl_xor(ss, 32);
                if (fq == 0) RSS[(size_t)row * 32 + u.pn * 4 + wc] = ss; }
        }
    }
};

constexpr int MT_BASE = CTLW + 1024, MT_NRT = MT_BASE, MT_CNT = MT_BASE + 16, MT_PBASE = MT_CNT + 32 * 4, MT_TE = MT_PBASE + 36 * 4, MT_TP = MT_TE + MAXRT * 4, MT_END = MT_TP + MAXRT * 4;
static_assert(MT_END <= LDS_BYTES && gla::LDS_BYTES <= CTLW && fa::LDS_BYTES <= CTLW, "LDS map");
__device__ __forceinline__ void moe_tables(LAS unsigned char* lds, unsigned* ctl) {
    LAS int* nrt = (LAS int*)(lds + MT_NRT); LAS int* cnt = (LAS int*)(lds + MT_CNT); LAS int* pbase = (LAS int*)(lds + MT_PBASE); LAS int* te = (LAS int*)(lds + MT_TE); LAS int* tp = (LAS int*)(lds + MT_TP);
    __syncthreads();
    if (threadIdx.x < 64) {
        const int lane = threadIdx.x;
        const int c = lane < NE ? (int)xb_ld(ctl + CW_CNT + lane) : 0;
        const int nt = (c + 255) >> 8;
        int pre = nt;
#pragma unroll
        for (int o = 1; o < 32; o <<= 1) { const int y = __shfl_up(pre, o); if (lane >= o) pre += y; }
        const int first = pre - nt;
        if (lane < NE) { cnt[lane] = c; pbase[lane] = first * 256; for (int k = 0; k < nt; ++k) { te[first + k] = lane; tp[first + k] = k * 256; } }
        if (lane == NE - 1) { pbase[NE] = pre * 256; nrt[0] = pre; } }
    __syncthreads();
}
constexpr int SIDE_OFF = RING_BYTES, SIDE_STRIDE = 3072;
static_assert(SIDE_OFF + 3 * SIDE_STRIDE <= CTLW, "side tables");
template <bool UP> struct MoeOrder {
    static constexpr bool SIDE = true;
    LAS unsigned char* lds; const int* tokl; const float* rowscale; const float* bias; int nN, G, c;
    __device__ __forceinline__ bool next(int i, pg8::Unit& u) const {
        const int nrt = *(const LAS int*)(lds + MT_NRT); int rt, pn;
        if (G == 256) { const int x = c & 7, j = c >> 3, s = i * 8 + x, parts = nN >> 2, rg = s / parts, ph = s - rg * parts;
            rt = 8 * rg + (j >> 2); pn = 4 * ph + (j & 3); if (rt >= nrt) return false; }
        else { const long L = (long)i * G + c; if (L >= (long)nrt * nN) return false; rt = (int)(L / nN); pn = (int)(L % nN); }
        u.pm = rt; u.pn = pn; u.pb = ((const LAS int*)(lds + MT_TE))[rt] * nN + pn; u.kofs = 0; return true;
    }
    __device__ __forceinline__ void prefetch(const pg8::Unit& u, int sb, int wid, int lane) const {
        if (wid != 0) return;
        const int e = ((const LAS int*)(lds + MT_TE))[u.pm], p0 = ((const LAS int*)(lds + MT_TP))[u.pm];
        LAS unsigned char* dst = lds + SIDE_OFF + sb * SIDE_STRIDE;
        if (UP) __builtin_amdgcn_global_load_lds((const unsigned*)(tokl + (size_t)e * T + p0 + 4 * lane), (LAS unsigned*)dst, 16, 0, 0);
        __builtin_amdgcn_global_load_lds((const unsigned*)(rowscale + (size_t)e * T + p0 + 4 * lane), (LAS unsigned*)(dst + 1024), 16, 0, 0);
        const float* bsrc = UP ? bias + (size_t)e * 4096 + 128 * u.pn + (lane < 32 ? 4 * lane : 2048 + 4 * (lane - 32)) : bias + (size_t)e * DM + 256 * u.pn + 4 * lane;
        __builtin_amdgcn_global_load_lds((const unsigned*)bsrc, (LAS unsigned*)(dst + 2048), 16, 0, 0);
    }
    __device__ __forceinline__ const LAS int* tok_table(int sb) const { return (const LAS int*)(lds + SIDE_OFF + sb * SIDE_STRIDE); }
    __device__ __forceinline__ void a_ready(const pg8::Unit&) const {}
    __device__ __forceinline__ void done(const pg8::Unit&) const {}
};
struct EpiSwiglu {
    static constexpr bool PERM = true;
    bf16* act; LAS unsigned char* lds;
    __device__ __forceinline__ void operator()(const f32x4 (&acc)[2][2][4][2], const pg8::Unit& u, int wr, int wc, int fr, int fq) const {
        const int col = 128 * u.pn + wc * 32 + 8 * fq;
        const LAS unsigned char* side = lds + SIDE_OFF + u.sb * SIDE_STRIDE;
        const LAS float* rrow = (const LAS float*)(side + 1024) + wr * 64 + fr;
        const LAS float* bg = (const LAS float*)(side + 2048) + wc * 32 + 8 * fq;
        const f32x4 bg0 = *(const LAS f32x4*)bg, bg1 = *(const LAS f32x4*)(bg + 4), bl0 = *(const LAS f32x4*)(bg + 128), bl1 = *(const LAS f32x4*)(bg + 132);
        bf16* dst = act + (size_t)(u.pm * 256 + wr * 64 + fr) * DM + col;
#pragma unroll
        for (int ai = 0; ai < 2; ++ai)
#pragma unroll
            for (int m = 0; m < 4; ++m) {
                const float rs = rrow[ai * 128 + m * 16];
                const f32x4 g0 = acc[ai][0][m][0] * rs + bg0, g1 = acc[ai][0][m][1] * rs + bg1, l0 = acc[ai][1][m][0] * rs + bl0, l1 = acc[ai][1][m][1] * rs + bl1;
                float o[8];
#pragma unroll
                for (int j = 0; j < 4; ++j) { const float ga = fminf(g0[j], 7.f), gb = fminf(g1[j], 7.f), la_ = fminf(fmaxf(l0[j], -7.f), 7.f), lb = fminf(fmaxf(l1[j], -7.f), 7.f);
                    o[j] = ga * sigmoid_f(1.702f * ga) * (la_ + 1.f); o[4 + j] = gb * sigmoid_f(1.702f * gb) * (lb + 1.f); }
                *(v4u*)(dst + (size_t)(ai * 128 + m * 16) * DM) = (v4u){pg8::cvt_pk_bf16(o[0], o[1]), pg8::cvt_pk_bf16(o[2], o[3]), pg8::cvt_pk_bf16(o[4], o[5]), pg8::cvt_pk_bf16(o[6], o[7])};
            }
    }
};
struct EpiDown {
    static constexpr bool PERM = true;
    bf16* yb; LAS unsigned char* lds;
    __device__ __forceinline__ void operator()(const f32x4 (&acc)[2][2][4][2], const pg8::Unit& u, int wr, int wc, int fr, int fq) const {
        const int col = 256 * u.pn + wc * 32 + 8 * fq;
        const LAS unsigned char* side = lds + SIDE_OFF + u.sb * SIDE_STRIDE;
        const LAS float* wrow = (const LAS float*)(side + 1024) + wr * 64 + fr;
        const LAS float* bb = (const LAS float*)(side + 2048) + wc * 32 + 8 * fq; f32x4 bv[2][2];
#pragma unroll
        for (int bj = 0; bj < 2; ++bj) { bv[bj][0] = *(const LAS f32x4*)(bb + 128 * bj); bv[bj][1] = *(const LAS f32x4*)(bb + 128 * bj + 4); }
        bf16* dst = yb + (size_t)(u.pm * 256 + wr * 64 + fr) * DM + col;
#pragma unroll
        for (int ai = 0; ai < 2; ++ai)
#pragma unroll
            for (int m = 0; m < 4; ++m) { const float gt = wrow[ai * 128 + m * 16];
#pragma unroll
                for (int bj = 0; bj < 2; ++bj) { const f32x4 v0 = (acc[ai][bj][m][0] + bv[bj][0]) * gt, v1 = (acc[ai][bj][m][1] + bv[bj][1]) * gt;
                    *(v4u*)(dst + (size_t)(ai * 128 + m * 16) * DM + 128 * bj) = (v4u){pg8::cvt_pk_bf16(v0[0], v0[1]), pg8::cvt_pk_bf16(v0[2], v0[3]), pg8::cvt_pk_bf16(v1[0], v1[1]), pg8::cvt_pk_bf16(v1[2], v1[3])}; } }
    }
};
__device__ __forceinline__ void transpose_job_up(Frame& F, const float* W, bf16* WT) {
    LAS float* scr = (LAS float*)(F.lds + F.wave * 16384);
    constexpr int K = DM, N = 4096, per = (K / 64) * (N / 32); const long total = (long)per * NE;
    for (long it = F.gw; it < total; it += F.ngw) { const int e = (int)(it / per), item = (int)(it % per), lane = F.lane;
        const float* Wp = W + (size_t)e * K * N; bf16* WTp = WT + (size_t)e * N * K;
        const int nblk = N / 32, kb = item / nblk, nb = item % nblk, k0 = 64 * kb, n0 = 32 * nb;
        const int m0 = n0 & 2047, r0 = 256 * (m0 >> 7) + (n0 >= 2048 ? 128 : 0) + (m0 & 127);
#pragma unroll 8
        for (int i = 0; i < 32; ++i) { const int kk = 2 * i + (lane >> 5); scr[kk * 33 + (lane & 31)] = Wp[(size_t)(k0 + kk) * N + n0 + (lane & 31)]; }
        LDS_WAIT(); asm volatile("" ::: "memory");
        const int c = lane & 7;
#pragma unroll
        for (int j = 0; j < 4; ++j) { const int n = (lane >> 3) + 8 * j; const LAS float* sp = scr + (8 * c) * 33 + n;
            v4u o; o.x = pk2(sp[0 * 33], sp[1 * 33]); o.y = pk2(sp[2 * 33], sp[3 * 33]); o.z = pk2(sp[4 * 33], sp[5 * 33]); o.w = pk2(sp[6 * 33], sp[7 * 33]);
            *(v4u*)(WTp + (size_t)(r0 + n) * K + k0 + 8 * c) = o; }
        LDS_WAIT(); asm volatile("" ::: "memory");
    }
}


__device__ __forceinline__ void convert_expert_share(LAS unsigned char* lds, const float* Wup, const float* Wdn, bf16* WtUp, bf16* WtDn, int sh) {
    int t_ = threadIdx.x; asm volatile("" : "+v"(t_));
    const int wid = __builtin_amdgcn_readfirstlane(t_ >> 6), lane = t_ & 63;
    const int e = sh >> 3, part = sh & 7;
    LAS unsigned char* tile = lds + wid * 19456;
    const unsigned tbase = (unsigned)(size_t)tile;
    const int lr = lane >> 4, lc = lane & 15;
    const int g = lane >> 4, q = (lane & 15) >> 2, p = lane & 3;
    const unsigned wr_off = (unsigned)(lr * 160 + lc * 8), tr_off = (unsigned)(q * 160 + (g * 16 + 4 * p) * 2);
#define CES_SRC(it_, src_, N_, n0_, k0_, dst_, up_) do { const int it__ = (it_); \
        if (it__ < 32) { const int id = it__ * 8 + wid, kb = id >> 3, nb = id & 7; N_ = 4096; n0_ = part * 512 + nb * 64; k0_ = kb * 64; src_ = Wup + (size_t)e * DM * 4096; dst_ = WtUp + (size_t)e * 4096 * DM; up_ = true; } \
        else { const int id = (it__ - 32) * 8 + wid, kb = id >> 2, nb = id & 3; N_ = DM; n0_ = part * 256 + nb * 64; k0_ = kb * 64; src_ = Wdn + (size_t)e * DM * DM; dst_ = WtDn + (size_t)e * DM * DM; up_ = false; } } while (0)
#define CES_LOAD(R_, src_, N_, n0_, k0_) do { _Pragma("unroll") for (int i = 0; i < 16; ++i) R_[i] = __builtin_nontemporal_load((const f32x4*)(src_ + (size_t)(k0_ + 4 * i + lr) * N_ + n0_ + 4 * lc)); } while (0)
#define CES_PROC(R_, dst_, UP_, n0_, k0_) do { \
        _Pragma("unroll") for (int i = 0; i < 16; ++i) { const v2u w = {pk2(R_[i].x, R_[i].y), pk2(R_[i].z, R_[i].w)}; *(LAS v2u*)(tile + wr_off + i * 640) = w; } \
        asm volatile("s_waitcnt lgkmcnt(0)" ::: "memory"); \
          \
        _Pragma("unroll") for (int hb_ = 0; hb_ < 2; ++hb_) { v2u ta_[4], tb_[4]; \
            _Pragma("unroll") for (int jj = 0; jj < 4; ++jj) { \
                asm volatile("ds_read_b64_tr_b16 %0, %1 offset:%2" : "=&v"(ta_[jj]) : "v"(tbase + tr_off), "i"((4 * hb_ + jj) * 1280) : "memory"); \
                asm volatile("ds_read_b64_tr_b16 %0, %1 offset:%2" : "=&v"(tb_[jj]) : "v"(tbase + tr_off), "i"((4 * hb_ + jj) * 1280 + 640) : "memory"); } \
            asm volatile("s_waitcnt lgkmcnt(0)" : "+v"(ta_[0]), "+v"(ta_[1]), "+v"(ta_[2]), "+v"(ta_[3]), "+v"(tb_[0]), "+v"(tb_[1]), "+v"(tb_[2]), "+v"(tb_[3]) :: "memory"); \
            _Pragma("unroll") for (int jj = 0; jj < 4; ++jj) *(LAS v4u*)(tile + 10240 + lane * 144 + (4 * hb_ + jj) * 16) = (v4u){ta_[jj].x, ta_[jj].y, tb_[jj].x, tb_[jj].y}; } \
        asm volatile("s_waitcnt lgkmcnt(0)" ::: "memory"); \
          \
        _Pragma("unroll") for (int hf_ = 0; hf_ < 2; ++hf_) { v4u ow_[4]; \
            _Pragma("unroll") for (int s_ = 0; s_ < 4; ++s_) ow_[s_] = *(const LAS v4u*)(tile + 10240 + (8 * (4 * hf_ + s_) + (lane >> 3)) * 144 + (lane & 7) * 16); \
            _Pragma("unroll") for (int s_ = 0; s_ < 4; ++s_) { const int n = n0_ + 8 * (4 * hf_ + s_) + (lane >> 3); \
                const int m0 = n & 2047, drow = UP_ ? 256 * (m0 >> 7) + (n >= 2048 ? 128 : 0) + (m0 & 127) : n; \
                __builtin_nontemporal_store(ow_[s_], (v4u*)(dst_ + (size_t)drow * DM + k0_ + 8 * (lane & 7))); } \
            asm volatile("" ::: "memory"); } \
        asm volatile("s_waitcnt lgkmcnt(0)" ::: "memory"); } while (0)
    f32x4 RA[16], RB[16], RC[16];
    const float* sA; const float* sB; const float* sC; bf16* dA; bf16* dB; bf16* dC; int NA, NB_, NC, n0A, n0B, n0C, k0A, k0B, k0C; bool uA, uB, uC;
    CES_SRC(0, sA, NA, n0A, k0A, dA, uA); CES_LOAD(RA, sA, NA, n0A, k0A);
    CES_SRC(1, sB, NB_, n0B, k0B, dB, uB); CES_LOAD(RB, sB, NB_, n0B, k0B);
    for (int it = 0; it < 48; it += 3) {
        CES_SRC(it + 2, sC, NC, n0C, k0C, dC, uC); CES_LOAD(RC, sC, NC, n0C, k0C);
        CES_PROC(RA, dA, uA, n0A, k0A);
        if (it + 3 < 48) { CES_SRC(it + 3, sA, NA, n0A, k0A, dA, uA); CES_LOAD(RA, sA, NA, n0A, k0A); }
        CES_PROC(RB, dB, uB, n0B, k0B);
        if (it + 4 < 48) { CES_SRC(it + 4, sB, NB_, n0B, k0B, dB, uB); CES_LOAD(RB, sB, NB_, n0B, k0B); }
        CES_PROC(RC, dC, uC, n0C, k0C);
    }
#undef CES_SRC
#undef CES_LOAD
#undef CES_PROC
}

__global__ void __launch_bounds__(NWAVES * 64, 2) mk_fwd(Args args) {
    extern __shared__ __attribute__((aligned(16))) unsigned char lds_raw[];
    Frame F;
    F.lds = (LAS unsigned char*)lds_raw;
    F.tid = threadIdx.x; F.lane = F.tid & 63; F.wave = __builtin_amdgcn_readfirstlane(F.tid >> 6);
    F.G = gridDim.x; F.bid = blockIdx.x; F.gw = F.bid * NWAVES + F.wave; F.ngw = F.G * NWAVES;
    unsigned char* ws = args.ws;
    unsigned* ctl = (unsigned*)(ws + WS_CTL);
    for (int u = F.tid; u < (LDS_BYTES - CTLW) / 4; u += NWAVES * 64) ((LAS unsigned*)(F.lds + CTLW))[u] = 0u;
    __syncthreads();
    XcdBarrier bar = xcd_barrier_post(ctl + CW_BAR, (volatile LAS unsigned*)(F.lds + CTLW + 64));
#define GRID_BAR(k) do { if (IN(k) && IN((k) + 1)) xcd_barrier(bar); } while (0)
    const float* x = args.in[0]; const float* mem = args.in[1];
    bf16* WtIn = (bf16*)(ws + WS_WTIN); bf16* WtBg = (bf16*)(ws + WS_WTBG); bf16* WtBf = (bf16*)(ws + WS_WTBF); bf16* WtOut = (bf16*)(ws + WS_WTOUT);
    bf16* WtMq = (bf16*)(ws + WS_WTMQ); bf16* WtMkv = (bf16*)(ws + WS_WTMKV); bf16* WtMo = (bf16*)(ws + WS_WTMO); bf16* WtUp = (bf16*)(ws + WS_WTUP); bf16* WtDn = (bf16*)(ws + WS_WTDN);
    bf16* WrT = (bf16*)(ws + WS_WRT); bf16* yb = (bf16*)(ws + WS_YB); int* tokl = (int*)(ws + WS_TOKL); float* wl = (float*)(ws + WS_WL); float* rsl = (float*)(ws + WS_RSL); float* RSS1 = (float*)(ws + WS_RSS1); float* RSS2 = (float*)(ws + WS_RSS2); float* logits = (float*)(ws + WS_LOG);
    bf16* QT = (bf16*)(ws + WS_QT); bf16* KT = (bf16*)(ws + WS_KT); bf16* VG = (bf16*)(ws + WS_VG); float* EBL = (float*)(ws + WS_EBL); bf16* AT = (bf16*)(ws + WS_AT);
    bf16* SG = (bf16*)(ws + WS_SG); bf16* GG = (bf16*)(ws + WS_GG); bf16* GF = (bf16*)(ws + WS_GF); float* GAFF = (float*)(ws + WS_GAFF);
    float* ogla = (float*)(ws + WS_OGLA); float* Y1 = (float*)(ws + WS_Y1); float* Y2 = (float*)(ws + WS_Y2); float* X1 = (float*)(ws + WS_X1); float* X2 = (float*)(ws + WS_X2);
    bf16* hb = (bf16*)(ws + WS_H); bf16* attb = (bf16*)(ws + WS_ATT); bf16* onb = (bf16*)(ws + WS_ON); bf16* mrg = (bf16*)(ws + WS_MRG); bf16* h2 = (bf16*)(ws + WS_H2); bf16* xs = (bf16*)(ws + WS_XS);
    bf16* om = (bf16*)(ws + WS_OM); bf16* mn = (bf16*)(ws + WS_MN); float* qm = (float*)(ws + WS_QM); float* kv = (float*)(ws + WS_KV);
    bf16* act = (bf16*)(ws + WS_ACT);
    int* asg_e = (int*)(ws + WS_ASG); int* asg_pos = asg_e + NASG;
    bf16* fqh = (bf16*)(ws + WS_FQH); bf16* fkh = (bf16*)(ws + WS_FKH); bf16* fvh = (bf16*)(ws + WS_FVH); float* cbias = (float*)(ws + WS_CB);
    bf16* qmb = (bf16*)(ws + WS_QMB); bf16* knb = (bf16*)(ws + WS_KNB); bf16* vb = (bf16*)(ws + WS_VB);
    const int lo = args.ph_lo, hi = args.ph_hi;
#define IN(k) (lo <= (k) && (k) < hi)
#define REFRESH() do { int t_ = threadIdx.x; asm volatile("" : "+v"(t_)); F.tid = t_; F.lane = t_ & 63; F.wave = __builtin_amdgcn_readfirstlane(t_ >> 6); F.gw = F.bid * NWAVES + F.wave; } while (0)

    if (IN(0)) { REFRESH();
        transpose_win64(F.lds, args.in[3], WtIn, F.gw, F.ngw);
        __syncthreads();
        transpose_win(F, args.in[3], WtIn);
        { v4u* z = (v4u*)(WtIn + (size_t)(64 * 256 + 32) * DM); const int nz = (INCP - INC) * DM / 8; for (int i = F.bid * 512 + F.tid; i < nz; i += F.G * 512) z[i] = (v4u){0u, 0u, 0u, 0u}; }
        for (int m = F.gw; m < T; m += 2 * F.ngw) {
            const int m2 = m + F.ngw;
            if (m2 < T) rms_rows2_bf16(x + (size_t)m * DM, x + (size_t)m2 * DM, args.in[2], hb + (size_t)m * DM, hb + (size_t)m2 * DM, F.lane);
            else rms_row_bf16(x + (size_t)m * DM, args.in[2], hb + (size_t)m * DM, F.lane); }
    }
    GRID_BAR(0);
    if (IN(1)) { REFRESH();
        pg8::Gemm g{hb, WtIn, T, 16384, DM}; pg8::StaticOrder S; S.init(T, 16384, F.G, F.bid);
        EpiInProj E{QT, VG, SG, fqh, GG, GAFF};
        { const int r0 = F.bid & 15; pg8::StaticOrder Sa = S; Sa.iend = r0;
          pg8::gemm_phase<EpiInProj, pg8::StaticOrder>(F.lds, g, Sa, E);
          __syncthreads();
          for (int sh = F.bid; sh < 256; sh += F.G) convert_expert_share(F.lds, args.in[23], args.in[25], WtUp, WtDn, sh);
          __syncthreads();
          transpose64(F.lds, args.in[16], DM, 1024, WtMkv, F.gw, F.ngw);
          __syncthreads();
          transpose_job(F, args.in[21], DM, NE, 1, WrT);
          { v4u* z = (v4u*)tokl; const int nz = NE * T / 4; for (int i = F.bid * 512 + F.tid; i < nz; i += F.G * 512) z[i] = (v4u){0u, 0u, 0u, 0u}; }
          { v4u* z = (v4u*)(WrT + (size_t)NE * DM); const int nz = (256 - NE) * DM / 8; for (int i = F.bid * 512 + F.tid; i < nz; i += F.G * 512) z[i] = (v4u){0u, 0u, 0u, 0u}; }
          for (int m = F.gw; m < NB * MEML; m += F.ngw) rms_row_bf16(mem + (size_t)m * DM, args.in[14], mn + (size_t)m * DM, F.lane);
          __syncthreads();
          S.i0 = r0; }
        static_assert(WS_KT == WS_QT + (size_t)T * 1024 * 2 && WS_FKH == WS_FQH + (size_t)T * DM * 2 && WS_FVH == WS_FKH + (size_t)T * DM * 2 && WS_GF == WS_GG + (size_t)T * DM * 2, "epilogue pointer arithmetic");
        pg8::gemm_phase<EpiInProj, pg8::StaticOrder>(F.lds, g, S, E);
        { pg8::Gemm g2{hb, WtIn + (size_t)16384 * DM, T, 256, 512, DM}; pg8::SplitOrder S2{64, 1, 4, 512, F.G, F.bid}; pg8::EpiN32 E2{GAFF, 128};
          pg8::gemm_phase<pg8::EpiN32, pg8::SplitOrder>(F.lds, g2, S2, E2); }
    }
    GRID_BAR(1);
    if (IN(2)) { REFRESH();
        const float* aup = args.in[4]; const float* abias = args.in[5];
        LAS float* gaL = (LAS float*)F.lds;
        LAS float* bL = (LAS float*)(F.lds + 4096);
        for (int job = F.bid; job < 16 * 64; job += F.G) {
            const int bh = job >> 6, c = job & 63, b = bh >> 2, h = bh & 3; const size_t tok0 = (size_t)b * SEQ + c * 64;
            __syncthreads();
            if (F.tid < 256) { const float* gp_ = GAFF + (tok0 + (F.tid >> 2)) * 128 + 4 * (F.tid & 3); *(LAS f32x4*)(gaL + (F.tid >> 2) * 16 + 4 * (F.tid & 3)) = (*(const f32x4*)gp_ + *(const f32x4*)(gp_ + 32)) + (*(const f32x4*)(gp_ + 64) + *(const f32x4*)(gp_ + 96)); }
            __syncthreads();
            const int k = F.tid & 255, half = F.tid >> 8;
            { float au[16];
#pragma unroll
              for (int r = 0; r < 16; ++r) au[r] = aup[r * 1024 + h * 256 + k];
              const float ab = abias[h * 256 + k]; float run = 0.f;
#pragma unroll 4
              for (int tt = 0; tt < 32; ++tt) { const int t = 32 * half + tt; float a = ab;
#pragma unroll
                for (int r4 = 0; r4 < 4; ++r4) { const f32x4 g4 = *(const LAS f32x4*)(gaL + t * 16 + 4 * r4); a += g4.x * au[4 * r4] + g4.y * au[4 * r4 + 1] + g4.z * au[4 * r4 + 2] + g4.w * au[4 * r4 + 3]; }
                run += log_sigmoid_f(a) * (1.0f / 16.0f); bL[t * 256 + k] = run; } }
            __syncthreads();
            { const float add = half ? bL[31 * 256 + k] : 0.f;
              __syncthreads();
              if (half) {
#pragma unroll 8
                for (int tt = 0; tt < 32; ++tt) bL[(32 + tt) * 256 + k] += add; } }
            __syncthreads();
            if (F.tid < 256) EBL[((size_t)bh * 64 + c) * 256 + F.tid] = __expf(bL[63 * 256 + F.tid]);
            { bf16* qb = QT + ((size_t)bh * SEQ + c * 64) * 256; bf16* kb = KT + ((size_t)bh * SEQ + c * 64) * 256;
              v4u qv[4], kv_[4];
#pragma unroll
              for (int i = 0; i < 4; ++i) { const int it = F.tid + 512 * i, t = it >> 5, cg = it & 31; qv[i] = *(const v4u*)(qb + t * 256 + 8 * cg); kv_[i] = *(const v4u*)(kb + t * 256 + 8 * cg); }
#pragma unroll
              for (int i = 0; i < 4; ++i) { const int it = F.tid + 512 * i, t = it >> 5, cg = it & 31;
                const f32x4 b0 = *(const LAS f32x4*)(bL + t * 256 + 8 * cg), b1 = *(const LAS f32x4*)(bL + t * 256 + 8 * cg + 4);
                const float eb[8] = {__expf(b0.x), __expf(b0.y), __expf(b0.z), __expf(b0.w), __expf(b1.x), __expf(b1.y), __expf(b1.z), __expf(b1.w)};
                const unsigned qw[4] = {qv[i].x, qv[i].y, qv[i].z, qv[i].w}, kw[4] = {kv_[i].x, kv_[i].y, kv_[i].z, kv_[i].w}; unsigned qo[4], ko[4];
#pragma unroll
                for (int j = 0; j < 4; ++j) { const float e0 = eb[2 * j], e1 = eb[2 * j + 1];
                    qo[j] = pk2(bf2f(qw[j] & 0xffffu) * e0 * (1.0f / 16.0f), bf2f(qw[j] >> 16) * e1 * (1.0f / 16.0f));
                    ko[j] = pk2(bf2f(kw[j] & 0xffffu) * __builtin_amdgcn_rcpf(e0), bf2f(kw[j] >> 16) * __builtin_amdgcn_rcpf(e1)); }
                *(v4u*)(qb + t * 256 + 8 * cg) = (v4u){qo[0], qo[1], qo[2], qo[3]}; *(v4u*)(kb + t * 256 + 8 * cg) = (v4u){ko[0], ko[1], ko[2], ko[3]}; } }
        }
        VM_WAIT(); __syncthreads();
        { int nj = 0; for (int job = F.bid; job < 16 * 64; job += F.G) ++nj;
          for (int a = F.wave; a < 3 * nj; a += NWAVES) { const int job = F.bid + (a / 3) * F.G; gla::apass_job(QT, KT, AT, job * 3 + (a % 3), F.lane); } }
        { const bool mid = F.G == 256; const int cgw = mid ? (F.bid - 64) * NWAVES + F.wave : F.gw, cngw = mid ? 128 * NWAVES : F.ngw;
          __syncthreads();
          if (!mid || (F.bid >= 64 && F.bid < 192)) {
              transpose64(F.lds, args.in[10], DM, DM, WtBg, cgw, cngw);
              transpose64(F.lds, args.in[11], DM, DM, WtBf, cgw, cngw);
              transpose64(F.lds, args.in[12], DM, DM, WtOut, cgw, cngw);
              transpose64(F.lds, args.in[15], DM, 512, WtMq, cgw, cngw);
              transpose64(F.lds, args.in[19], 512, DM, WtMo, cgw, cngw); } }
        __syncthreads();
        { pg8::Gemm g{mn, WtMkv, 1024, 1024, 512, DM}; pg8::SplitOrder S{4, 4, 4, 512, F.G, F.bid}; pg8::EpiF32 E{kv, 4096, nullptr}; pg8::gemm_phase<pg8::EpiF32, pg8::SplitOrder>(F.lds, g, S, E); }
        __syncthreads(); REFRESH();
        for (int job = F.bid - (F.G - 64); job >= 0 && job < NB * 16; job += F.G) {
            const int b = job >> 4, h = job & 15; const float fb = args.in[7][h];
            LAS double* wsum = (LAS double*)(F.lds + 4096 + 65536);
            float xv[8];
#pragma unroll
            for (int j = 0; j < 8; ++j) { const float* gp_ = GAFF + (size_t)(b * SEQ + 8 * F.tid + j) * 128 + 16 + h; xv[j] = log_sigmoid_f((gp_[0] + gp_[32]) + (gp_[64] + gp_[96]) + fb); }
            double loc = 0.0;
#pragma unroll
            for (int j = 0; j < 8; ++j) loc += (double)xv[j];
            double pre = loc;
#pragma unroll
            for (int o = 1; o < 64; o <<= 1) { const double y = __shfl_up(pre, o); if (F.lane >= o) pre += y; }
            __syncthreads();
            if (F.lane == 63) wsum[F.wave] = pre;
            __syncthreads();
            double run = pre - loc;
            for (int w = 0; w < F.wave; ++w) run += wsum[w];
#pragma unroll
            for (int j = 0; j < 8; ++j) { run += (double)xv[j]; cbias[(size_t)(b * 16 + h) * SEQ + 8 * F.tid + j] = (float)(-run * (double)(1.0f / fa::SCALE)); }
        }
        { int tl_ = threadIdx.x; asm volatile("" : "+v"(tl_));
          const int l16 = tl_ & 15, rsub = (tl_ & 63) >> 4;
          const f32x4 gq0 = *(const f32x4*)(args.in[8] + 8 * l16), gq1 = *(const f32x4*)(args.in[8] + 8 * l16 + 4), gk0 = *(const f32x4*)(args.in[9] + 8 * l16), gk1 = *(const f32x4*)(args.in[9] + 8 * l16 + 4);
#define QKN_LOAD(W_, r0_) do { _Pragma("unroll") for (int i = 0; i < 4; ++i) W_[i] = *(const v4u*)(fqh + (size_t)((r0_) + 4 * i + rsub) * 128 + 8 * l16); } while (0)
#define QKN_PROC(W_, r0_) do { const bool isk_ = (r0_) >= T * 16; const f32x4 g0 = isk_ ? gk0 : gq0, g1 = isk_ ? gk1 : gq1; \
            _Pragma("unroll") for (int i = 0; i < 4; ++i) { \
                float v[8] = {bf2f(W_[i].x & 0xffffu), bf2f(W_[i].x >> 16), bf2f(W_[i].y & 0xffffu), bf2f(W_[i].y >> 16), bf2f(W_[i].z & 0xffffu), bf2f(W_[i].z >> 16), bf2f(W_[i].w & 0xffffu), bf2f(W_[i].w >> 16)}; \
                float ss = 0.f; \
                _Pragma("unroll") for (int j = 0; j < 8; ++j) ss += v[j] * v[j]; \
                ss += __shfl_xor(ss, 1); ss += __shfl_xor(ss, 2); ss += __shfl_xor(ss, 4); ss += __shfl_xor(ss, 8); \
                const float r = 1.0f / sqrtf(ss * (1.f / 128.f) + EPS); \
                *(v4u*)(fqh + (size_t)((r0_) + 4 * i + rsub) * 128 + 8 * l16) = (v4u){pk2(v[0] * r * g0.x, v[1] * r * g0.y), pk2(v[2] * r * g0.z, v[3] * r * g0.w), pk2(v[4] * r * g1.x, v[5] * r * g1.y), pk2(v[6] * r * g1.z, v[7] * r * g1.w)}; } } while (0)
          const int step = F.ngw * 16, end = T * 32;
          v4u wa[4], wb[4];
          int r0 = F.gw * 16;
          if (r0 < end) { QKN_LOAD(wa, r0);
            for (;;) {
              const int r1 = r0 + step, r2 = r1 + step;
              if (r1 < end) QKN_LOAD(wb, r1);
              QKN_PROC(wa, r0);
              if (r1 >= end) break;
              if (r2 < end) QKN_LOAD(wa, r2);
              QKN_PROC(wb, r1);
              if (r2 >= end) break;
              r0 = r2;
            } }
#undef QKN_LOAD
#undef QKN_PROC
        }
    }
    GRID_BAR(2);
    if (IN(3)) { REFRESH();
        for (int item = F.bid; item < 64; item += F.G) {
            const int bh = item >> 2, grp = item & 3, b = bh >> 2, h = bh & 3;
            gla::ScanRef R{QT + (size_t)bh * SEQ * 256, KT + (size_t)bh * SEQ * 256, VG + (size_t)bh * SEQ * 512 + 128 * grp, AT + (size_t)bh * 64 * 64 * 64, EBL + (size_t)bh * 64 * 256,
                           ogla + (size_t)b * SEQ * DM + h * 512 + 128 * grp};
            gla::scan_item(R, F.lds);
            VM_WAIT(); __syncthreads();
            if (F.tid == 0) {
                unsigned* cw = ctl + CW_GLA + 64 * bh;
                __builtin_amdgcn_fence(__ATOMIC_RELEASE, "agent"); VM_WAIT();
                (void)xb_add(cw, 1u);
                unsigned sp = 0; while (xb_ld(cw) < 4u) { __builtin_amdgcn_s_sleep(2); if (++sp > (1u << 20)) { atomicAdd(ctl + CW_BAR + XB_TMO, 1u); break; } }
                __builtin_amdgcn_fence(__ATOMIC_ACQUIRE, "agent"); VM_WAIT();
            }
            __syncthreads();
            { const float* gp = args.in[6] + F.lane * 8; const f32x4 gq0 = *(const f32x4*)gp, gq1 = *(const f32x4*)(gp + 4);
              for (int tt = F.wave * 4; tt < 1024; tt += NWAVES * 4) {
                f32x4 v0[4], v1[4]; v4u sgw[4];
#pragma unroll
                for (int i = 0; i < 4; ++i) { const size_t o = ((size_t)b * SEQ + grp * 1024 + tt + i) * DM + h * 512 + F.lane * 8; v0[i] = *(const f32x4*)(ogla + o); v1[i] = *(const f32x4*)(ogla + o + 4); sgw[i] = *(const v4u*)(SG + o); }
#pragma unroll
                for (int i = 0; i < 4; ++i) { const size_t o = ((size_t)b * SEQ + grp * 1024 + tt + i) * DM + h * 512 + F.lane * 8;
                    const float ss = (v0[i].x * v0[i].x + v0[i].y * v0[i].y + v0[i].z * v0[i].z + v0[i].w * v0[i].w) + (v1[i].x * v1[i].x + v1[i].y * v1[i].y + v1[i].z * v1[i].z + v1[i].w * v1[i].w);
                    const float r = 1.0f / sqrtf(wave_sum(ss) * (1.f / 512.f) + EPS);
                    const float sg[8] = {bf2f(sgw[i].x & 0xffffu), bf2f(sgw[i].x >> 16), bf2f(sgw[i].y & 0xffffu), bf2f(sgw[i].y >> 16), bf2f(sgw[i].z & 0xffffu), bf2f(sgw[i].z >> 16), bf2f(sgw[i].w & 0xffffu), bf2f(sgw[i].w >> 16)};
                    *(v4u*)(onb + o) = (v4u){pk2(v0[i].x * r * gq0.x * sg[0], v0[i].y * r * gq0.y * sg[1]), pk2(v0[i].z * r * gq0.z * sg[2], v0[i].w * r * gq0.w * sg[3]),
                                             pk2(v1[i].x * r * gq1.x * sg[4], v1[i].y * r * gq1.y * sg[5]), pk2(v1[i].z * r * gq1.z * sg[6], v1[i].w * r * gq1.w * sg[7])}; } } }
        }
        __syncthreads();
        {
            constexpr int total = NB * 16 * 16, per_q = total / 8;
            volatile LAS int* qs = (volatile LAS int*)(F.lds + CTLW + 256);
            const unsigned myq = xb_xcc_id() & 7u;
#define FOX_FETCH(dst_) do { int got_ = total; for (unsigned k_ = 0; k_ < 8u; ++k_) { const unsigned q_ = (myq + k_) & 7u; \
                if (xb_ld(ctl + CW_FOXQ + 64 * q_) < (unsigned)per_q) { const unsigned v_ = atomicAdd(ctl + CW_FOXQ + 64 * q_, 1u); if (v_ < (unsigned)per_q) { got_ = (int)(q_ * per_q + v_); break; } } } (dst_) = got_; } while (0)
            if (F.tid == 0) { int a_, b_; FOX_FETCH(a_); FOX_FETCH(b_); qs[2] = a_; qs[3] = b_; }
            __syncthreads();
            int L = __builtin_amdgcn_readfirstlane(qs[2]), Ln = __builtin_amdgcn_readfirstlane(qs[3]), it = 0;
            if (L < total) {
#define FOX_REF(R_, L_) do { const int q_ = (L_) / per_q, i_ = (L_) - q_ * per_q, qb_ = 15 - (i_ >> 3), bh_ = (i_ & 7) * 8 + q_, b_ = bh_ >> 4, h_ = bh_ & 15; \
                (R_).Q = fqh + ((size_t)bh_ * SEQ + qb_ * 256) * 128; (R_).K = fkh + (size_t)bh_ * SEQ * 128; (R_).V = fvh + (size_t)bh_ * SEQ * 128; (R_).Bk = cbias + (size_t)bh_ * SEQ; \
                (R_).O = attb + ((size_t)(b_ * SEQ + qb_ * 256)) * DM + h_ * 128; (R_).P0 = qb_ * 256; } while (0)
                fa::BlockRef cur, nxt; fa::Seam S;
                FOX_REF(cur, L);
                fa::attn_prime<true, 128, 128, 128, DM>(cur, SEQ, (char*)lds_raw, S);
                for (;;) {
                    const bool last = Ln >= total;
                    if (last) nxt = cur; else FOX_REF(nxt, Ln);
                    if (F.tid == 0 && !last) { int a_; FOX_FETCH(a_); qs[it & 1] = a_; }
                    fa::attn_block<true, 128, 128, 128, DM>(cur, nxt, SEQ, SEQ, (char*)lds_raw, S);
                    if (last) break;
                    cur = nxt; L = Ln; Ln = __builtin_amdgcn_readfirstlane(qs[it & 1]); ++it;
                }
#undef FOX_REF
#undef FOX_FETCH
            }
        }
    }
    GRID_BAR(3);
    if (IN(5)) { REFRESH();
        { pg8::Gemm g{onb, WtBg, T, DM, DM}; pg8::StaticOrder S; S.init(T, DM, F.G, F.bid); EpiGate<0> E{(bf16*)Y1, GG, nullptr}; pg8::gemm_phase<EpiGate<0>, pg8::StaticOrder>(F.lds, g, S, E); }
        { pg8::Gemm g{attb, WtBf, T, DM, DM}; pg8::StaticOrder S; S.init(T, DM, F.G, F.bid); EpiGate<1> E{(bf16*)Y1, GF, mrg}; pg8::gemm_phase<EpiGate<1>, pg8::StaticOrder>(F.lds, g, S, E); }
    }
    GRID_BAR(5);
    if (IN(7)) { REFRESH(); pg8::Gemm g{mrg, WtOut, T, DM, DM}; pg8::StaticOrder S; S.init(T, DM, F.G, F.bid); EpiRes<true, false> E{x, X1, args.in[13], h2, RSS1}; pg8::gemm_phase<EpiRes<true, false>, pg8::StaticOrder>(F.lds, g, S, E); }
    GRID_BAR(7);
    if (IN(9)) { REFRESH();
        { pg8::Gemm g{h2, WtMq, T, 512, 1024, DM}; pg8::SplitOrder S{64, 2, 2, 1024, F.G, F.bid}; pg8::EpiF32 E{qm, 1024, nullptr}; pg8::gemm_phase<pg8::EpiF32, pg8::SplitOrder>(F.lds, g, S, E); }
    }
    GRID_BAR(9);
    if (IN(10)) { REFRESH();
        const int l16 = F.lane & 15, rsub = F.lane >> 4;
        for (int r0 = F.gw * 16; r0 < T * 4 + 1024 * 4; r0 += F.ngw * 16) {
            const bool isq = r0 < T * 4; const float* gp = args.in[isq ? 17 : 18] + 8 * l16; const f32x4 g0 = *(const f32x4*)gp, g1 = *(const f32x4*)(gp + 4);
            f32x4 a0[4], a1[4], c0[4], c1[4];
#pragma unroll
            for (int i = 0; i < 4; ++i) { const int r = (isq ? r0 : r0 - T * 4) + 4 * i + rsub, h = r & 3, row = r >> 2;
                if (isq) { const float* src = qm + (size_t)row * 1024 + h * 128 + 8 * l16; a0[i] = *(const f32x4*)src + *(const f32x4*)(src + 512); a1[i] = *(const f32x4*)(src + 4) + *(const f32x4*)(src + 516); }
                else { const float* src = kv + (size_t)row * 4096 + h * 128 + 8 * l16;
                    a0[i] = (*(const f32x4*)src + *(const f32x4*)(src + 1024)) + (*(const f32x4*)(src + 2048) + *(const f32x4*)(src + 3072));
                    a1[i] = (*(const f32x4*)(src + 4) + *(const f32x4*)(src + 1028)) + (*(const f32x4*)(src + 2052) + *(const f32x4*)(src + 3076));
                    c0[i] = (*(const f32x4*)(src + 512) + *(const f32x4*)(src + 1536)) + (*(const f32x4*)(src + 2560) + *(const f32x4*)(src + 3584));
                    c1[i] = (*(const f32x4*)(src + 516) + *(const f32x4*)(src + 1540)) + (*(const f32x4*)(src + 2564) + *(const f32x4*)(src + 3588)); } }
#pragma unroll
            for (int i = 0; i < 4; ++i) { const int r = (isq ? r0 : r0 - T * 4) + 4 * i + rsub, h = r & 3, row = r >> 2;
                float ss = (a0[i].x * a0[i].x + a0[i].y * a0[i].y + a0[i].z * a0[i].z + a0[i].w * a0[i].w) + (a1[i].x * a1[i].x + a1[i].y * a1[i].y + a1[i].z * a1[i].z + a1[i].w * a1[i].w);
                ss += __shfl_xor(ss, 1); ss += __shfl_xor(ss, 2); ss += __shfl_xor(ss, 4); ss += __shfl_xor(ss, 8);
                float epsq = EPS;
                if (isq) { const f32x2 p2 = *(const f32x2*)(RSS1 + (size_t)row * 32 + 2 * l16); float ms = p2.x + p2.y; ms += __shfl_xor(ms, 1); ms += __shfl_xor(ms, 2); ms += __shfl_xor(ms, 4); ms += __shfl_xor(ms, 8); epsq = EPS * (ms * (1.f / DM) + EPS); }
                const float rr = 1.0f / sqrtf(ss * (1.f / 128.f) + epsq);
                const v4u w = {pk2(a0[i].x * rr * g0.x, a0[i].y * rr * g0.y), pk2(a0[i].z * rr * g0.z, a0[i].w * rr * g0.w), pk2(a1[i].x * rr * g1.x, a1[i].y * rr * g1.y), pk2(a1[i].z * rr * g1.z, a1[i].w * rr * g1.w)};
                if (isq) *(v4u*)(qmb + (size_t)row * 512 + h * 128 + 8 * l16) = w;
                else { const size_t o = ((size_t)((row >> 8) * 4 + h) * MEML + (row & 255)) * 128 + 8 * l16; *(v4u*)(knb + o) = w;
                       *(v4u*)(vb + o) = (v4u){pk2(c0[i].x, c0[i].y), pk2(c0[i].z, c0[i].w), pk2(c1[i].x, c1[i].y), pk2(c1[i].z, c1[i].w)}; } }
        }
    }
    GRID_BAR(10);
    if (IN(11)) { REFRESH();
        {
            constexpr int total = NB * 4 * 16; const int stride = F.G; int L = F.bid;
            if (L < total) {
#define MEM_REF(R_, L_) do { const int bh_ = (L_) >> 4, qb_ = (L_) & 15, b_ = bh_ >> 2, h_ = bh_ & 3; \
                (R_).Q = qmb + ((size_t)(b_ * SEQ + qb_ * 256)) * 512 + h_ * 128; (R_).K = knb + (size_t)bh_ * MEML * 128; (R_).V = vb + (size_t)bh_ * MEML * 128; (R_).Bk = nullptr; \
                (R_).O = om + ((size_t)(b_ * SEQ + qb_ * 256)) * 512 + h_ * 128; (R_).P0 = MEML; } while (0)
                fa::BlockRef cur, nxt; fa::Seam S;
                MEM_REF(cur, L);
                fa::attn_prime<false, 512, 128, 128, 512>(cur, 1 << 30, (char*)lds_raw, S);
                for (;;) {
                    const bool more_item = L + stride < total; const int Ln = more_item ? L + stride : L;
                    if (!more_item) nxt = cur; else MEM_REF(nxt, Ln);
                    fa::attn_block<false, 512, 128, 128, 512>(cur, nxt, MEML, 1 << 30, (char*)lds_raw, S);
                    if (!more_item) break;
                    cur = nxt; L = Ln;
                }
#undef MEM_REF
            }
        }
    }
    GRID_BAR(11);
    if (IN(12)) { REFRESH(); pg8::Gemm g{om, WtMo, T, DM, 512}; pg8::StaticOrder S; S.init(T, DM, F.G, F.bid); EpiRes<true, true> E{X1, X2, args.in[20], xs, RSS2}; pg8::gemm_phase<EpiRes<true, true>, pg8::StaticOrder>(F.lds, g, S, E); }
    GRID_BAR(12);
    if (IN(15)) { REFRESH();
        const float* br = args.in[22];
        LAS int* hist = (LAS int*)F.lds; LAS int* gbase = hist + NE;
        LAS float* part = (LAS float*)(F.lds + 1024);
        for (int m0 = F.bid * 64; m0 < T; m0 += F.G * 64) {
            __syncthreads();
            if (F.tid < NE) hist[F.tid] = 0;
            { const int fr = F.lane & 15, fq = F.lane >> 4;
              f32x4 acc[4][2];
#pragma unroll
              for (int tb = 0; tb < 4; ++tb)
#pragma unroll
                  for (int eb = 0; eb < 2; ++eb) acc[tb][eb] = (f32x4){0.f, 0.f, 0.f, 0.f};
              const bf16* ap = xs + (size_t)(m0 + fr) * DM + 256 * F.wave + 8 * fq;
              const bf16* bp = WrT + (size_t)fr * DM + 256 * F.wave + 8 * fq;
              bf16x8 a[8][4], bw[8][2];
#pragma unroll
              for (int ks = 0; ks < 8; ++ks) {
#pragma unroll
                  for (int tb = 0; tb < 4; ++tb) a[ks][tb] = *(const bf16x8*)(ap + (size_t)tb * 16 * DM + ks * 32);
#pragma unroll
                  for (int eb = 0; eb < 2; ++eb) bw[ks][eb] = *(const bf16x8*)(bp + (size_t)eb * 16 * DM + ks * 32); }
#pragma unroll
              for (int ks = 0; ks < 8; ++ks)
#pragma unroll
                  for (int tb = 0; tb < 4; ++tb)
#pragma unroll
                      for (int eb = 0; eb < 2; ++eb) acc[tb][eb] = __builtin_amdgcn_mfma_f32_16x16x32_bf16(a[ks][tb], bw[ks][eb], acc[tb][eb], 0, 0, 0);
#pragma unroll
              for (int tb = 0; tb < 4; ++tb)
#pragma unroll
                  for (int eb = 0; eb < 2; ++eb)
#pragma unroll
                      for (int i = 0; i < 4; ++i) part[(F.wave * 64 + tb * 16 + 4 * fq + i) * 32 + eb * 16 + fr] = acc[tb][eb][i]; }
            __syncthreads();
            int ti[TOPK], rk[TOPK]; float gt[TOPK], rstd = 0.f; const int m = m0 + F.tid;
            if (F.tid < 64) {
                float ms = 0.f;
#pragma unroll
                for (int q = 0; q < 8; ++q) { const f32x4 p4 = *(const f32x4*)(RSS2 + (size_t)m * 32 + 4 * q); ms += (p4.x + p4.y) + (p4.z + p4.w); }
                rstd = 1.0f / sqrtf(ms * (1.f / DM) + EPS);
                float lg[NE];
#pragma unroll
                for (int q = 0; q < 8; ++q) { const LAS float* lp_ = part + F.tid * 32 + 4 * q;
                    const f32x4 l4 = ((*(const LAS f32x4*)lp_ + *(const LAS f32x4*)(lp_ + 2048)) + (*(const LAS f32x4*)(lp_ + 4096) + *(const LAS f32x4*)(lp_ + 6144)))
                                   + ((*(const LAS f32x4*)(lp_ + 8192) + *(const LAS f32x4*)(lp_ + 10240)) + (*(const LAS f32x4*)(lp_ + 12288) + *(const LAS f32x4*)(lp_ + 14336))), b4 = *(const f32x4*)(br + 4 * q);
                    lg[4 * q] = l4.x * rstd + b4.x; lg[4 * q + 1] = l4.y * rstd + b4.y; lg[4 * q + 2] = l4.z * rstd + b4.z; lg[4 * q + 3] = l4.w * rstd + b4.w; }
                unsigned taken = 0u; float tv[TOPK];
#pragma unroll
                for (int k = 0; k < TOPK; ++k) { float best = -3.0e38f; int bi = 0;
#pragma unroll
                    for (int e = 0; e < NE; ++e) { const bool ok = !((taken >> e) & 1u) && lg[e] > best; best = ok ? lg[e] : best; bi = ok ? e : bi; }
                    taken |= 1u << bi; tv[k] = best; ti[k] = bi; }
                float ps = 0.f;
#pragma unroll
                for (int k = 0; k < TOPK; ++k) { gt[k] = __expf(tv[k] - tv[0]); ps += gt[k]; }
#pragma unroll
                for (int k = 0; k < TOPK; ++k) { gt[k] /= ps; rk[k] = __hip_atomic_fetch_add(&hist[ti[k]], 1, __ATOMIC_RELAXED, __HIP_MEMORY_SCOPE_WORKGROUP); }
            }
            __syncthreads();
            if (F.tid < NE) gbase[F.tid] = (int)atomicAdd(ctl + CW_CNT + F.tid, (unsigned)hist[F.tid]);
            __syncthreads();
            if (F.tid < 64) {
#pragma unroll
                for (int k = 0; k < TOPK; ++k) { const int pos = gbase[ti[k]] + rk[k]; asg_e[m * TOPK + k] = ti[k]; asg_pos[m * TOPK + k] = pos;
                    const size_t li = (size_t)ti[k] * T + pos; tokl[li] = m; wl[li] = gt[k]; rsl[li] = rstd; }
            }
        }
    }
    GRID_BAR(15);
    if (IN(16)) { REFRESH();
        moe_tables(F.lds, ctl);
        pg8::Gemm g{xs, WtUp, PMAX, 4096, DM}; MoeOrder<true> S{F.lds, tokl, rsl, args.in[24], 16, F.G, F.bid}; EpiSwiglu E{act, F.lds};
        pg8::gemm_phase_gather<EpiSwiglu, MoeOrder<true>>(F.lds, g, S, E);
    }
    GRID_BAR(16);
    if (IN(17)) { REFRESH();
        moe_tables(F.lds, ctl);
        pg8::Gemm g{act, WtDn, PMAX, DM, DM}; MoeOrder<false> S{F.lds, tokl, wl, args.in[26], 8, F.G, F.bid}; EpiDown E{yb, F.lds};
        pg8::gemm_phase<EpiDown, MoeOrder<false>>(F.lds, g, S, E);
    }
    GRID_BAR(17);
    if (IN(18)) { REFRESH();
        moe_tables(F.lds, ctl);
        const LAS int* pbase = (const LAS int*)(F.lds + MT_PBASE);
        for (int t = F.gw; t < T; t += F.ngw) {
            int slot[TOPK];
#pragma unroll
            for (int k = 0; k < TOPK; ++k) slot[k] = pbase[asg_e[t * TOPK + k]] + asg_pos[t * TOPK + k];
            f32x4 o0[4], o1[4]; v4u w[4][TOPK];
#pragma unroll
            for (int p = 0; p < 4; ++p) { const int j = 512 * p + 8 * F.lane; { const v4u xw = *(const v4u*)((const bf16*)X2 + (size_t)t * DM + j); o0[p] = (f32x4){bf2f(xw.x & 0xffffu), bf2f(xw.x >> 16), bf2f(xw.y & 0xffffu), bf2f(xw.y >> 16)}; o1[p] = (f32x4){bf2f(xw.z & 0xffffu), bf2f(xw.z >> 16), bf2f(xw.w & 0xffffu), bf2f(xw.w >> 16)}; }
#pragma unroll
                for (int k = 0; k < TOPK; ++k) w[p][k] = *(const v4u*)(yb + (size_t)slot[k] * DM + j); }
#pragma unroll
            for (int p = 0; p < 4; ++p) { const int j = 512 * p + 8 * F.lane;
#pragma unroll
                for (int k = 0; k < TOPK; ++k) { const v4u q = w[p][k];
                    o0[p].x += bf2f(q.x & 0xffffu); o0[p].y += bf2f(q.x >> 16); o0[p].z += bf2f(q.y & 0xffffu); o0[p].w += bf2f(q.y >> 16);
                    o1[p].x += bf2f(q.z & 0xffffu); o1[p].y += bf2f(q.z >> 16); o1[p].z += bf2f(q.w & 0xffffu); o1[p].w += bf2f(q.w >> 16); }
                *(f32x4*)(args.out + (size_t)t * DM + j) = o0[p]; *(f32x4*)(args.out + (size_t)t * DM + j + 4) = o1[p]; }
        }
    }
#undef IN
}

constexpr int NPHASE = 19;
extern "C" void kernel_launch(void* const* d_in, const int* in_sizes, int n_in, void* d_out, int out_size, void* d_ws, size_t ws_size, hipStream_t stream) {
    static int grid = 0;
    static_assert(WS_END <= (size_t)4290 * 1000 * 1000, "d_ws map too large");
    if (grid == 0) {
        if (n_in != 27 || out_size != T * DM || ws_size < WS_END) { fprintf(stderr, "kernel_launch: unexpected shapes (n_in %d, out %d, ws %zu, need %zu)\n", n_in, out_size, ws_size, (size_t)WS_END); grid = -1; return; }
        int dev = 0, cus = 0, per_cu = 0;
        if (hipGetDevice(&dev) != hipSuccess || hipDeviceGetAttribute(&cus, hipDeviceAttributeMultiprocessorCount, dev) != hipSuccess) { grid = -1; return; }
        if (hipFuncSetAttribute((const void*)mk_fwd, hipFuncAttributeMaxDynamicSharedMemorySize, LDS_BYTES) != hipSuccess) { fprintf(stderr, "kernel_launch: hipFuncSetAttribute failed\n"); grid = -1; return; }
        if (hipOccupancyMaxActiveBlocksPerMultiprocessor(&per_cu, (const void*)mk_fwd, NWAVES * 64, LDS_BYTES) != hipSuccess || per_cu < 1) fprintf(stderr, "kernel_launch: occupancy query says %d\n", per_cu);
        (void)hipGetLastError();
        grid = cus;
    }
    if (grid < 0) return;
    (void)hipMemsetAsync((char*)d_ws + WS_CTL, 0, CTL_BYTES, stream);
    Args a{};
    for (int i = 0; i < 27; ++i) a.in[i] = (const float*)d_in[i];
    a.out = (float*)d_out; a.ws = (unsigned char*)d_ws;
    #ifndef MK_PER_PHASE
    a.ph_lo = 0; a.ph_hi = NPHASE; hipLaunchKernelGGL(mk_fwd, dim3(grid), dim3(NWAVES * 64), LDS_BYTES, stream, a);
#ifdef PROBE_LO
    (void)hipMemsetAsync((char*)d_ws + WS_CTL, 0, CTL_BYTES, stream);
    a.ph_lo = PROBE_LO; a.ph_hi = PROBE_HI; hipLaunchKernelGGL(mk_fwd, dim3(grid), dim3(NWAVES * 64), LDS_BYTES, stream, a);
#endif
#else
    for (int p = 0; p < NPHASE; ++p) { a.ph_lo = p; a.ph_hi = p + 1; hipLaunchKernelGGL(mk_fwd, dim3(grid), dim3(NWAVES * 64), LDS_BYTES, stream, a); }
#endif
}
```
